# Optimizing an MI355X kernel written in HIP

```python
import math
import jax, jax.numpy as jnp
from jax import lax
import numpy as np

D_MODEL = 1024
BATCH = 4
SEQ = 8192
DEPTH = 2

CTX_LEN = 256
GRID_W = 64
Q_BLOCK = 128
ROPE_THETA = 10000.0
NORM_EPS = 1e-6

N_BRANCH = 4
BRANCH_W = 512

S5_WIDTH = 512
S5_GROUP = 16
S5_GROUPS = S5_WIDTH // S5_GROUP
S5_STATE = 64

DA_HEADS = 4
DA_DK = 64
DA_DV = 2 * DA_DK

GQ_HEADS = 4
GQ_KV = 2
GQ_DH = 128

ML_HEADS = 4
ML_QRANK = 256
ML_KVRANK = 128
ML_NOPE = 128
ML_ROPE = 64
ML_DV = 128

D_FF = ((8 * D_MODEL + 3 * 256 - 1) // (3 * 256)) * 256

COLS_S5 = S5_WIDTH
COLS_DA = 3 * DA_HEADS * DA_DV
COLS_GQ = (GQ_HEADS + 2 * GQ_KV) * GQ_DH
COLS_ML = ML_QRANK + ML_KVRANK + ML_ROPE
OFF_DA = COLS_S5
OFF_GQ = OFF_DA + COLS_DA
OFF_ML = OFF_GQ + COLS_GQ
MIX_COLS = OFF_ML + COLS_ML
IN_COLS = MIX_COLS + N_BRANCH * D_MODEL

kernel_name = "hybrid_gated_s5_diffattn_gqa_mla_dit_block"


def rmsnorm(x, gain):
    xf = x.astype(jnp.float32)
    y = xf * lax.rsqrt(jnp.mean(xf * xf, axis=-1, keepdims=True) + NORM_EPS)
    return (y * gain.astype(jnp.float32)).astype(x.dtype)


def modulate(h, shift, scale):
    return h * (1.0 + scale) + shift


def axial_rope(rows, rot_dim):
    t = jnp.arange(rows * GRID_W)
    r = (t // GRID_W).astype(jnp.float32)
    col = (t % GRID_W).astype(jnp.float32)
    half = rot_dim // 2
    inv = ROPE_THETA ** (-jnp.arange(0, half, 2, dtype=jnp.float32) / half)
    ang = jnp.concatenate([r[:, None] * inv, col[:, None] * inv], axis=-1)
    return jnp.cos(ang), jnp.sin(ang)


def apply_rope(x, cos, sin):
    xf = x.astype(jnp.float32).reshape(x.shape[:-1] + (-1, 2))
    x0, x1 = xf[..., 0], xf[..., 1]
    out = jnp.stack([x0 * cos - x1 * sin, x0 * sin + x1 * cos], axis=-1)
    return out.reshape(x.shape).astype(x.dtype)


def _attend_block(q, k, v, scale):
    s = jnp.einsum('bhgqd,bhkd->bhgqk', q.astype(jnp.float32), k.astype(jnp.float32)) * scale
    p = jax.nn.softmax(s, axis=-1)
    return jnp.einsum('bhgqk,bhkd->bhgqd', p, v.astype(jnp.float32))


def attention(q, k, v, scale):
    b, hk, g, lq, dk = q.shape
    nb = lq // Q_BLOCK
    qb = jnp.moveaxis(q.reshape(b, hk, g, nb, Q_BLOCK, dk), 3, 0)
    out = lax.map(lambda qq: _attend_block(qq, k, v, scale), qb)
    return jnp.moveaxis(out, 0, 3).reshape(b, hk, g, lq, v.shape[-1])


def s5_discretise(lam_re, lam_im, log_step, b_re, b_im):
    lam_re = lam_re.astype(jnp.float32)
    lam_im = lam_im.astype(jnp.float32)
    dt = jnp.exp(log_step.astype(jnp.float32))[:, None]
    mag = jnp.exp(lam_re * dt)
    ab_re, ab_im = mag * jnp.cos(lam_im * dt), mag * jnp.sin(lam_im * dt)
    den = lam_re * lam_re + lam_im * lam_im
    nr, ni = ab_re - 1.0, ab_im
    coef_re = (nr * lam_re + ni * lam_im) / den
    coef_im = (ni * lam_re - nr * lam_im) / den
    b_re = b_re.astype(jnp.float32)
    b_im = b_im.astype(jnp.float32)
    bb_re = coef_re[..., None] * b_re - coef_im[..., None] * b_im
    bb_im = coef_re[..., None] * b_im + coef_im[..., None] * b_re
    return ab_re, ab_im, bb_re, bb_im


def _complex_affine_combine(e1, e2):
    a1r, a1i, b1r, b1i = e1
    a2r, a2i, b2r, b2i = e2
    return (a2r * a1r - a2i * a1i,
            a2r * a1i + a2i * a1r,
            a2r * b1r - a2i * b1i + b2r,
            a2r * b1i + a2i * b1r + b2i)


def s5_scan(u, ab_re, ab_im, bb_re, bb_im, h0_re, h0_im, reverse):
    bu_re = jnp.einsum('blgc,gpc->blgp', u, bb_re)
    bu_im = jnp.einsum('blgc,gpc->blgp', u, bb_im)
    if reverse:
        bu_re, bu_im = jnp.flip(bu_re, axis=1), jnp.flip(bu_im, axis=1)
    if h0_re is not None:
        bu_re = bu_re.at[:, 0].add(ab_re * h0_re - ab_im * h0_im)
        bu_im = bu_im.at[:, 0].add(ab_re * h0_im + ab_im * h0_re)
    n = u.shape[1]
    a_re = jnp.broadcast_to(ab_re[None, None], (1, n) + ab_re.shape)
    a_im = jnp.broadcast_to(ab_im[None, None], (1, n) + ab_im.shape)
    _, _, h_re, h_im = lax.associative_scan(_complex_affine_combine, (a_re, a_im, bu_re, bu_im), axis=1)
    f_re, f_im = h_re[:, -1], h_im[:, -1]
    if reverse:
        h_re, h_im = jnp.flip(h_re, axis=1), jnp.flip(h_im, axis=1)
    return h_re, h_im, f_re, f_im


def s5_readout(h_re, h_im, c_re, c_im):
    return (jnp.einsum('blgp,gcp->blgc', h_re, c_re.astype(jnp.float32))
            - jnp.einsum('blgp,gcp->blgc', h_im, c_im.astype(jnp.float32)))


def s5_branch(ul, uc, lam_re, lam_im, log_step, b_re, b_im, c_re, c_im, d, w_glu, b_glu, ctx_out):
    def groups(u):
        return u.astype(jnp.float32).reshape(u.shape[0], u.shape[1], S5_GROUPS, S5_GROUP)
    gl, gc = groups(ul), groups(uc)
    d_g = d.astype(jnp.float32).reshape(S5_GROUPS, S5_GROUP)
    y_l = d_g * gl
    y_c = d_g * gc if ctx_out else None
    for direction, reverse in ((0, False), (1, True)):
        disc = s5_discretise(lam_re[direction], lam_im[direction], log_step[direction],
                             b_re[direction], b_im[direction])
        hc_re, hc_im, fc_re, fc_im = s5_scan(gc, *disc, None, None, reverse)
        hl_re, hl_im, _, _ = s5_scan(gl, *disc, fc_re, fc_im, reverse)
        y_l = y_l + s5_readout(hl_re, hl_im, c_re[direction], c_im[direction])
        if ctx_out:
            y_c = y_c + s5_readout(hc_re, hc_im, c_re[direction], c_im[direction])

    def glu(y):
        g = jax.nn.gelu(y.reshape(y.shape[0], y.shape[1], S5_WIDTH))
        gate = jax.nn.sigmoid(g @ w_glu.astype(jnp.float32) + b_glu.astype(jnp.float32))
        return (g * gate).astype(ul.dtype)

    return glu(y_l), (glu(y_c) if ctx_out else None)


def diff_attn_branch(zl, zc, q_norm, k_norm, lam, subln, lam_init, cos, sin, ctx_out):
    def project(z, rope):
        b, l, _ = z.shape
        q, k, v = jnp.split(z, 3, axis=-1)
        q = rmsnorm(q.reshape(b, l, DA_HEADS, 2, DA_DK).transpose(0, 2, 3, 1, 4), q_norm)
        k = rmsnorm(k.reshape(b, l, DA_HEADS, 2, DA_DK).transpose(0, 2, 3, 1, 4), k_norm)
        v = v.reshape(b, l, DA_HEADS, DA_DV).transpose(0, 2, 1, 3)
        if rope:
            q, k = apply_rope(q, cos, sin), apply_rope(k, cos, sin)
        return q, k, v

    lam_f = lam.astype(jnp.float32)
    lam_full = jnp.exp(jnp.sum(lam_f[0] * lam_f[1])) - jnp.exp(jnp.sum(lam_f[2] * lam_f[3])) + lam_init
    scale = DA_DK ** -0.5

    def diff(q, k, v):
        a1 = attention(q[:, :, 0:1], k[:, :, 0], v, scale)[:, :, 0]
        a2 = attention(q[:, :, 1:2], k[:, :, 1], v, scale)[:, :, 0]
        o = rmsnorm(a1 - lam_full * a2, subln) * (1.0 - lam_init)
        b, h, l, dv = o.shape
        return o.transpose(0, 2, 1, 3).reshape(b, l, h * dv).astype(zl.dtype)

    qc, kc, vc = project(zc, False)
    ql, kl, vl = project(zl, True)
    out_l = diff(ql, jnp.concatenate([kc, kl], axis=3), jnp.concatenate([vc, vl], axis=2))
    out_c = diff(qc, kc, vc) if ctx_out else None
    return out_l, out_c


def gqa_branch(zl, zc, q_norm, k_norm, cos, sin, ctx_out):
    group = GQ_HEADS // GQ_KV

    def project(z, rope):
        b, l, _ = z.shape
        q, k, v = jnp.split(z, [GQ_HEADS * GQ_DH, (GQ_HEADS + GQ_KV) * GQ_DH], axis=-1)
        q = rmsnorm(q.reshape(b, l, GQ_KV, group, GQ_DH).transpose(0, 2, 3, 1, 4), q_norm)
        k = rmsnorm(k.reshape(b, l, GQ_KV, GQ_DH).transpose(0, 2, 1, 3), k_norm)
        v = v.reshape(b, l, GQ_KV, GQ_DH).transpose(0, 2, 1, 3)
        if rope:
            q, k = apply_rope(q, cos, sin), apply_rope(k, cos, sin)
        return q, k, v

    def attend(q, k, v):
        o = attention(q, k, v, GQ_DH ** -0.5)
        b, kv, g, l, dh = o.shape
        return o.transpose(0, 3, 1, 2, 4).reshape(b, l, kv * g * dh).astype(zl.dtype)

    qc, kc, vc = project(zc, False)
    ql, kl, vl = project(zl, True)
    out_l = attend(ql, jnp.concatenate([kc, kl], axis=2), jnp.concatenate([vc, vl], axis=2))
    out_c = attend(qc, kc, vc) if ctx_out else None
    return out_l, out_c


def mla_branch(zl, zc, cq_norm, ckv_norm, w_uq, w_ukv, q_norm, k_norm, cos, sin, ctx_out):
    dqk = ML_NOPE + ML_ROPE

    def project(z, rope):
        b, l, _ = z.shape
        cq, ckv, kr = jnp.split(z, [ML_QRANK, ML_QRANK + ML_KVRANK], axis=-1)
        q = (rmsnorm(cq, cq_norm) @ w_uq).reshape(b, l, ML_HEADS, dqk).transpose(0, 2, 1, 3)
        kv = (rmsnorm(ckv, ckv_norm) @ w_ukv).reshape(b, l, ML_HEADS, ML_NOPE + ML_DV).transpose(0, 2, 1, 3)
        q_nope = rmsnorm(q[..., :ML_NOPE], q_norm[:ML_NOPE])
        q_rope = rmsnorm(q[..., ML_NOPE:], q_norm[ML_NOPE:])
        k_nope = rmsnorm(kv[..., :ML_NOPE], k_norm[:ML_NOPE])
        v = kv[..., ML_NOPE:]
        k_rope = rmsnorm(kr, k_norm[ML_NOPE:])[:, None]
        if rope:
            q_rope, k_rope = apply_rope(q_rope, cos, sin), apply_rope(k_rope, cos, sin)
        q = jnp.concatenate([q_nope, q_rope], axis=-1)
        k = jnp.concatenate([k_nope, jnp.broadcast_to(k_rope, k_nope.shape[:-1] + (ML_ROPE,))], axis=-1)
        return q, k, v

    def attend(q, k, v):
        o = attention(q[:, :, None], k, v, dqk ** -0.5)[:, :, 0]
        b, h, l, dv = o.shape
        return o.transpose(0, 2, 1, 3).reshape(b, l, h * dv).astype(zl.dtype)

    qc, kc, vc = project(zc, False)
    ql, kl, vl = project(zl, True)
    out_l = attend(ql, jnp.concatenate([kc, kl], axis=2), jnp.concatenate([vc, vl], axis=2))
    out_c = attend(qc, kc, vc) if ctx_out else None
    return out_l, out_c


def merge_branches(branches, gate_logits, w_branch, w_out):
    b, l, _ = gate_logits.shape
    gates = jax.nn.sigmoid(gate_logits.reshape(b, l, N_BRANCH, D_MODEL))
    acc = gates[:, :, 0] * (branches[0] @ w_branch[0])
    for n in range(1, N_BRANCH):
        acc = acc + gates[:, :, n] * (branches[n] @ w_branch[n])
    return acc @ w_out


def swiglu(h, w_in, w_out):
    gate, up = jnp.split(h @ w_in, 2, axis=-1)
    return (jax.nn.silu(gate) * up) @ w_out


def setup_inputs(seed: int = 0) -> dict:
    key = jax.random.key(seed)
    keys = jax.random.split(key, 40)
    counter = iter(range(40))

    def nrm(shape, scale):
        return jax.random.normal(keys[next(counter)], shape, jnp.float32) * scale

    def gain(shape):
        return 1.0 + 0.02 * jax.random.normal(keys[next(counter)], shape, jnp.float32)

    L, G, P, C = DEPTH, S5_GROUPS, S5_STATE, S5_GROUP
    n_idx = jnp.arange(P, dtype=jnp.float32)
    return {
        "x": nrm((BATCH, SEQ, D_MODEL), 1.0),
        "c": nrm((BATCH, D_MODEL), 1.0),
        "ctx": nrm((BATCH, CTX_LEN, D_MODEL), 1.0),
        "c_ctx": nrm((D_MODEL,), 1.0),
        "w_mod": nrm((L, D_MODEL, 6 * D_MODEL), 0.3 * D_MODEL ** -0.5),
        "b_mod": nrm((L, 6 * D_MODEL), 0.01),
        "norm_mix": gain((L, D_MODEL)),
        "w_in": nrm((L, D_MODEL, IN_COLS), D_MODEL ** -0.5),
        "s5_lam_re": -0.5 + nrm((L, 2, G, P), 0.01),
        "s5_lam_im": math.pi * n_idx + nrm((L, 2, G, P), 0.01),
        "s5_log_step": jax.random.uniform(keys[next(counter)], (L, 2, G), jnp.float32,
                                          math.log(1e-3), math.log(1e-1)),
        "s5_b_re": nrm((L, 2, G, P, C), (2 * C) ** -0.5),
        "s5_b_im": nrm((L, 2, G, P, C), (2 * C) ** -0.5),
        "s5_c_re": nrm((L, 2, G, C, P), (2 * P) ** -0.5),
        "s5_c_im": nrm((L, 2, G, C, P), (2 * P) ** -0.5),
        "s5_d": nrm((L, S5_WIDTH), 1.0),
        "s5_w_glu": nrm((L, S5_WIDTH, S5_WIDTH), S5_WIDTH ** -0.5),
        "s5_b_glu": nrm((L, S5_WIDTH), 0.01),
        "da_q_norm": gain((L, DA_DK)),
        "da_k_norm": gain((L, DA_DK)),
        "da_lam": nrm((L, 4, DA_DK), 0.1),
        "da_subln": gain((L, DA_DV)),
        "gq_q_norm": gain((L, GQ_DH)),
        "gq_k_norm": gain((L, GQ_DH)),
        "ml_cq_norm": gain((L, ML_QRANK)),
        "ml_ckv_norm": gain((L, ML_KVRANK)),
        "ml_w_uq": nrm((L, ML_QRANK, ML_HEADS * (ML_NOPE + ML_ROPE)), ML_QRANK ** -0.5),
        "ml_w_ukv": nrm((L, ML_KVRANK, ML_HEADS * (ML_NOPE + ML_DV)), ML_KVRANK ** -0.5),
        "ml_q_norm": gain((L, ML_NOPE + ML_ROPE)),
        "ml_k_norm": gain((L, ML_NOPE + ML_ROPE)),
        "w_branch": nrm((L, N_BRANCH, BRANCH_W, D_MODEL), BRANCH_W ** -0.5),
        "w_out": nrm((L, D_MODEL, D_MODEL), D_MODEL ** -0.5),
        "norm_ffn": gain((L, D_MODEL)),
        "w_ffn_in": nrm((L, D_MODEL, 2 * D_FF), D_MODEL ** -0.5),
        "w_ffn_out": nrm((L, D_FF, D_MODEL), D_FF ** -0.5),
    }


def reference(x, c, ctx, c_ctx, w_mod, b_mod, norm_mix, w_in, s5_lam_re, s5_lam_im, s5_log_step,
              s5_b_re, s5_b_im, s5_c_re, s5_c_im, s5_d, s5_w_glu, s5_b_glu, da_q_norm, da_k_norm,
              da_lam, da_subln, gq_q_norm, gq_k_norm, ml_cq_norm, ml_ckv_norm, ml_w_uq, ml_w_ukv,
              ml_q_norm, ml_k_norm, w_branch, w_out, norm_ffn, w_ffn_in, w_ffn_out):
    rows = x.shape[1] // GRID_W
    cos64, sin64 = axial_rope(rows, DA_DK)
    cos128, sin128 = axial_rope(rows, GQ_DH)
    splits = [OFF_DA, OFF_GQ, OFF_ML, MIX_COLS]
    for i in range(DEPTH):
        ctx_out = i < DEPTH - 1
        mod_l = (jax.nn.silu(c) @ w_mod[i] + b_mod[i])[:, None, :]
        mod_c = jax.nn.silu(c_ctx) @ w_mod[i] + b_mod[i]
        sh1l, sc1l, g1l, sh2l, sc2l, g2l = jnp.split(mod_l, 6, axis=-1)
        sh1c, sc1c, g1c, sh2c, sc2c, g2c = jnp.split(mod_c, 6, axis=-1)

        hl = modulate(rmsnorm(x, norm_mix[i]), sh1l, sc1l)
        hc = modulate(rmsnorm(ctx, norm_mix[i]), sh1c, sc1c)
        zl = hl @ w_in[i]
        zc = hc @ (w_in[i] if ctx_out else w_in[i][:, :MIX_COLS])
        s5l, dal, gql, mll, gate_l = jnp.split(zl, splits, axis=-1)
        s5c, dac, gqc, mlc, gate_c = jnp.split(zc, splits, axis=-1)

        a_l, a_c = s5_branch(s5l, s5c, s5_lam_re[i], s5_lam_im[i], s5_log_step[i], s5_b_re[i], s5_b_im[i],
                             s5_c_re[i], s5_c_im[i], s5_d[i], s5_w_glu[i], s5_b_glu[i], ctx_out)
        lam_init = 0.8 - 0.6 * math.exp(-0.3 * i)
        b_l, b_c = diff_attn_branch(dal, dac, da_q_norm[i], da_k_norm[i], da_lam[i], da_subln[i],
                                    lam_init, cos64, sin64, ctx_out)
        c_l, c_c = gqa_branch(gql, gqc, gq_q_norm[i], gq_k_norm[i], cos128, sin128, ctx_out)
        d_l, d_c = mla_branch(mll, mlc, ml_cq_norm[i], ml_ckv_norm[i], ml_w_uq[i], ml_w_ukv[i],
                              ml_q_norm[i], ml_k_norm[i], cos64, sin64, ctx_out)

        x = x + g1l * merge_branches((a_l, b_l, c_l, d_l), gate_l, w_branch[i], w_out[i])
        x = x + g2l * swiglu(modulate(rmsnorm(x, norm_ffn[i]), sh2l, sc2l), w_ffn_in[i], w_ffn_out[i])
        if ctx_out:
            ctx = ctx + g1c * merge_branches((a_c, b_c, c_c, d_c), gate_c, w_branch[i], w_out[i])
            ctx = ctx + g2c * swiglu(modulate(rmsnorm(ctx, norm_ffn[i]), sh2c, sc2c), w_ffn_in[i], w_ffn_out[i])
    return x
```

```cpp
#include <hip/hip_runtime.h>
#include <hip/hip_cooperative_groups.h>
#include <cstdio>
#include <cstdint>
namespace cg = cooperative_groups;

#ifndef MK_MODE
#define MK_MODE 0
#endif

#define LAS __attribute__((address_space(3)))
typedef unsigned short bf16_t;
typedef short bf16x8 __attribute__((ext_vector_type(8)));
typedef short s16x4 __attribute__((ext_vector_type(4)));
typedef float f32x4 __attribute__((ext_vector_type(4)));
typedef float f32x16 __attribute__((ext_vector_type(16)));
typedef unsigned u32x4 __attribute__((ext_vector_type(4)));
typedef unsigned u32x2 __attribute__((ext_vector_type(2)));

constexpr int DM = 1024, NB = 4, SEQ = 8192, CTX = 256, RB = SEQ + CTX  , MTOT = NB * RB  ;
constexpr int TPB = RB / 256;
constexpr int ZW = 7168;
constexpr int Z_DAQ = 0, Z_DAK = 512, Z_DAV = 1024, Z_GQQ = 1536, Z_GQK = 2048, Z_GQV = 2304, Z_CQ = 2560, Z_CKV = 2816, Z_KR = 2944, Z_GATE = 3072;
constexpr int DFF = 2816, MODW = 6144;
constexpr float EPS = 1e-6f;

constexpr size_t MiB = 1u << 20;
constexpr size_t al(size_t x) { return (x + MiB - 1) / MiB * MiB; }
constexpr size_t WS_MOD = 0;
constexpr size_t WS_CTXB = al(WS_MOD + 2 * 5 * MODW * 4);
constexpr size_t WS_W = WS_CTXB + 4 * MiB;
constexpr size_t W_IN = 0, W_UQ = W_IN + (size_t)7680 * 1024, W_UKV = W_UQ + 768 * 256, W_GLU = W_UKV + 1024 * 128, W_BR = W_GLU + 512 * 512,
                 W_OUT = W_BR + (size_t)4 * 1024 * 512, W_FI = W_OUT + (size_t)1024 * 1024, W_FO = W_FI + (size_t)5632 * 1024, W_LAYER = W_FO + (size_t)1024 * 2816;
constexpr size_t W_LAYER_B = al(W_LAYER * 2);
constexpr size_t WS_H = WS_W + 2 * W_LAYER_B;
constexpr size_t WS_ABR = WS_H + al((size_t)MTOT * 1024 * 2);
constexpr size_t WS_G = WS_ABR + al((size_t)MTOT * 512 * 2);
constexpr size_t G_Z = 0;
constexpr size_t G_CQ = al(G_Z + (size_t)RB * ZW * 2);
constexpr size_t G_CKV = al(G_CQ + (size_t)RB * 256 * 2);
constexpr size_t G_MLQ = al(G_CKV + (size_t)RB * 128 * 2);
constexpr size_t G_MLKV = al(G_MLQ + (size_t)RB * 768 * 2);
constexpr size_t G_KF = al(G_MLKV + (size_t)RB * 1024 * 2);
constexpr size_t G_A1 = al(G_KF + (size_t)RB * 768 * 2);
constexpr size_t G_A2 = al(G_A1 + (size_t)RB * 512 * 2);
constexpr size_t G_BR = al(G_A2 + (size_t)RB * 512 * 2);
constexpr size_t G_MF = al(G_BR + (size_t)3 * RB * 512 * 2);
constexpr size_t G_END = al(G_MF + (size_t)RB * 1024 * 4);
constexpr size_t S_U = 0, S_YF = al((size_t)MTOT * 512 * 2), S_YR = 2 * S_YF, S_END = 3 * S_YF;
constexpr size_t HID_B = (size_t)MTOT * DFF * 2;
static_assert(S_END <= G_END && HID_B <= G_END, "aliases fit");
constexpr size_t WS_END = WS_G + G_END;
static_assert(WS_END <= (size_t)512 * MiB, "workspace budget");
static_assert((WS_G + G_BR - WS_ABR) % 262144 == 0, "merge virtual tiles");

constexpr int LDS_BYTES = 147456;

__device__ __forceinline__ unsigned cvt_pk_bf16(float lo, float hi) { unsigned r; asm volatile("v_cvt_pk_bf16_f32 %0, %1, %2" : "=v"(r) : "v"(lo), "v"(hi)); return r; }
__device__ __forceinline__ float bf2f(unsigned v) { return __uint_as_float(v << 16); }
__device__ __forceinline__ float bflo(unsigned w) { return __uint_as_float(w << 16); }
__device__ __forceinline__ float bfhi(unsigned w) { return __uint_as_float(w & 0xffff0000u); }
__device__ __forceinline__ bf16_t f2bf(float f) { return (bf16_t)(cvt_pk_bf16(f, 0.f) & 0xffffu); }
template <int O> __device__ __forceinline__ float swz_xor(float v) { return __int_as_float(__builtin_amdgcn_ds_swizzle(__float_as_int(v), 0x1f | (O << 10))); }
__device__ __forceinline__ float half_sum(float v) {
    v += swz_xor<1>(v); v += swz_xor<2>(v); v += swz_xor<4>(v); v += swz_xor<8>(v); v += swz_xor<16>(v); return v;
}
__device__ __forceinline__ float wave_sum(float v) {
    v = half_sum(v);
    auto rr = __builtin_amdgcn_permlane32_swap(__float_as_uint(v), __float_as_uint(v), false, false);
    return __uint_as_float(rr[0]) + __uint_as_float(rr[1]);
}
__device__ __forceinline__ int otid() { int t = threadIdx.x; asm volatile("" : "+v"(t)); return t; }
__device__ __forceinline__ float sigmoidf_(float x) { return 1.f / (1.f + __expf(-x)); }

__device__ __forceinline__ int obid() { int b = blockIdx.x; asm volatile("" : "+s"(b)); return b; }
struct Params { const float* in[35]; float* out; unsigned char* ws; int lo, hi; };
__device__ __forceinline__ Params load_params() {
#if defined(__HIP_DEVICE_COMPILE__)
    typedef const __attribute__((address_space(4))) Params* CP;
    CP q = (CP)__builtin_amdgcn_kernarg_segment_ptr(); asm volatile("" : "+s"(q));
    Params r;
#pragma unroll
    for (int i = 0; i < 35; ++i) r.in[i] = q->in[i];
    r.out = q->out; r.ws = q->ws; r.lo = q->lo; r.hi = q->hi; return r;
#else
    return Params{};
#endif
}

namespace pg8 {
constexpr int BM = 256, BK = 64, HALF = 128, HTB = HALF * BK * 2, STAGE_BYTES = 8 * HTB, NXCD = 8, WGM = 8;
__host__ __device__ __forceinline__ int lds_byte(int r, int c) { const int st = (r >> 4) * 2 + (c >> 5), rr = r & 15, cc = c & 31, ob = rr * 64 + cc * 2; return st * 1024 + (ob ^ (((ob >> 9) & 1) << 5)); }
__host__ __device__ __forceinline__ void stage_rc(int b, int& R, int& C) { const int st = b / 1024, sb = b % 1024, swz = sb ^ (((sb >> 9) & 1) << 5); R = (st >> 1) * 16 + swz / 64; C = (st & 1) * 32 + (swz % 64) / 2; }
__host__ __device__ __forceinline__ int perm32(int rho) { const int n = rho >> 4, i = rho & 15; return 8 * (i >> 2) + 4 * n + (i & 3); }
struct Unit { int pm, pn; };
struct Gemm { const bf16_t* A; const bf16_t* Bt; int M, N, K; };
struct StaticOrder {
    int nM, nN, nwg, G, c;
    __device__ void init(int M, int N, int G_, int c_) { nM = M / BM; nN = N / BM; nwg = nM * nN; G = G_; c = c_; }
    __device__ bool next(int i, Unit& u) const {
        const long L = (long)i * G + c; if (L >= nwg) return false;
        int wgid = (int)L; { const int q = nwg / NXCD, r = nwg % NXCD, xcd = wgid % NXCD, off = wgid / NXCD; wgid = (xcd < r ? xcd * (q + 1) : r * (q + 1) + (xcd - r) * q) + off; }
        const int nig = WGM * nN, gid = wgid / nig, fm = gid * WGM, gsz = (nM - fm) < WGM ? (nM - fm) : WGM;
        u.pm = fm + ((wgid % nig) % gsz); u.pn = (wgid % nig) / gsz; return true;
    }
};
struct MergeOrder {
    int G, c, vpm0, vpm1;
    __device__ bool next(int i, Unit& u) const {
        const int j = i >> 2, n = i & 3; const int L = j * G + c; if (L >= TPB * 4) return false;
        const int pm = L >> 2, pn = L & 3; u.pm = (n == 0 ? vpm0 : vpm1 + (n - 1) * TPB) + pm; u.pn = n * 4 + pn; return true;
    }
};

enum { E_STORE = 0, E_INPROJ = 1, E_GLU = 2, E_MERGE = 3, E_RESID = 4, E_SWIGLU = 5 };
struct EpiArgs {
    bf16_t* O; int ldc;
    const bf16_t* G; int ldg;
    const float* bias;
    float* MF;
    int vpm0, vpm1;
    const float* xin_l; const float* xin_c; float* xout_l; float* xout_c; const float* gate;
};
template <int MODE> struct Epi {
    EpiArgs a;
    __device__ __forceinline__ void operator()(const f32x4 (&acc)[2][2][4][2], const Unit& u, int, int, int, int) const {
        const int t_ = otid(), wid_ = __builtin_amdgcn_readfirstlane(t_ >> 6), wr = wid_ >> 2, wc = wid_ & 3, fr = t_ & 15, fq = (t_ & 63) >> 4;
        int pm = u.pm, pn = u.pn, nbr = 0;
        if (MODE == E_MERGE) { nbr = u.pn >> 2; pn = u.pn & 3; pm = u.pm - (nbr == 0 ? a.vpm0 : a.vpm1 + (nbr - 1) * TPB); }
        const int row0 = pm * BM + wr * 64 + fr;
        const int col0 = (MODE == E_SWIGLU ? pn * 128 : pn * BM) + wc * 32 + 8 * fq;
        const float* xin = nullptr; float* xout = nullptr; const float* gv = nullptr;
        if (MODE == E_RESID) {
            const int b = pm / TPB, t = pm - b * TPB;
            if (t == 0) { xin = a.xin_c + (size_t)b * CTX * DM; xout = a.xout_c + (size_t)b * CTX * DM; gv = a.gate + 4 * MODW; }
            else { xin = a.xin_l + ((size_t)b * SEQ + (size_t)(t - 1) * 256) * DM; xout = a.xout_l + ((size_t)b * SEQ + (size_t)(t - 1) * 256) * DM; gv = a.gate + b * MODW; }
        }
#pragma unroll
        for (int ai = 0; ai < 2; ++ai)
#pragma unroll
            for (int m = 0; m < 4; ++m) {
                const int row = row0 + ai * HALF + m * 16;
                if (MODE == E_SWIGLU) {
                    const f32x4 g0 = acc[ai][0][m][0], g1 = acc[ai][0][m][1], u0 = acc[ai][1][m][0], u1 = acc[ai][1][m][1];
                    float h[8];
#pragma unroll
                    for (int e = 0; e < 4; ++e) { h[e] = g0[e] * sigmoidf_(g0[e]) * u0[e]; h[4 + e] = g1[e] * sigmoidf_(g1[e]) * u1[e]; }
                    u32x4 w; w.x = cvt_pk_bf16(h[0], h[1]); w.y = cvt_pk_bf16(h[2], h[3]); w.z = cvt_pk_bf16(h[4], h[5]); w.w = cvt_pk_bf16(h[6], h[7]);
                    *(u32x4*)(a.O + (size_t)row * a.ldc + col0) = w;
                    continue;
                }
#pragma unroll
                for (int bj = 0; bj < 2; ++bj) {
                    const int col = col0 + bj * HALF;
                    f32x4 v0 = acc[ai][bj][m][0], v1 = acc[ai][bj][m][1];
                    if (MODE == E_STORE) {
                        u32x4 w; w.x = cvt_pk_bf16(v0[0], v0[1]); w.y = cvt_pk_bf16(v0[2], v0[3]); w.z = cvt_pk_bf16(v1[0], v1[1]); w.w = cvt_pk_bf16(v1[2], v1[3]);
                        *(u32x4*)(a.O + (size_t)row * a.ldc + col) = w;
                    } else if (MODE == E_INPROJ) {
                        if (pn >= 12) {
#pragma unroll
                            for (int e = 0; e < 4; ++e) { v0[e] = sigmoidf_(v0[e]); v1[e] = sigmoidf_(v1[e]); }
                        }
                        u32x4 w; w.x = cvt_pk_bf16(v0[0], v0[1]); w.y = cvt_pk_bf16(v0[2], v0[3]); w.z = cvt_pk_bf16(v1[0], v1[1]); w.w = cvt_pk_bf16(v1[2], v1[3]);
                        *(u32x4*)(a.O + (size_t)row * a.ldc + col) = w;
                    } else if (MODE == E_GLU) {
                        const u32x4 gw = *(const u32x4*)(a.G + (size_t)row * a.ldg + col);
                        const f32x4 b0 = *(const f32x4*)(a.bias + col), b1 = *(const f32x4*)(a.bias + col + 4);
                        float o[8];
                        o[0] = bflo(gw.x) * sigmoidf_(v0[0] + b0[0]); o[1] = bfhi(gw.x) * sigmoidf_(v0[1] + b0[1]);
                        o[2] = bflo(gw.y) * sigmoidf_(v0[2] + b0[2]); o[3] = bfhi(gw.y) * sigmoidf_(v0[3] + b0[3]);
                        o[4] = bflo(gw.z) * sigmoidf_(v1[0] + b1[0]); o[5] = bfhi(gw.z) * sigmoidf_(v1[1] + b1[1]);
                        o[6] = bflo(gw.w) * sigmoidf_(v1[2] + b1[2]); o[7] = bfhi(gw.w) * sigmoidf_(v1[3] + b1[3]);
                        u32x4 w; w.x = cvt_pk_bf16(o[0], o[1]); w.y = cvt_pk_bf16(o[2], o[3]); w.z = cvt_pk_bf16(o[4], o[5]); w.w = cvt_pk_bf16(o[6], o[7]);
                        *(u32x4*)(a.O + (size_t)row * a.ldc + col) = w;
                    } else if (MODE == E_MERGE) {
                        const u32x4 gw = *(const u32x4*)(a.G + (size_t)row * a.ldg + nbr * 1024 + col);
                        f32x4 p0, p1;
                        p0[0] = bflo(gw.x) * v0[0]; p0[1] = bfhi(gw.x) * v0[1]; p0[2] = bflo(gw.y) * v0[2]; p0[3] = bfhi(gw.y) * v0[3];
                        p1[0] = bflo(gw.z) * v1[0]; p1[1] = bfhi(gw.z) * v1[1]; p1[2] = bflo(gw.w) * v1[2]; p1[3] = bfhi(gw.w) * v1[3];
                        float* mf = a.MF + (size_t)row * 1024 + col;
                        if (nbr != 0) { p0 = p0 + *(const f32x4*)mf; p1 = p1 + *(const f32x4*)(mf + 4); }
                        if (nbr != 3) { *(f32x4*)mf = p0; *(f32x4*)(mf + 4) = p1; }
                        else { u32x4 w; w.x = cvt_pk_bf16(p0[0], p0[1]); w.y = cvt_pk_bf16(p0[2], p0[3]); w.z = cvt_pk_bf16(p1[0], p1[1]); w.w = cvt_pk_bf16(p1[2], p1[3]);
                               *(u32x4*)(a.O + (size_t)row * a.ldc + col) = w; }
                    } else if (MODE == E_RESID) {
                        const int lr = row - pm * BM;
                        const f32x4 g0 = *(const f32x4*)(gv + col), g1 = *(const f32x4*)(gv + col + 4);
                        const f32x4 x0 = *(const f32x4*)(xin + (size_t)lr * DM + col), x1 = *(const f32x4*)(xin + (size_t)lr * DM + col + 4);
                        *(f32x4*)(xout + (size_t)lr * DM + col) = x0 + g0 * v0;
                        *(f32x4*)(xout + (size_t)lr * DM + col + 4) = x1 + g1 * v1;
                    }
                }
            }
    }
};

template <class EpiT, class Sched>
__device__ __forceinline__ void gemm_phase(LAS unsigned char* lds, const Gemm g, const Sched& S, const EpiT& E) {
    int tid_ = threadIdx.x; asm volatile("" : "+v"(tid_));
    const int tid = tid_, wid = __builtin_amdgcn_readfirstlane(tid >> 6), lane = tid & 63, wr = wid >> 2, wc = wid & 3, fr = lane & 15, fq = lane >> 4;
    const int K = g.K, nt = K / BK;
    unsigned voffA[2], voffB[2];
#pragma unroll
    for (int i = 0; i < 2; ++i) { int R, C; stage_rc(tid * 16 + i * 8192, R, C); const int Rb = (R & ~31) + perm32(R & 31);
        voffA[i] = (unsigned)(R * K + C) * 2u; voffB[i] = (unsigned)(Rb * K + C) * 2u; }
    const size_t kstep = (size_t)(BK * 2);
    const size_t hstep = (size_t)HALF * K * 2;
    const size_t tstep = 2 * hstep;
    const unsigned ldsw = (unsigned)wid * 1024u;
    const int aoff = lds_byte(wr * 64 + fr, fq * 8), boff = lds_byte(wc * 32 + fr, fq * 8);
#define PG8_SA(b, h) (((b) * 2 + (h)) * HTB)
#define PG8_SB(b, h) ((4 + (b) * 2 + (h)) * HTB)
#define PG8_STAGE(bufoff, gbase, voff) do { _Pragma("unroll") for (int _i = 0; _i < 2; ++_i) \
        __builtin_amdgcn_global_load_lds((const unsigned*)((const char*)(gbase) + (voff)[_i]), (LAS unsigned*)(lds + (bufoff) + ldsw + _i * 8192), 16, 0, 0); } while (0)
#define PG8_LDA(dst, b, h) do { _Pragma("unroll") for (int m = 0; m < 4; ++m) _Pragma("unroll") for (int k = 0; k < 2; ++k) dst[m][k] = *(const LAS bf16x8*)(lds + PG8_SA(b, h) + aoff + m * 2048 + k * 1024); } while (0)
#define PG8_LDB(dst, b, h) do { _Pragma("unroll") for (int n = 0; n < 2; ++n) _Pragma("unroll") for (int k = 0; k < 2; ++k) dst[n][k] = *(const LAS bf16x8*)(lds + PG8_SB(b, h) + boff + n * 2048 + k * 1024); } while (0)
#define PG8_MMA(ai, bj, At, Bt) do { __builtin_amdgcn_s_setprio(1); _Pragma("unroll") for (int m = 0; m < 4; ++m) _Pragma("unroll") for (int n = 0; n < 2; ++n) _Pragma("unroll") for (int k = 0; k < 2; ++k) \
        acc[ai][bj][m][n] = __builtin_amdgcn_mfma_f32_16x16x32_bf16(Bt[n][k], At[m][k], acc[ai][bj][m][n], 0, 0, 0); __builtin_amdgcn_s_setprio(0); } while (0)
#define PG8_WAIT_V(n) asm volatile("s_waitcnt vmcnt(" #n ")" ::: "memory")
#define PG8_WAIT_L(n) asm volatile("s_waitcnt lgkmcnt(" #n ")" ::: "memory")
#define PG8_BAR __builtin_amdgcn_s_barrier()
#define PG8_SCHED __builtin_amdgcn_sched_barrier(0)
    Unit cur, nxt; int ui = 0;
    if (!S.next(0, cur)) return;
    f32x4 acc[2][2][4][2];
#pragma unroll
    for (int a = 0; a < 2; ++a)
#pragma unroll
        for (int b = 0; b < 2; ++b)
#pragma unroll
            for (int m = 0; m < 4; ++m)
#pragma unroll
                for (int n = 0; n < 2; ++n) acc[a][b][m][n] = (f32x4){0.f, 0.f, 0.f, 0.f};
    bf16x8 At[4][2], B0[2][2], B1[2][2];
    const char* cA = (const char*)g.A + (size_t)cur.pm * tstep; const char* cB = (const char*)g.Bt + (size_t)cur.pn * tstep;
    PG8_STAGE(PG8_SB(0, 0), cB, voffB); PG8_STAGE(PG8_SB(0, 1), cB + hstep, voffB); PG8_STAGE(PG8_SA(0, 0), cA, voffA); PG8_STAGE(PG8_SA(0, 1), cA + hstep, voffA);
    if (wr == 1) PG8_BAR;
    PG8_WAIT_V(2); PG8_BAR;
    PG8_STAGE(PG8_SB(1, 0), cB + kstep, voffB); PG8_STAGE(PG8_SA(1, 0), cA + kstep, voffA); PG8_STAGE(PG8_SB(1, 1), cB + hstep + kstep, voffB);
    PG8_WAIT_V(6); PG8_BAR;
    for (;;) {
        const bool has_next = S.next(ui + 1, nxt);
        const char* nA = has_next ? (const char*)g.A + (size_t)nxt.pm * tstep : cA; const char* nB = has_next ? (const char*)g.Bt + (size_t)nxt.pn * tstep : cB;
        for (int t = 0; t < nt; t += 2) {
            const bool last = (t == nt - 2);
            const char* a1 = cA + (size_t)(t + 1) * kstep;
            const char* a2 = last ? nA : cA + (size_t)(t + 2) * kstep; const char* b2 = last ? nB : cB + (size_t)(t + 2) * kstep;
            const char* a3 = a2 + kstep; const char* b3 = b2 + kstep;
            PG8_LDB(B0, 0, 0); PG8_LDB(B1, 0, 1); PG8_SCHED; PG8_LDA(At, 0, 0); PG8_STAGE(PG8_SA(1, 1), a1 + hstep, voffA);
            PG8_WAIT_V(8); PG8_WAIT_L(0); PG8_BAR; PG8_MMA(0, 0, At, B0); PG8_MMA(0, 1, At, B1); PG8_BAR; PG8_SCHED;
            PG8_LDA(At, 0, 1); PG8_STAGE(PG8_SB(0, 0), b2, voffB); PG8_STAGE(PG8_SB(0, 1), b2 + hstep, voffB); PG8_STAGE(PG8_SA(0, 0), a2, voffA);
            PG8_WAIT_V(8); PG8_WAIT_L(0); PG8_BAR; PG8_MMA(1, 0, At, B0); PG8_MMA(1, 1, At, B1); PG8_BAR; PG8_SCHED;
            PG8_LDB(B0, 1, 0); PG8_LDB(B1, 1, 1); PG8_SCHED; PG8_LDA(At, 1, 0); PG8_STAGE(PG8_SA(0, 1), a2 + hstep, voffA);
            PG8_WAIT_V(8); PG8_WAIT_L(0); PG8_BAR; PG8_MMA(0, 0, At, B0); PG8_MMA(0, 1, At, B1); PG8_BAR; PG8_SCHED;
            PG8_LDA(At, 1, 1); PG8_STAGE(PG8_SB(1, 0), b3, voffB); PG8_STAGE(PG8_SB(1, 1), b3 + hstep, voffB); PG8_STAGE(PG8_SA(1, 0), a3, voffA);
            PG8_WAIT_V(8); PG8_WAIT_L(0); PG8_BAR; PG8_MMA(1, 0, At, B0); PG8_MMA(1, 1, At, B1); PG8_BAR; PG8_SCHED;
        }
        if (wr == 0) PG8_BAR;
        E(acc, cur, wr, wc, fr, fq);
        if (!has_next) break;
#pragma unroll
        for (int a = 0; a < 2; ++a)
#pragma unroll
            for (int b = 0; b < 2; ++b)
#pragma unroll
                for (int m = 0; m < 4; ++m)
#pragma unroll
                    for (int n = 0; n < 2; ++n) acc[a][b][m][n] = (f32x4){0.f, 0.f, 0.f, 0.f};
        cur = nxt; cA = nA; cB = nB; ++ui;
        if (wr == 1) PG8_BAR;
    }
    PG8_WAIT_V(0);
    PG8_BAR;
#undef PG8_SA
#undef PG8_SB
#undef PG8_STAGE
#undef PG8_LDA
#undef PG8_LDB
#undef PG8_MMA
#undef PG8_WAIT_V
#undef PG8_WAIT_L
#undef PG8_BAR
#undef PG8_SCHED
}
}

#ifndef ATT_SD1_FROM
#define ATT_SD1_FROM 128
#endif
namespace att {
constexpr int NW = 8, QBLK = 32, KVBLK = 64;
constexpr float THR = 8.f;
constexpr int SHM_V = KVBLK * 128 * 2;
#define SBAR() __builtin_amdgcn_sched_barrier(0)
__device__ __forceinline__ int crow(int r, int hi) { return (r & 3) + 8 * (r >> 2) + 4 * hi; }
template <int DQK> __device__ __forceinline__ constexpr float scale_of() { return DQK == 64 ? 0.125f : (DQK == 128 ? 0.088388347648318440f : 0.072168783648703220f); }

template <int DQK>
__device__ __forceinline__ void partialSM(f32x16& p0, f32x16& p1, float& m_reg, float& mn, float& alpha) {
    constexpr float SCALE = scale_of<DQK>();
    constexpr float C = SCALE * 1.4426950408889634f;
    float pmax = p0[0];
#pragma unroll
    for (int r = 1; r < 16; ++r) pmax = fmaxf(pmax, p0[r]);
#pragma unroll
    for (int r = 0; r < 16; ++r) pmax = fmaxf(pmax, p1[r]);
    { auto rr = __builtin_amdgcn_permlane32_swap(__float_as_uint(pmax), __float_as_uint(pmax), false, false);
      pmax = fmaxf(__uint_as_float(rr[0]), __uint_as_float(rr[1])); }
    if (__builtin_expect(__all(pmax - m_reg <= THR / SCALE), 1)) { mn = m_reg; alpha = 1.f; }
    else { mn = fmaxf(m_reg, pmax); alpha = __builtin_amdgcn_exp2f((m_reg - mn) * C); m_reg = mn; }
    float mnC = -mn * C;
#pragma unroll
    for (int r = 0; r < 16; ++r) p0[r] = fmaf(p0[r], C, mnC);
#pragma unroll
    for (int r = 0; r < 16; ++r) p1[r] = fmaf(p1[r], C, mnC);
#pragma unroll
    for (int r = 0; r < 16; ++r) p0[r] = __builtin_amdgcn_exp2f(p0[r]);
}
__device__ __forceinline__ void finishSM(f32x16& p0, f32x16& p1, float alpha, float& l_reg, bf16x8& pa0, bf16x8& pa1, bf16x8& pa2, bf16x8& pa3) {
#pragma unroll
    for (int r = 0; r < 16; ++r) p1[r] = __builtin_amdgcn_exp2f(p1[r]);
    float ps = 0;
#pragma unroll
    for (int r = 0; r < 16; ++r) ps += p0[r];
#pragma unroll
    for (int r = 0; r < 16; ++r) ps += p1[r];
    { auto rr = __builtin_amdgcn_permlane32_swap(__float_as_uint(ps), __float_as_uint(ps), false, false);
      ps = __uint_as_float(rr[0]) + __uint_as_float(rr[1]); }
    l_reg = l_reg * alpha + ps;
#define PK4(P, BASE, OUT) do { unsigned a0 = cvt_pk_bf16(P[BASE + 0], P[BASE + 1]), a1 = cvt_pk_bf16(P[BASE + 2], P[BASE + 3]);   \
    unsigned b0 = cvt_pk_bf16(P[BASE + 4], P[BASE + 5]), b1 = cvt_pk_bf16(P[BASE + 6], P[BASE + 7]);                              \
    auto r0 = __builtin_amdgcn_permlane32_swap(a0, b0, false, false); auto r1 = __builtin_amdgcn_permlane32_swap(a1, b1, false, false); \
    u32x4 w = {r0[0], r1[0], r0[1], r1[1]}; OUT = *reinterpret_cast<bf16x8*>(&w); } while (0)
    PK4(p0, 0, pa0); PK4(p0, 8, pa1); PK4(p1, 0, pa2); PK4(p1, 8, pa3);
#undef PK4
}
template <int DQK>
__device__ __forceinline__ void qkt(f32x16& p0, f32x16& p1, const char* Ks, const bf16x8* qr, int r32, int hi) {
    p0 = f32x16{}; p1 = f32x16{};
#pragma unroll
    for (int d0 = 0; d0 < DQK / 16; ++d0) { const int cb = (d0 * 16 + hi * 8) * 2;
        bf16x8 b0 = *reinterpret_cast<const bf16x8*>(Ks + r32 * (DQK * 2) + (cb ^ ((r32 & 7) << 4)));
        bf16x8 b1 = *reinterpret_cast<const bf16x8*>(Ks + (32 + r32) * (DQK * 2) + (cb ^ ((r32 & 7) << 4)));
        p0 = __builtin_amdgcn_mfma_f32_32x32x16_bf16(b0, qr[d0], p0, 0, 0, 0);
        p1 = __builtin_amdgcn_mfma_f32_32x32x16_bf16(b1, qr[d0], p1, 0, 0, 0); }
}
__device__ __forceinline__ int v_st(int k, int c) { const int kk = (k & ~0xC) | ((k & 4) << 1) | ((k & 8) >> 1); return ((kk >> 3) * 4 + (c >> 5)) * 512 + ((kk & 7) * 32 + (c & 31)) * 2; }
__device__ __forceinline__ int v_rd_base(int lane) { return ((lane & 3) << 3) | (((lane >> 2) & 3) << 6) | (((lane >> 4) & 1) << 5) | (((lane >> 5) & 1) << 8); }
constexpr int v_rd_off(int d0, int ks, int half) { return d0 * 512 + ks * 4096 + half * 2048; }
template <int OFF> __device__ __forceinline__ s16x4 tr_read(int vb) {
    s16x4 r; asm volatile("ds_read_b64_tr_b16 %0, %1 offset:%2" : "=&v"(r) : "v"(vb), "i"(OFF) : "memory"); return r;
}
template <int D0> __device__ __forceinline__ void pv_one(f32x16& od, int vb, bf16x8 pa0, bf16x8 pa1, bf16x8 pa2, bf16x8 pa3) {
    const s16x4 l0 = tr_read<v_rd_off(D0, 0, 0)>(vb), h0 = tr_read<v_rd_off(D0, 0, 1)>(vb), l1 = tr_read<v_rd_off(D0, 1, 0)>(vb), h1 = tr_read<v_rd_off(D0, 1, 1)>(vb);
    const s16x4 l2 = tr_read<v_rd_off(D0, 2, 0)>(vb), h2 = tr_read<v_rd_off(D0, 2, 1)>(vb), l3 = tr_read<v_rd_off(D0, 3, 0)>(vb), h3 = tr_read<v_rd_off(D0, 3, 1)>(vb);
    asm volatile("s_waitcnt lgkmcnt(0)" ::: "memory"); SBAR();
#define PK(L, H) (bf16x8){L[0], L[1], L[2], L[3], H[0], H[1], H[2], H[3]}
    od = __builtin_amdgcn_mfma_f32_32x32x16_bf16(pa0, PK(l0, h0), od, 0, 0, 0);
    od = __builtin_amdgcn_mfma_f32_32x32x16_bf16(pa1, PK(l1, h1), od, 0, 0, 0);
    od = __builtin_amdgcn_mfma_f32_32x32x16_bf16(pa2, PK(l2, h2), od, 0, 0, 0);
    od = __builtin_amdgcn_mfma_f32_32x32x16_bf16(pa3, PK(l3, h3), od, 0, 0, 0);
#undef PK
}
__device__ __forceinline__ void pv_d0(f32x16* o, int vb, bf16x8 pa0, bf16x8 pa1, bf16x8 pa2, bf16x8 pa3) {
    pv_one<0>(o[0], vb, pa0, pa1, pa2, pa3); pv_one<1>(o[1], vb, pa0, pa1, pa2, pa3); pv_one<2>(o[2], vb, pa0, pa1, pa2, pa3); pv_one<3>(o[3], vb, pa0, pa1, pa2, pa3);
}

template <int DQK, int ldq, int ldk, int ldv, int ldo>
__device__ __forceinline__ void attn_body(const bf16_t* __restrict__ Qb, const bf16_t* __restrict__ Kh, const bf16_t* __restrict__ Vh,
                                          bf16_t* __restrict__ Ob, int seq, char* lds) {
    constexpr int SHM_K = KVBLK * DQK * 2, NKC = DQK / 64, SD = (DQK >= ATT_SD1_FROM) ? 1 : 2, CPR = DQK / 8;
    int tid_ = threadIdx.x; asm volatile("" : "+v"(tid_));
    const int tid = tid_, wid = tid >> 6, lane = tid & 63, r32 = lane & 31, hi = lane >> 5;
    char* V_lds = lds; char* K_lds = lds + 2 * SHM_V;
    float* ws = (float*)(lds + 2 * SHM_V + 2 * SHM_K) + wid * 64; float* li_l = ws; float* al_l = ws + 32;
    float m_reg = -1e30f, l_reg = 0; f32x16 o[4] = {}; bf16x8 qr[DQK / 16];
    const bf16_t* Qw = Qb + (long)(wid * QBLK + r32) * ldq + hi * 8;
#pragma unroll
    for (int d0 = 0; d0 < DQK / 16; ++d0) qr[d0] = *reinterpret_cast<const bf16x8*>(Qw + d0 * 16);
    const int sr = tid >> 4, sc = (tid & 15) * 8, vst0 = v_st(sr, sc), vst1 = v_st(32 + sr, sc);
    unsigned koff[NKC]; int kdst[NKC];
    const unsigned voffV0 = (unsigned)(sr * ldv + sc) * 2u, voffV1 = (unsigned)((32 + sr) * ldv + sc) * 2u;
#pragma unroll
    for (int kc = 0; kc < NKC; ++kc) { const int ci = tid + 512 * kc; const int krow = ci / CPR, kcol = (ci % CPR) * 8; koff[kc] = (unsigned)(krow * ldk + kcol) * 2u;
        kdst[kc] = krow * (DQK * 2) + ((kcol * 2) ^ ((krow & 7) << 4)); }
    const int vb0 = (int)(uintptr_t)V_lds + v_rd_base(lane);
    struct { bf16x8 vs0, vs1, ks[NKC]; } sr_[SD];
#define SLOAD(i, k0) do { const char* vb_ = (const char*)Vh + (size_t)(k0) * (ldv * 2); const char* kb_ = (const char*)Kh + (size_t)(k0) * (ldk * 2); \
    sr_[i].vs0 = *reinterpret_cast<const bf16x8*>(vb_ + voffV0); sr_[i].vs1 = *reinterpret_cast<const bf16x8*>(vb_ + voffV1); \
    _Pragma("unroll") for (int kc_ = 0; kc_ < NKC; ++kc_) sr_[i].ks[kc_] = *reinterpret_cast<const bf16x8*>(kb_ + koff[kc_]); } while (0)
#define SWRITE(b, i) do { *(bf16x8*)(V_lds + (b) * SHM_V + vst0) = sr_[i].vs0; *(bf16x8*)(V_lds + (b) * SHM_V + vst1) = sr_[i].vs1; \
    _Pragma("unroll") for (int kc_ = 0; kc_ < NKC; ++kc_) *(bf16x8*)(K_lds + (b) * SHM_K + kdst[kc_]) = sr_[i].ks[kc_]; } while (0)
#define SWAIT() do { if constexpr (SD == 2) asm volatile("s_waitcnt vmcnt(%0)" :: "n"(2 + NKC) : "memory"); else asm volatile("s_waitcnt vmcnt(0)" ::: "memory"); } while (0)
#define RESC(a) do { if (__any((a) < 1.f)) { if (hi == 0) al_l[r32] = (a); asm volatile("s_waitcnt lgkmcnt(0)" ::: "memory"); \
    _Pragma("unroll") for (int d = 0; d < 4; ++d) _Pragma("unroll") for (int r = 0; r < 16; ++r) o[d][r] *= al_l[crow(r, hi)]; } } while (0)
    f32x16 pA0, pA1, pB0, pB1; float mnA, mnB, alA, alB; bf16x8 pa0, pa1, pa2, pa3; const int NT = seq / KVBLK;
    constexpr int SE = 0, SO = SD - 1;
    SLOAD(SE, 0); asm volatile("s_waitcnt vmcnt(0)" ::: "memory"); SWRITE(0, SE); __syncthreads();
    qkt<DQK>(pA0, pA1, K_lds, qr, r32, hi); partialSM<DQK>(pA0, pA1, m_reg, mnA, alA);
    SLOAD(SO, KVBLK); if constexpr (SD == 2) { if (2 < NT) SLOAD(SE, 2 * KVBLK); }
    SWAIT(); SWRITE(1, SO); __syncthreads();
    for (int j = 1; j + 1 < NT; j += 2) {
        SBAR(); qkt<DQK>(pB0, pB1, K_lds + SHM_K, qr, r32, hi);
        finishSM(pA0, pA1, alA, l_reg, pa0, pa1, pa2, pa3); SBAR();
        SLOAD(SO, (j + SD) * KVBLK); SBAR();
        pv_d0(o, vb0, pa0, pa1, pa2, pa3); partialSM<DQK>(pB0, pB1, m_reg, mnB, alB);
        __syncthreads(); SWAIT(); SWRITE(0, SE);
        RESC(alB); __syncthreads();
        SBAR(); qkt<DQK>(pA0, pA1, K_lds, qr, r32, hi);
        finishSM(pB0, pB1, alB, l_reg, pa0, pa1, pa2, pa3); SBAR();
        if (SD == 1 || j + 3 < NT) SLOAD(SE, (j + 1 + SD) * KVBLK); SBAR();
        pv_d0(o, vb0 + (int)SHM_V, pa0, pa1, pa2, pa3); partialSM<DQK>(pA0, pA1, m_reg, mnA, alA);
        __syncthreads(); SWAIT(); SWRITE(1, SO);
        RESC(alA); __syncthreads();
    }
    SBAR(); qkt<DQK>(pB0, pB1, K_lds + SHM_K, qr, r32, hi);
    finishSM(pA0, pA1, alA, l_reg, pa0, pa1, pa2, pa3); SBAR();
    pv_d0(o, vb0, pa0, pa1, pa2, pa3); partialSM<DQK>(pB0, pB1, m_reg, mnB, alB);
    __syncthreads(); RESC(alB);
    finishSM(pB0, pB1, alB, l_reg, pa0, pa1, pa2, pa3); SBAR();
    pv_d0(o, vb0 + (int)SHM_V, pa0, pa1, pa2, pa3);
    if (hi == 0) li_l[r32] = l_reg; asm volatile("s_waitcnt lgkmcnt(0)" ::: "memory");
    float rli[16];
#pragma unroll
    for (int r = 0; r < 16; ++r) rli[r] = __builtin_amdgcn_rcpf(li_l[crow(r, hi)]);
    bf16_t* Ow = Ob + (long)(wid * QBLK) * ldo;
#pragma unroll
    for (int r = 0; r < 16; ++r) { const int orow = crow(r, hi);
#pragma unroll
        for (int d0 = 0; d0 < 4; ++d0) Ow[(long)orow * ldo + d0 * 32 + r32] = f2bf(o[d0][r] * rli[r]); }
    __syncthreads();
#undef SLOAD
#undef SWRITE
#undef SWAIT
#undef RESC
}

template <int DQK, int ldq, int ldk, int ldv, int ldo>
__device__ __forceinline__ void attn_body_simple(const bf16_t* __restrict__ Qb, const bf16_t* __restrict__ Kh, const bf16_t* __restrict__ Vh,
                                                 bf16_t* __restrict__ Ob, int seq, char* lds) {
    constexpr int SHM_K = KVBLK * DQK * 2, NKC = DQK / 64, CPR = DQK / 8;
    int tid_ = threadIdx.x; asm volatile("" : "+v"(tid_));
    const int tid = tid_, wid = tid >> 6, lane = tid & 63, r32 = lane & 31, hi = lane >> 5;
    char* V_lds = lds; char* K_lds = lds + 2 * SHM_V;
    float* ws = (float*)(lds + 2 * SHM_V + 2 * SHM_K) + wid * 64; float* li_l = ws; float* al_l = ws + 32;
    float m_reg = -1e30f, l_reg = 0; f32x16 o[4] = {}; bf16x8 qr[DQK / 16];
    const bf16_t* Qw = Qb + (long)(wid * QBLK + r32) * ldq + hi * 8;
#pragma unroll
    for (int d0 = 0; d0 < DQK / 16; ++d0) qr[d0] = *reinterpret_cast<const bf16x8*>(Qw + d0 * 16);
    const int sr = tid >> 4, sc = (tid & 15) * 8, vst0 = v_st(sr, sc), vst1 = v_st(32 + sr, sc);
    unsigned koff[NKC]; int kdst[NKC];
    const unsigned voffV0 = (unsigned)(sr * ldv + sc) * 2u, voffV1 = (unsigned)((32 + sr) * ldv + sc) * 2u;
#pragma unroll
    for (int kc = 0; kc < NKC; ++kc) { const int ci = tid + 512 * kc; const int krow = ci / CPR, kcol = (ci % CPR) * 8; koff[kc] = (unsigned)(krow * ldk + kcol) * 2u;
        kdst[kc] = krow * (DQK * 2) + ((kcol * 2) ^ ((krow & 7) << 4)); }
    const int vb0 = (int)(uintptr_t)V_lds + v_rd_base(lane);
    bf16x8 vs0, vs1, ks[NKC];
#define SLOAD1(k0) do { const char* vb_ = (const char*)Vh + (size_t)(k0) * (ldv * 2); const char* kb_ = (const char*)Kh + (size_t)(k0) * (ldk * 2); \
    vs0 = *reinterpret_cast<const bf16x8*>(vb_ + voffV0); vs1 = *reinterpret_cast<const bf16x8*>(vb_ + voffV1); \
    _Pragma("unroll") for (int kc_ = 0; kc_ < NKC; ++kc_) ks[kc_] = *reinterpret_cast<const bf16x8*>(kb_ + koff[kc_]); } while (0)
#define SWRITE1(b) do { *(bf16x8*)(V_lds + (b) * SHM_V + vst0) = vs0; *(bf16x8*)(V_lds + (b) * SHM_V + vst1) = vs1; \
    _Pragma("unroll") for (int kc_ = 0; kc_ < NKC; ++kc_) *(bf16x8*)(K_lds + (b) * SHM_K + kdst[kc_]) = ks[kc_]; } while (0)
    f32x16 pA0, pA1; float mnA, alA; bf16x8 pa0, pa1, pa2, pa3; const int NT = seq / KVBLK;
    SLOAD1(0); asm volatile("s_waitcnt vmcnt(0)" ::: "memory"); SWRITE1(0); __syncthreads();
    for (int j = 0; j < NT; ++j) {
        const int buf = j & 1;
        if (j + 1 < NT) SLOAD1((j + 1) * KVBLK);
        SBAR();
        qkt<DQK>(pA0, pA1, K_lds + buf * SHM_K, qr, r32, hi);
        partialSM<DQK>(pA0, pA1, m_reg, mnA, alA);
        if (__any(alA < 1.f)) { if (hi == 0) al_l[r32] = alA; asm volatile("s_waitcnt lgkmcnt(0)" ::: "memory");
#pragma unroll
            for (int d = 0; d < 4; ++d)
#pragma unroll
                for (int r = 0; r < 16; ++r) o[d][r] *= al_l[crow(r, hi)]; }
        finishSM(pA0, pA1, alA, l_reg, pa0, pa1, pa2, pa3); SBAR();
        pv_d0(o, vb0 + buf * (int)SHM_V, pa0, pa1, pa2, pa3);
        if (j + 1 < NT) { asm volatile("s_waitcnt vmcnt(0)" ::: "memory"); SWRITE1(buf ^ 1); }
        __syncthreads();
    }
    if (hi == 0) li_l[r32] = l_reg; asm volatile("s_waitcnt lgkmcnt(0)" ::: "memory");
    float rli[16];
#pragma unroll
    for (int r = 0; r < 16; ++r) rli[r] = __builtin_amdgcn_rcpf(li_l[crow(r, hi)]);
    bf16_t* Ow = Ob + (long)(wid * QBLK) * ldo;
#pragma unroll
    for (int r = 0; r < 16; ++r) { const int orow = crow(r, hi);
#pragma unroll
        for (int d0 = 0; d0 < 4; ++d0) Ow[(long)orow * ldo + d0 * 32 + r32] = f2bf(o[d0][r] * rli[r]); }
    __syncthreads();
#undef SLOAD1
#undef SWRITE1
}
}

__device__ __forceinline__ unsigned pk2(float lo, float hi) { return cvt_pk_bf16(lo, hi); }

__device__ __forceinline__ void transpose_mat(const float* W, int K, int Nsrc, bf16_t* WT, int Ndst, int mode, LAS float* scr, int gw, int NGW, int lane) {
    const int nblk = Ndst / 32, nitems = (K / 64) * nblk;
    for (int item = gw; item < nitems; item += NGW) {
        const int kb = item / nblk, nb = item % nblk, k0 = 64 * kb, n0 = 32 * nb;
        int s0 = n0;
        if (mode == 1) s0 = n0 < 3520 ? n0 : (n0 < 3584 ? -1 : n0 - 64);
        if (mode == 2) { const int pn = n0 >> 8, j = n0 & 255; s0 = j < 128 ? 128 * pn + j : DFF + 128 * pn + (j - 128); }
#pragma unroll 8
        for (int i = 0; i < 32; ++i) { const int kk = 2 * i + (lane >> 5); scr[kk * 33 + (lane & 31)] = s0 < 0 ? 0.f : W[(size_t)(k0 + kk) * Nsrc + s0 + (lane & 31)]; }
        asm volatile("s_waitcnt lgkmcnt(0)" ::: "memory");
        const int c = lane & 7;
#pragma unroll
        for (int j = 0; j < 4; ++j) { const int n = (lane >> 3) + 8 * j; const LAS float* s = scr + (8 * c) * 33 + n;
            u32x4 o; o.x = pk2(s[0 * 33], s[1 * 33]); o.y = pk2(s[2 * 33], s[3 * 33]); o.z = pk2(s[4 * 33], s[5 * 33]); o.w = pk2(s[6 * 33], s[7 * 33]);
            *(u32x4*)(WT + (size_t)(n0 + n) * K + k0 + 8 * c) = o; }
        asm volatile("s_waitcnt lgkmcnt(0)" ::: "memory");
    }
}

__device__ __forceinline__ void ph_prologue(const Params& p, LAS unsigned char* lds) {
    const int tid = otid(), wave = tid >> 6, lane = tid & 63;
    const int gw = obid() * 8 + wave, NGW = gridDim.x * 8;
    LAS float* scr = (LAS float*)(lds + wave * 16384);
    for (int l = 0; l < 2; ++l) {
        bf16_t* Wl = (bf16_t*)(p.ws + WS_W + l * W_LAYER_B);
        transpose_mat(p.in[7] + (size_t)l * 1024 * 7616, 1024, 7616, Wl + W_IN, 7680, 1, scr, gw, NGW, lane);
        transpose_mat(p.in[26] + (size_t)l * 256 * 768, 256, 768, Wl + W_UQ, 768, 0, scr, gw, NGW, lane);
        transpose_mat(p.in[27] + (size_t)l * 128 * 1024, 128, 1024, Wl + W_UKV, 1024, 0, scr, gw, NGW, lane);
        transpose_mat(p.in[16] + (size_t)l * 512 * 512, 512, 512, Wl + W_GLU, 512, 0, scr, gw, NGW, lane);
        for (int n = 0; n < 4; ++n) transpose_mat(p.in[30] + ((size_t)l * 4 + n) * 512 * 1024, 512, 1024, Wl + W_BR + (size_t)n * 1024 * 512, 1024, 0, scr, gw, NGW, lane);
        transpose_mat(p.in[31] + (size_t)l * 1024 * 1024, 1024, 1024, Wl + W_OUT, 1024, 0, scr, gw, NGW, lane);
        transpose_mat(p.in[33] + (size_t)l * 1024 * 5632, 1024, 5632, Wl + W_FI, 5632, 2, scr, gw, NGW, lane);
        transpose_mat(p.in[34] + (size_t)l * 2816 * 1024, 2816, 1024, Wl + W_FO, 1024, 0, scr, gw, NGW, lane);
    }
    __syncthreads();
    LAS float* sc = (LAS float*)lds;
    LAS float* part = (LAS float*)(lds + 32768);
    float* MOD = (float*)(p.ws + WS_MOD);
    for (int it = obid(); it < 2 * 96; it += gridDim.x) {
        const int l = it / 96, cb = it % 96;
        for (int idx = tid; idx < 5 * 1024; idx += 512) { const int mi = idx >> 10, k = idx & 1023; const float v = mi < 4 ? p.in[1][mi * 1024 + k] : p.in[3][k]; sc[idx] = v / (1.f + __expf(-v)); }
        __syncthreads();
        const int j = cb * 64 + lane; const float* wm = p.in[4] + (size_t)l * 1024 * MODW + j;
        float a0 = 0, a1 = 0, a2 = 0, a3 = 0, a4 = 0;
#pragma unroll 8
        for (int kk = 0; kk < 128; ++kk) { const int k = wave * 128 + kk; const float w = wm[(size_t)k * MODW];
            a0 += sc[k] * w; a1 += sc[1024 + k] * w; a2 += sc[2048 + k] * w; a3 += sc[3072 + k] * w; a4 += sc[4096 + k] * w; }
        part[(wave * 5 + 0) * 64 + lane] = a0; part[(wave * 5 + 1) * 64 + lane] = a1; part[(wave * 5 + 2) * 64 + lane] = a2; part[(wave * 5 + 3) * 64 + lane] = a3; part[(wave * 5 + 4) * 64 + lane] = a4;
        __syncthreads();
        if (tid < 320) { const int mi = tid >> 6, jj = tid & 63; float s = 0;
#pragma unroll
            for (int w = 0; w < 8; ++w) s += part[(w * 5 + mi) * 64 + jj];
            MOD[((size_t)l * 5 + mi) * MODW + cb * 64 + jj] = s + p.in[5][l * MODW + cb * 64 + jj]; }
        __syncthreads();
    }
}

__device__ __forceinline__ const float* row_src(int R, const float* xl, const float* xc, int& mi) {
    const int b = R / RB, s = R - b * RB;
    if (s < CTX) { mi = 4; return xc + ((size_t)b * CTX + s) * DM; }
    mi = b; return xl + ((size_t)b * SEQ + (s - CTX)) * DM;
}
__device__ __forceinline__ void ph_norm_mod(const float* xl, const float* xc, const float* gain, const float* modl, int sh_chunk, bf16_t* H) {
    const int tid = otid(); const int lane = tid & 63, gw = obid() * 8 + (tid >> 6), NGW = gridDim.x * 8;
    for (int R = gw; R < MTOT; R += NGW) {
        int mi; const float* xr = row_src(R, xl, xc, mi);
        const float* shp = modl + (size_t)mi * MODW + sh_chunk * 1024; const float* scp = shp + 1024;
        f32x4 v[4]; float ss = 0.f;
#pragma unroll
        for (int j = 0; j < 4; ++j) { v[j] = *(const f32x4*)(xr + j * 256 + lane * 4); ss += (v[j].x * v[j].x + v[j].y * v[j].y) + (v[j].z * v[j].z + v[j].w * v[j].w); }
        const float rs = rsqrtf(wave_sum(ss) * (1.f / DM) + EPS);
#pragma unroll
        for (int j = 0; j < 4; ++j) { const int c = j * 256 + lane * 4;
            const f32x4 g = *(const f32x4*)(gain + c), sh = *(const f32x4*)(shp + c), sc = *(const f32x4*)(scp + c);
            const f32x4 y = (v[j] * rs * g) * (sc + 1.0f) + sh;
            u32x2 w; w.x = cvt_pk_bf16(y.x, y.y); w.y = cvt_pk_bf16(y.z, y.w);
            *(u32x2*)(H + (size_t)R * DM + c) = w; }
    }
}

__device__ __forceinline__ int s5_pos(int i, int dir) { return dir == 0 ? i : (i < CTX ? (CTX - 1 - i) : (RB + CTX - 1 - i)); }
__device__ __forceinline__ void s5_chain(const Params& p, int layer, int unit, LAS unsigned char* lds) {
    const int b = unit >> 6, dir = (unit >> 5) & 1, g = unit & 31;
    const int tid = otid(), wid = tid >> 6, lane = tid & 63, fr = lane & 15, quad = lane >> 4;
    LAS float* BU = (LAS float*)lds;
    LAS bf16_t* Hb = (LAS bf16_t*)(lds + 32768);
    const int ldg = ((layer * 2 + dir) * 32 + g);
    const float* lam_re = p.in[8] + (size_t)ldg * 64; const float* lam_im = p.in[9] + (size_t)ldg * 64;
    const float dt = expf(p.in[10][ldg]);
    const float* bre = p.in[11] + (size_t)ldg * 64 * 16; const float* bim = p.in[12] + (size_t)ldg * 64 * 16;
    const float* cre = p.in[13] + (size_t)ldg * 16 * 64; const float* cim = p.in[14] + (size_t)ldg * 16 * 64;
    const bf16_t* U = (const bf16_t*)(p.ws + WS_G + S_U) + (size_t)b * RB * 512 + g * 16;
    bf16_t* Y = (bf16_t*)(p.ws + WS_G + (dir == 0 ? S_YF : S_YR)) + (size_t)b * RB * 512 + g * 16;
    bf16x8 bop = {0, 0, 0, 0, 0, 0, 0, 0};
    {
        const int pst = (wid & 3) * 16 + fr; const float lr = lam_re[pst], li = lam_im[pst];
        const float mag = expf(lr * dt); const float abr = mag * cosf(li * dt), abi = mag * sinf(li * dt);
        const float den = lr * lr + li * li, nr = abr - 1.f, ni = abi;
        const float cr = (nr * lr + ni * li) / den, ci = (ni * lr - nr * li) / den;
        if (quad < 2) {
#pragma unroll
            for (int j = 0; j < 8; ++j) { const int c = quad * 8 + j; const float br_ = bre[pst * 16 + c], bi_ = bim[pst * 16 + c];
                const float v = (wid < 4) ? cr * br_ - ci * bi_ : cr * bi_ + ci * br_; bop[j] = (short)f2bf(v); }
        }
    }
    float ar, ai, hr = 0.f, hi = 0.f;
    { const float lr = lam_re[lane], li = lam_im[lane]; const float mag = expf(lr * dt); ar = mag * cosf(li * dt); ai = mag * sinf(li * dt); }
    bf16x8 cop[4];
#pragma unroll
    for (int ks = 0; ks < 4; ++ks)
#pragma unroll
        for (int j = 0; j < 8; ++j) { const int k = ks * 32 + quad * 8 + j; const float v = k < 64 ? cre[fr * 64 + k] : -cim[fr * 64 + (k - 64)]; cop[ks][j] = (short)f2bf(v); }

    for (int chunk = 0; chunk < RB / 64; ++chunk) {
#pragma unroll
        for (int rb = 0; rb < 4; ++rb) {
            const int s = s5_pos(chunk * 64 + rb * 16 + fr, dir);
            bf16x8 aop = {0, 0, 0, 0, 0, 0, 0, 0};
            if (quad < 2) aop = *(const bf16x8*)(U + (size_t)s * 512 + quad * 8);
            f32x4 acc = {0.f, 0.f, 0.f, 0.f};
            acc = __builtin_amdgcn_mfma_f32_16x16x32_bf16(aop, bop, acc, 0, 0, 0);
#pragma unroll
            for (int j = 0; j < 4; ++j) BU[(rb * 16 + quad * 4 + j) * 128 + wid * 16 + fr] = acc[j];
        }
        __syncthreads();
        if (wid == 0) {
#pragma unroll 8
            for (int i = 0; i < 64; ++i) {
                const float br_ = BU[i * 128 + lane], bi_ = BU[i * 128 + 64 + lane];
                const float nr = fmaf(ar, hr, fmaf(-ai, hi, br_)), ni = fmaf(ar, hi, fmaf(ai, hr, bi_));
                hr = nr; hi = ni;
                Hb[i * 136 + lane] = f2bf(hr); Hb[i * 136 + 64 + lane] = f2bf(hi);
            }
        }
        __syncthreads();
        if (wid < 4) {
            f32x4 acc = {0.f, 0.f, 0.f, 0.f};
#pragma unroll
            for (int ks = 0; ks < 4; ++ks) { const bf16x8 aop = *(const LAS bf16x8*)(Hb + (wid * 16 + fr) * 136 + ks * 32 + quad * 8);
                acc = __builtin_amdgcn_mfma_f32_16x16x32_bf16(aop, cop[ks], acc, 0, 0, 0); }
#pragma unroll
            for (int j = 0; j < 4; ++j) { const int s = s5_pos(chunk * 64 + wid * 16 + quad * 4 + j, dir); Y[(size_t)s * 512 + fr] = f2bf(acc[j]); }
        }
    }
    __syncthreads();
}

__device__ __forceinline__ void ph_s5_gelu(const Params& p, int layer) {
    bf16_t* U = (bf16_t*)(p.ws + WS_G + S_U); const bf16_t* YF = (const bf16_t*)(p.ws + WS_G + S_YF); const bf16_t* YR = (const bf16_t*)(p.ws + WS_G + S_YR);
    const float* d = p.in[15] + layer * 512;
    const size_t n8 = (size_t)MTOT * 512 / 8;
    const int tid = otid();
    for (size_t i = (size_t)obid() * 512 + tid; i < n8; i += (size_t)gridDim.x * 512) {
        const int c = (int)(i & 63) * 8;
        const u32x4 u = *(const u32x4*)(U + i * 8), yf = *(const u32x4*)(YF + i * 8), yr = *(const u32x4*)(YR + i * 8);
        float o[8];
#pragma unroll
        for (int e = 0; e < 4; ++e) {
            const float y0 = d[c + 2 * e] * bflo(u[e]) + bflo(yf[e]) + bflo(yr[e]);
            const float y1 = d[c + 2 * e + 1] * bfhi(u[e]) + bfhi(yf[e]) + bfhi(yr[e]);
            o[2 * e] = y0 * sigmoidf_(1.5957691216057308f * (y0 + 0.044715f * y0 * y0 * y0));
            o[2 * e + 1] = y1 * sigmoidf_(1.5957691216057308f * (y1 + 0.044715f * y1 * y1 * y1));
        }
        u32x4 w; w.x = cvt_pk_bf16(o[0], o[1]); w.y = cvt_pk_bf16(o[2], o[3]); w.z = cvt_pk_bf16(o[4], o[5]); w.w = cvt_pk_bf16(o[6], o[7]);
        *(u32x4*)(U + i * 8) = w;
    }
}

template <int CW>
__device__ __forceinline__ void norm_seg(const bf16_t* in, bf16_t* out, int ncols, const float* gain, bool rope, int t, int lane) {
    for (int c0 = 0; c0 < ncols; c0 += 128) {
        const bool valid = c0 + 2 * lane < ncols;
        const unsigned w = valid ? *(const unsigned*)(in + c0 + 2 * lane) : 0u;
        const float x0 = bflo(w), x1 = bfhi(w);
        float ss = x0 * x0 + x1 * x1;
        ss = (CW == 64) ? half_sum(ss) : wave_sum(ss);
        const float rs = rsqrtf(ss * (1.f / CW) + EPS);
        const int e = (2 * lane) % CW;
        float y0 = x0 * rs * gain[e], y1 = x1 * rs * gain[e + 1];
        if (rope) {
            const int pi = e >> 1, q = CW / 4; const int k = pi < q ? pi : pi - q; const float pos = pi < q ? (float)(t >> 6) : (float)(t & 63);
            const float inv = exp2f(-(float)(4 * k) * (13.287712379549449f / CW)); const float ang = pos * inv; const float cs = cosf(ang), sn = sinf(ang);
            const float r0 = y0 * cs - y1 * sn, r1 = y0 * sn + y1 * cs; y0 = r0; y1 = r1;
        }
        if (valid) *(unsigned*)(out + c0 + 2 * lane) = cvt_pk_bf16(y0, y1);
    }
}
__device__ __forceinline__ void ph_prep1(const Params& p, int layer) {
    const int tid = otid(); const int lane = tid & 63, gw = obid() * 8 + (tid >> 6), NGW = gridDim.x * 8;
    bf16_t* Z = (bf16_t*)(p.ws + WS_G + G_Z); bf16_t* CQ = (bf16_t*)(p.ws + WS_G + G_CQ); bf16_t* CKV = (bf16_t*)(p.ws + WS_G + G_CKV);
    const float* daq = p.in[18] + layer * 64; const float* dak = p.in[19] + layer * 64; const float* gqq = p.in[22] + layer * 128; const float* gqk = p.in[23] + layer * 128;
    const float* cqn = p.in[24] + layer * 256; const float* ckvn = p.in[25] + layer * 128; const float* mlk = p.in[29] + layer * 192;
    for (int r = gw; r < RB; r += NGW) {
        bf16_t* z = Z + (size_t)r * ZW; const bool lat = r >= CTX; const int t = r - CTX;
        norm_seg<64>(z + Z_DAQ, z + Z_DAQ, 512, daq, lat, t, lane);
        norm_seg<64>(z + Z_DAK, z + Z_DAK, 512, dak, lat, t, lane);
        norm_seg<128>(z + Z_GQQ, z + Z_GQQ, 512, gqq, lat, t, lane);
        norm_seg<128>(z + Z_GQK, z + Z_GQK, 256, gqk, lat, t, lane);
        norm_seg<128>(z + Z_CKV, CKV + (size_t)r * 128, 128, ckvn, false, 0, lane);
        norm_seg<64>(z + Z_KR, z + Z_KR, 64, mlk + 128, lat, t, lane);
        {
            const u32x2 w = *(const u32x2*)(z + Z_CQ + 4 * lane);
            const float x0 = bflo(w.x), x1 = bfhi(w.x), x2 = bflo(w.y), x3 = bfhi(w.y);
            const float rs = rsqrtf(wave_sum(x0 * x0 + x1 * x1 + x2 * x2 + x3 * x3) * (1.f / 256) + EPS);
            const f32x4 g = *(const f32x4*)(cqn + 4 * lane);
            u32x2 o; o.x = cvt_pk_bf16(x0 * rs * g.x, x1 * rs * g.y); o.y = cvt_pk_bf16(x2 * rs * g.z, x3 * rs * g.w);
            *(u32x2*)(CQ + (size_t)r * 256 + 4 * lane) = o;
        }
    }
}
__device__ __forceinline__ void ph_prep2(const Params& p, int layer) {
    const int tid = otid(); const int lane = tid & 63, gw = obid() * 8 + (tid >> 6), NGW = gridDim.x * 8;
    const bf16_t* Z = (const bf16_t*)(p.ws + WS_G + G_Z); bf16_t* MLQ = (bf16_t*)(p.ws + WS_G + G_MLQ); const bf16_t* MLKV = (const bf16_t*)(p.ws + WS_G + G_MLKV); bf16_t* KF = (bf16_t*)(p.ws + WS_G + G_KF);
    const float* mlq = p.in[28] + layer * 192; const float* mlk = p.in[29] + layer * 192;
    for (int r = gw; r < RB; r += NGW) {
        const bool lat = r >= CTX; const int t = r - CTX;
        bf16_t* q = MLQ + (size_t)r * 768; const bf16_t* kv = MLKV + (size_t)r * 1024; bf16_t* kf = KF + (size_t)r * 768;
        const unsigned krw = lane < 32 ? *(const unsigned*)(Z + (size_t)r * ZW + Z_KR + 2 * lane) : 0u;
#pragma unroll
        for (int h = 0; h < 4; ++h) {
            norm_seg<128>(q + h * 192, q + h * 192, 128, mlq, false, 0, lane);
            norm_seg<64>(q + h * 192 + 128, q + h * 192 + 128, 64, mlq + 128, lat, t, lane);
            norm_seg<128>(kv + h * 256, kf + h * 192, 128, mlk, false, 0, lane);
            if (lane < 32) *(unsigned*)(kf + h * 192 + 128 + 2 * lane) = krw;
        }
    }
}
__device__ __forceinline__ void ph_subln(const Params& p, int layer) {
    const int tid = otid(); const int lane = tid & 63, gw = obid() * 8 + (tid >> 6), NGW = gridDim.x * 8;
    const bf16_t* A1 = (const bf16_t*)(p.ws + WS_G + G_A1); const bf16_t* A2 = (const bf16_t*)(p.ws + WS_G + G_A2); bf16_t* O = (bf16_t*)(p.ws + WS_G + G_BR);
    const float* lam = p.in[20] + layer * 256; const float* sub = p.in[21] + layer * 128;
    int lyr = layer; asm volatile("" : "+s"(lyr));
    const float lam_init = lyr == 0 ? 0.2f : 0.35550907f;
    const float l1 = wave_sum(lam[lane] * lam[64 + lane]), l2 = wave_sum(lam[128 + lane] * lam[192 + lane]);
    const float lam_full = expf(l1) - expf(l2) + lam_init;
    const float g0 = sub[2 * lane] * (1.f - lam_init), g1 = sub[2 * lane + 1] * (1.f - lam_init);
    for (int r = gw; r < RB; r += NGW) {
#pragma unroll
        for (int h = 0; h < 4; ++h) {
            const size_t off = (size_t)r * 512 + h * 128 + 2 * lane;
            const unsigned w1 = *(const unsigned*)(A1 + off), w2 = *(const unsigned*)(A2 + off);
            const float d0 = bflo(w1) - lam_full * bflo(w2), d1 = bfhi(w1) - lam_full * bfhi(w2);
            const float rs = rsqrtf(wave_sum(d0 * d0 + d1 * d1) * (1.f / 128) + EPS);
            *(unsigned*)(O + off) = cvt_pk_bf16(d0 * rs * g0, d1 * rs * g1);
        }
    }
}

__device__ __forceinline__ void attn_unit(const Params& p, int u, char* lds) {
    const bf16_t* Z = (const bf16_t*)(p.ws + WS_G + G_Z);
    int type, hd, qb;
    if (u < 128) { type = 0; hd = u >> 5; qb = 1 + (u & 31); }
    else if (u < 256) { type = 1; hd = (u - 128) >> 5; qb = 1 + (u & 31); }
    else if (u < 512) { type = 2; hd = (u - 256) >> 5; qb = 1 + (u & 31); }
    else { const int k = u - 512; qb = 0; if (k < 4) { type = 0; hd = k; } else if (k < 8) { type = 1; hd = k - 4; } else { type = 2; hd = k - 8; } }
    const int seq = qb == 0 ? CTX : RB; const size_t q0 = (size_t)qb * 256;
#ifndef ATT_TYPES
#define ATT_TYPES 7
#endif
    if (type == 0 && (ATT_TYPES & 1)) {
        const bf16_t* Q = (const bf16_t*)(p.ws + WS_G + G_MLQ) + q0 * 768 + hd * 192;
        const bf16_t* K = (const bf16_t*)(p.ws + WS_G + G_KF) + hd * 192;
        const bf16_t* V = (const bf16_t*)(p.ws + WS_G + G_MLKV) + hd * 256 + 128;
        bf16_t* O = (bf16_t*)(p.ws + WS_G + G_BR) + (size_t)2 * RB * 512 + q0 * 512 + hd * 128;
        att::attn_body_simple<192, 768, 768, 1024, 512>(Q, K, V, O, seq, lds);
    } else if (type == 1 && (ATT_TYPES & 2)) {
        const int kvh = hd >> 1;
        const bf16_t* Q = Z + q0 * ZW + Z_GQQ + hd * 128;
        const bf16_t* K = Z + Z_GQK + kvh * 128;
        const bf16_t* V = Z + Z_GQV + kvh * 128;
        bf16_t* O = (bf16_t*)(p.ws + WS_G + G_BR) + (size_t)1 * RB * 512 + q0 * 512 + hd * 128;
        att::attn_body<128, ZW, ZW, ZW, 512>(Q, K, V, O, seq, lds);
    } else if (type == 2 && (ATT_TYPES & 4)) {
        const int h = hd >> 1, m = hd & 1;
        const bf16_t* Q = Z + q0 * ZW + Z_DAQ + h * 128 + m * 64;
        const bf16_t* K = Z + Z_DAK + h * 128 + m * 64;
        const bf16_t* V = Z + Z_DAV + h * 128;
        bf16_t* O = (bf16_t*)(p.ws + WS_G + (m == 0 ? G_A1 : G_A2)) + q0 * 512 + h * 128;
        att::attn_body<64, ZW, ZW, ZW, 512>(Q, K, V, O, seq, lds);
    }
}
__device__ __forceinline__ void ph_attn(const Params& p, char* lds) {
    const int G = gridDim.x, c = obid();
    for (int i = 0; i < 3; ++i) {
        int u;
        if (G == 256) u = i == 0 ? c : (i == 1 ? 256 + c : ((c >= 128 && c < 144) ? 512 + (c - 128) : -1));
        else u = -1;
        if (u >= 0) attn_unit(p, u, lds);
    }
    if (G != 256) for (int u = c; u < 528; u += G) attn_unit(p, u, lds);
}

__global__ void __launch_bounds__(512, 2) mk_fwd(Params p0) {
    extern __shared__ __attribute__((aligned(16))) unsigned char lds_raw[];
    LAS unsigned char* lds = (LAS unsigned char*)lds_raw;
    cg::grid_group grid = cg::this_grid();
    const int lo = p0.lo, hi = p0.hi; int ph = 0; int layer = 0;
#ifndef PHASE_MASK
#define PHASE_MASK 0xFFFF
#endif
#define PH_BEGIN(cat) if (ph >= lo && ph < hi) { if constexpr ((PHASE_MASK >> (cat)) & 1) { const Params p = load_params(); \
    unsigned char* ws = p.ws; float* MOD = (float*)(ws + WS_MOD); float* ctxb = (float*)(ws + WS_CTXB); bf16_t* H = (bf16_t*)(ws + WS_H); bf16_t* ABR = (bf16_t*)(ws + WS_ABR); \
    const bf16_t* Wl = (const bf16_t*)(ws + WS_W + layer * W_LAYER_B); const float* modl = MOD + (size_t)layer * 5 * MODW; \
    const float* xl_in = layer == 0 ? p.in[0] : p.out; const float* xc_in = layer == 0 ? p.in[2] : ctxb; \
    (void)MOD; (void)ctxb; (void)H; (void)ABR; (void)Wl; (void)modl; (void)xl_in; (void)xc_in;
#define PH_END   } if (ph + 1 < hi) grid.sync(); } ++ph;
    const int G = gridDim.x, c = blockIdx.x;

    PH_BEGIN(0) ph_prologue(p, lds); PH_END

    for (layer = 0; layer < 2; ++layer) {

        PH_BEGIN(1) ph_norm_mod(xl_in, xc_in, p.in[6] + layer * DM, modl, 0, H); PH_END

        PH_BEGIN(2) {
            pg8::Gemm g{H, Wl + W_IN, MTOT, 512, 1024}; pg8::StaticOrder S; S.init(MTOT, 512, G, c);
            pg8::Epi<pg8::E_STORE> E{}; E.a.O = (bf16_t*)(ws + WS_G + S_U); E.a.ldc = 512;
            pg8::gemm_phase(lds, g, S, E);
        } PH_END

        PH_BEGIN(3) { for (int u = c; u < 256; u += G) s5_chain(p, layer, u, lds); } PH_END

        PH_BEGIN(4) ph_s5_gelu(p, layer); PH_END

        PH_BEGIN(9) {
            pg8::Gemm g{(const bf16_t*)(ws + WS_G + S_U), Wl + W_GLU, MTOT, 512, 512}; pg8::StaticOrder S; S.init(MTOT, 512, G, c);
            pg8::Epi<pg8::E_GLU> E{}; E.a.O = ABR; E.a.ldc = 512; E.a.G = (const bf16_t*)(ws + WS_G + S_U); E.a.ldg = 512; E.a.bias = p.in[17] + layer * 512;
            pg8::gemm_phase(lds, g, S, E);
        } PH_END

        for (int gb = 0; gb < NB; ++gb) {
            const size_t grow0 = (size_t)gb * RB;
            PH_BEGIN(10) {
                pg8::Gemm g{H + grow0 * DM, Wl + W_IN + (size_t)512 * 1024, RB, ZW, 1024}; pg8::StaticOrder S; S.init(RB, ZW, G, c);
                pg8::Epi<pg8::E_INPROJ> E{}; E.a.O = (bf16_t*)(ws + WS_G + G_Z); E.a.ldc = ZW;
                pg8::gemm_phase(lds, g, S, E);
            } PH_END

            PH_BEGIN(5) ph_prep1(p, layer); PH_END

            PH_BEGIN(11) {
                { pg8::Gemm g{(const bf16_t*)(ws + WS_G + G_CQ), Wl + W_UQ, RB, 768, 256}; pg8::StaticOrder S; S.init(RB, 768, G, c);
                  pg8::Epi<pg8::E_STORE> E{}; E.a.O = (bf16_t*)(ws + WS_G + G_MLQ); E.a.ldc = 768;
                  pg8::gemm_phase(lds, g, S, E); }
            } PH_END
            PH_BEGIN(11) {
                { pg8::Gemm g{(const bf16_t*)(ws + WS_G + G_CKV), Wl + W_UKV, RB, 1024, 128}; pg8::StaticOrder S; S.init(RB, 1024, G, c);
                  pg8::Epi<pg8::E_STORE> E{}; E.a.O = (bf16_t*)(ws + WS_G + G_MLKV); E.a.ldc = 1024;
                  pg8::gemm_phase(lds, g, S, E); }
            } PH_END

            PH_BEGIN(6) ph_prep2(p, layer); PH_END

            PH_BEGIN(7) ph_attn(p, (char*)lds_raw); PH_END

            PH_BEGIN(8) ph_subln(p, layer); PH_END

            PH_BEGIN(12) {
                const int vpm0 = gb * TPB, vpm1 = (int)((WS_G + G_BR - WS_ABR) / 262144);
                pg8::Gemm g{ABR, Wl + W_BR, RB, 1024, 512}; pg8::MergeOrder S{G, c, vpm0, vpm1};
                pg8::Epi<pg8::E_MERGE> E{}; E.a.O = H + grow0 * DM; E.a.ldc = DM; E.a.G = (const bf16_t*)(ws + WS_G + G_Z) + Z_GATE; E.a.ldg = ZW;
                E.a.MF = (float*)(ws + WS_G + G_MF); E.a.vpm0 = vpm0; E.a.vpm1 = vpm1;
                pg8::gemm_phase(lds, g, S, E);
            } PH_END
        }

        PH_BEGIN(13) {
            pg8::Gemm g{H, Wl + W_OUT, MTOT, 1024, 1024}; pg8::StaticOrder S; S.init(MTOT, 1024, G, c);
            pg8::Epi<pg8::E_RESID> E{}; E.a.xin_l = xl_in; E.a.xin_c = xc_in; E.a.xout_l = p.out; E.a.xout_c = ctxb; E.a.gate = modl + 2 * 1024;
            pg8::gemm_phase(lds, g, S, E);
        } PH_END

        PH_BEGIN(1) ph_norm_mod(p.out, ctxb, p.in[32] + layer * DM, modl, 3, H); PH_END

        PH_BEGIN(14) {
            pg8::Gemm g{H, Wl + W_FI, MTOT, 2 * DFF, 1024}; pg8::StaticOrder S; S.init(MTOT, 2 * DFF, G, c);
            pg8::Epi<pg8::E_SWIGLU> E{}; E.a.O = (bf16_t*)(ws + WS_G); E.a.ldc = DFF;
            pg8::gemm_phase(lds, g, S, E);
        } PH_END

        PH_BEGIN(15) {
            pg8::Gemm g{(const bf16_t*)(ws + WS_G), Wl + W_FO, MTOT, 1024, DFF}; pg8::StaticOrder S; S.init(MTOT, 1024, G, c);
            pg8::Epi<pg8::E_RESID> E{}; E.a.xin_l = p.out; E.a.xin_c = ctxb; E.a.xout_l = p.out; E.a.xout_c = ctxb; E.a.gate = modl + 5 * 1024;
            pg8::gemm_phase(lds, g, S, E);
        } PH_END
    }
#undef PH_BEGIN
#undef PH_END
}
constexpr int N_PHASES = 1 + 2 * (5 + 4 * 8 + 4);

extern "C" void kernel_launch(void* const* d_in, const int* in_sizes, int n_in, void* d_out, int out_size, void* d_ws, size_t ws_size, hipStream_t stream) {
    static int grid = 0;
    if (grid == 0) {
        if (n_in != 35 || out_size != NB * SEQ * DM || ws_size < WS_END) { fprintf(stderr, "kernel_launch: bad shapes: n_in %d out %d ws %zu (need %zu)\n", n_in, out_size, ws_size, (size_t)WS_END); grid = -1; return; }
        int dev = 0, cus = 0, per_cu = 0;
        (void)hipGetDevice(&dev); (void)hipDeviceGetAttribute(&cus, hipDeviceAttributeMultiprocessorCount, dev);
        if (hipFuncSetAttribute((const void*)mk_fwd, hipFuncAttributeMaxDynamicSharedMemorySize, LDS_BYTES) != hipSuccess) { fprintf(stderr, "kernel_launch: hipFuncSetAttribute failed\n"); grid = -1; return; }
        (void)hipOccupancyMaxActiveBlocksPerMultiprocessor(&per_cu, (const void*)mk_fwd, 512, LDS_BYTES);
        (void)hipGetLastError();
        if (per_cu < 1) per_cu = 1;
        grid = cus;
    }
    if (grid < 0) return;
    Params p{};
    for (int i = 0; i < 35; ++i) p.in[i] = (const float*)d_in[i];
    p.out = (float*)d_out; p.ws = (unsigned char*)d_ws;
#if MK_MODE == 0
    p.lo = 0; p.hi = N_PHASES;
    void* args[] = {&p};
    hipError_t e = hipLaunchCooperativeKernel((const void*)mk_fwd, dim3(grid), dim3(512), args, LDS_BYTES, stream);
    if (e != hipSuccess) fprintf(stderr, "cooperative launch failed: %s (grid %d)\n", hipGetErrorString(e), grid);
#else
    for (int ph = 0; ph < N_PHASES; ++ph) {
        p.lo = ph; p.hi = ph + 1;
        hipLaunchKernelGGL(mk_fwd, dim3(grid), dim3(512), LDS_BYTES, stream, p);
    }
#endif
}
```

```cpp
#include <hip/hip_runtime.h>
#include <hip/hip_cooperative_groups.h>
#include <cstdio>
#include <cstdint>
namespace cg = cooperative_groups;

#ifndef MK_MODE
#define MK_MODE 0
#endif

#define LAS __attribute__((address_space(3)))
typedef unsigned short bf16_t;
typedef short bf16x8 __attribute__((ext_vector_type(8)));
typedef short s16x4 __attribute__((ext_vector_type(4)));
typedef float f32x4 __attribute__((ext_vector_type(4)));
typedef float f32x16 __attribute__((ext_vector_type(16)));
typedef unsigned u32x4 __attribute__((ext_vector_type(4)));
typedef unsigned u32x2 __attribute__((ext_vector_type(2)));

constexpr int DM = 1024, NB = 4, SEQ = 8192, CTX = 256, RB = SEQ + CTX  , MTOT = NB * RB  ;
constexpr int TPB = RB / 256;
constexpr int ZW = 7168;
constexpr int Z_DAQ = 0, Z_DAK = 512, Z_DAV = 1024, Z_GQQ = 1536, Z_GQK = 2048, Z_GQV = 2304, Z_CQ = 2560, Z_CKV = 2816, Z_KR = 2944, Z_GATE = 3072;
constexpr int DFF = 2816, MODW = 6144;
constexpr float EPS = 1e-6f;

constexpr size_t MiB = 1u << 20;
constexpr size_t al(size_t x) { return (x + MiB - 1) / MiB * MiB; }
constexpr size_t WS_MOD = 0;
constexpr size_t WS_ROPE64 = 256 * 1024, WS_ROPE128 = WS_ROPE64 + 128 * 16 * 8;
constexpr size_t WS_BAR = 512 * 1024;
constexpr size_t WS_CTXB = al(WS_MOD + 2 * 5 * MODW * 4);
constexpr size_t WS_W = WS_CTXB + 4 * MiB;
constexpr size_t W_IN = 0, W_UQ = W_IN + (size_t)7680 * 1024, W_UKV = W_UQ + 768 * 256, W_GLU = W_UKV + 1024 * 128, W_BR = W_GLU + 512 * 512,
                 W_OUT = W_BR + (size_t)4 * 1024 * 512, W_FI = W_OUT + (size_t)1024 * 1024, W_FO = W_FI + (size_t)5632 * 1024, W_LAYER = W_FO + (size_t)1024 * 2816;
constexpr size_t W_LAYER_B = al(W_LAYER * 2);
constexpr size_t WS_H = WS_W + 2 * W_LAYER_B;
constexpr size_t WS_ABR = WS_H + al((size_t)MTOT * 1024 * 2);
constexpr size_t WS_G = WS_ABR + al((size_t)MTOT * 512 * 2);
constexpr size_t G_Z = 0;
constexpr size_t G_CQ = al(G_Z + (size_t)RB * ZW * 2);
constexpr size_t G_CKV = al(G_CQ + (size_t)RB * 256 * 2);
constexpr size_t G_MLQ = al(G_CKV + (size_t)RB * 128 * 2);
constexpr size_t G_MLKV = al(G_MLQ + (size_t)RB * 768 * 2);
constexpr size_t G_KF = al(G_MLKV + (size_t)RB * 1024 * 2);
constexpr size_t G_A1 = al(G_KF + (size_t)RB * 768 * 2);
constexpr size_t G_A2 = al(G_A1 + (size_t)RB * 512 * 2);
constexpr size_t G_BR = al(G_A2 + (size_t)RB * 512 * 2);
constexpr size_t G_MF = al(G_BR + (size_t)3 * RB * 512 * 2);
constexpr size_t G_END = al(G_MF + (size_t)RB * 1024 * 4);
constexpr size_t S_SZ = al((size_t)MTOT * 512 * 2), S_U = G_MLQ  , S_YF = S_U + S_SZ, S_YR = S_YF + S_SZ, S_END = S_YR + S_SZ;
constexpr size_t HID_B = (size_t)MTOT * DFF * 2;
static_assert(S_END <= G_END && HID_B <= G_END, "aliases fit");
constexpr size_t WS_END = WS_G + G_END;
static_assert(WS_END <= (size_t)512 * MiB, "workspace budget");
static_assert((WS_G + G_BR - WS_ABR) % 262144 == 0, "merge virtual tiles");

constexpr int LDS_BYTES = 147456;

typedef __bf16 bf16x2n __attribute__((ext_vector_type(2)));
typedef float f32x2n __attribute__((ext_vector_type(2)));
__device__ __forceinline__ unsigned cvt_pk_bf16(float lo, float hi) { f32x2n v = {lo, hi}; bf16x2n b = __builtin_convertvector(v, bf16x2n); return __builtin_bit_cast(unsigned, b); }
__device__ __forceinline__ float bf2f(unsigned v) { return __uint_as_float(v << 16); }
__device__ __forceinline__ float bflo(unsigned w) { return __uint_as_float(w << 16); }
__device__ __forceinline__ float bfhi(unsigned w) { return __uint_as_float(w & 0xffff0000u); }
__device__ __forceinline__ bf16_t f2bf(float f) { return (bf16_t)(cvt_pk_bf16(f, 0.f) & 0xffffu); }
template <int O> __device__ __forceinline__ float swz_xor(float v) { return __int_as_float(__builtin_amdgcn_ds_swizzle(__float_as_int(v), 0x1f | (O << 10))); }
__device__ __forceinline__ float half_sum(float v) {
    v += swz_xor<1>(v); v += swz_xor<2>(v); v += swz_xor<4>(v); v += swz_xor<8>(v); v += swz_xor<16>(v); return v;
}
__device__ __forceinline__ float wave_sum(float v) {
    v = half_sum(v);
    auto rr = __builtin_amdgcn_permlane32_swap(__float_as_uint(v), __float_as_uint(v), false, false);
    return __uint_as_float(rr[0]) + __uint_as_float(rr[1]);
}
__device__ __forceinline__ int otid() { int t = threadIdx.x; asm volatile("" : "+v"(t)); return t; }
__device__ __forceinline__ float sigmoidf_(float x) { return __builtin_amdgcn_rcpf(1.f + __expf(-x)); }

__device__ __forceinline__ int obid() { int b = blockIdx.x; asm volatile("" : "+s"(b)); return b; }
struct Params { const float* in[35]; float* out; unsigned char* ws; int lo, hi; };
__device__ __forceinline__ Params load_params() {
#if defined(__HIP_DEVICE_COMPILE__)
    typedef const __attribute__((address_space(4))) Params* CP;
    CP q = (CP)__builtin_amdgcn_kernarg_segment_ptr(); asm volatile("" : "+s"(q));
    Params r;
#pragma unroll
    for (int i = 0; i < 35; ++i) r.in[i] = q->in[i];
    r.out = q->out; r.ws = q->ws; r.lo = q->lo; r.hi = q->hi; return r;
#else
    return Params{};
#endif
}

namespace pg8 {
constexpr int BM = 256, BK = 64, HALF = 128, HTB = HALF * BK * 2, STAGE_BYTES = 8 * HTB, NXCD = 8, WGM = 8;
__host__ __device__ __forceinline__ int lds_byte(int r, int c) { const int st = (r >> 4) * 2 + (c >> 5), rr = r & 15, cc = c & 31, ob = rr * 64 + cc * 2; return st * 1024 + (ob ^ (((ob >> 9) & 1) << 5)); }
__host__ __device__ __forceinline__ void stage_rc(int b, int& R, int& C) { const int st = b / 1024, sb = b % 1024, swz = sb ^ (((sb >> 9) & 1) << 5); R = (st >> 1) * 16 + swz / 64; C = (st & 1) * 32 + (swz % 64) / 2; }
__host__ __device__ __forceinline__ int perm32(int rho) { const int n = rho >> 4, i = rho & 15; return 8 * (i >> 2) + 4 * n + (i & 3); }
struct Unit { int pm, pn; };
struct Gemm { const bf16_t* A; const bf16_t* Bt; int M, N, K; };
struct StaticOrder {
    int nM, nN, nwg, G, c;
    int skip;
    __device__ void init(int M, int N, int G_, int c_, int skip_ = 0) { skip = skip_; nM = skip_ ? NB * (TPB - 1) : M / BM; nN = N / BM; nwg = nM * nN; G = G_; c = c_; }
    __device__ bool next(int i, Unit& u) const {
        const long L = (long)i * G + c; if (L >= nwg) return false;
        int wgid = (int)L; { const int q = nwg / NXCD, r = nwg % NXCD, xcd = wgid % NXCD, off = wgid / NXCD; wgid = (xcd < r ? xcd * (q + 1) : r * (q + 1) + (xcd - r) * q) + off; }
        const int nig = WGM * nN, gid = wgid / nig, fm = gid * WGM, gsz = (nM - fm) < WGM ? (nM - fm) : WGM;
        u.pm = fm + ((wgid % nig) % gsz); u.pn = (wgid % nig) / gsz; if (skip) u.pm += u.pm / (TPB - 1) + 1; return true;
    }
};
struct MergeOrder {
    int G, c, vpm0, vpm1, skip;
    __device__ bool next(int i, Unit& u) const {
        const int j = i >> 2, n = i & 3; const int L = j * G + c; if (L >= (TPB - skip) * 4) return false;
        const int pm = (L >> 2) + skip, pn = L & 3; u.pm = (n == 0 ? vpm0 : vpm1 + (n - 1) * TPB) + pm; u.pn = n * 4 + pn; return true;
    }
};

enum { E_STORE = 0, E_INPROJ = 1, E_GLU = 2, E_MERGE = 3, E_RESID = 4, E_SWIGLU = 5 };
struct EpiArgs {
    bf16_t* O; int ldc;
    const bf16_t* G; int ldg;
    const float* bias;
    float* MF;
    int vpm0, vpm1;
    const float* xin_l; const float* xin_c; float* xout_l; float* xout_c; const float* gate;
};
template <int MODE> struct Epi {
    EpiArgs a;
    __device__ __forceinline__ void operator()(const f32x4 (&acc)[2][2][4][2], const Unit& u, int, int, int, int) const {
        const int t_ = otid(), wid_ = __builtin_amdgcn_readfirstlane(t_ >> 6), wr = wid_ >> 2, wc = wid_ & 3, fr = t_ & 15, fq = (t_ & 63) >> 4;
        int pm = u.pm, pn = u.pn, nbr = 0;
        if (MODE == E_MERGE) { nbr = u.pn >> 2; pn = u.pn & 3; pm = u.pm - (nbr == 0 ? a.vpm0 : a.vpm1 + (nbr - 1) * TPB); }
        const int row0 = pm * BM + wr * 64 + fr;
        const int col0 = (MODE == E_SWIGLU ? pn * 128 : pn * BM) + wc * 32 + 8 * fq;
        const float* xin = nullptr; float* xout = nullptr; const float* gv = nullptr;
        if (MODE == E_RESID) {
            const int b = pm / TPB, t = pm - b * TPB;
            if (t == 0) { xin = a.xin_c + (size_t)b * CTX * DM; xout = a.xout_c + (size_t)b * CTX * DM; gv = a.gate + 4 * MODW; }
            else { xin = a.xin_l + ((size_t)b * SEQ + (size_t)(t - 1) * 256) * DM; xout = a.xout_l + ((size_t)b * SEQ + (size_t)(t - 1) * 256) * DM; gv = a.gate + b * MODW; }
        }
        if (MODE == E_SWIGLU || MODE == E_STORE || MODE == E_INPROJ) {
#pragma unroll
            for (int ai = 0; ai < 2; ++ai)
#pragma unroll
                for (int m = 0; m < 4; ++m) {
                    const int row = row0 + ai * HALF + m * 16;
                    if (MODE == E_SWIGLU) {
                        const f32x4 g0 = acc[ai][0][m][0], g1 = acc[ai][0][m][1], u0 = acc[ai][1][m][0], u1 = acc[ai][1][m][1];
                        float h[8];
#pragma unroll
                        for (int e = 0; e < 4; ++e) { h[e] = g0[e] * sigmoidf_(g0[e]) * u0[e]; h[4 + e] = g1[e] * sigmoidf_(g1[e]) * u1[e]; }
                        u32x4 w; w.x = cvt_pk_bf16(h[0], h[1]); w.y = cvt_pk_bf16(h[2], h[3]); w.z = cvt_pk_bf16(h[4], h[5]); w.w = cvt_pk_bf16(h[6], h[7]);
                        *(u32x4*)(a.O + (size_t)row * a.ldc + col0) = w;
                        continue;
                    }
#pragma unroll
                    for (int bj = 0; bj < 2; ++bj) {
                        const int col = col0 + bj * HALF;
                        f32x4 v0 = acc[ai][bj][m][0], v1 = acc[ai][bj][m][1];
                        if (MODE == E_INPROJ && pn >= 12) {
#pragma unroll
                            for (int e = 0; e < 4; ++e) { v0[e] = sigmoidf_(v0[e]); v1[e] = sigmoidf_(v1[e]); }
                        }
                        u32x4 w; w.x = cvt_pk_bf16(v0[0], v0[1]); w.y = cvt_pk_bf16(v0[2], v0[3]); w.z = cvt_pk_bf16(v1[0], v1[1]); w.w = cvt_pk_bf16(v1[2], v1[3]);
                        *(u32x4*)(a.O + (size_t)row * a.ldc + col) = w;
                    }
                }
            return;
        }
        f32x4 gb0[2], gb1[2];
#pragma unroll
        for (int bj = 0; bj < 2; ++bj) {
            const int col = col0 + bj * HALF;
            if (MODE == E_GLU) { gb0[bj] = *(const f32x4*)(a.bias + col); gb1[bj] = *(const f32x4*)(a.bias + col + 4); }
            else if (MODE == E_RESID) { gb0[bj] = *(const f32x4*)(gv + col); gb1[bj] = *(const f32x4*)(gv + col + 4); }
            else { gb0[bj] = (f32x4){0.f, 0.f, 0.f, 0.f}; gb1[bj] = gb0[bj]; }
        }
#pragma unroll
        for (int ai = 0; ai < 2; ++ai)
#pragma unroll
            for (int mp = 0; mp < 2; ++mp) {
                u32x4 gw[2][2]; f32x4 xa[2][2], xb[2][2];
#pragma unroll
                for (int mm = 0; mm < 2; ++mm)
#pragma unroll
                    for (int bj = 0; bj < 2; ++bj) {
                        const int row = row0 + ai * HALF + (mp * 2 + mm) * 16, col = col0 + bj * HALF;
                        if (MODE == E_GLU) gw[mm][bj] = *(const u32x4*)(a.G + (size_t)row * a.ldg + col);
                        if (MODE == E_MERGE) { gw[mm][bj] = *(const u32x4*)(a.G + (size_t)row * a.ldg + nbr * 1024 + col);
                            if (nbr != 0) { const u32x4 mw = *(const u32x4*)((const bf16_t*)a.MF + (size_t)row * 1024 + col);
                                xa[mm][bj] = (f32x4){bflo(mw.x), bfhi(mw.x), bflo(mw.y), bfhi(mw.y)}; xb[mm][bj] = (f32x4){bflo(mw.z), bfhi(mw.z), bflo(mw.w), bfhi(mw.w)}; } }
                        if (MODE == E_RESID) { const int lr = row - pm * BM; xa[mm][bj] = *(const f32x4*)(xin + (size_t)lr * DM + col); xb[mm][bj] = *(const f32x4*)(xin + (size_t)lr * DM + col + 4); }
                    }
#pragma unroll
                for (int mm = 0; mm < 2; ++mm)
#pragma unroll
                    for (int bj = 0; bj < 2; ++bj) {
                        const int m = mp * 2 + mm; const int row = row0 + ai * HALF + m * 16, col = col0 + bj * HALF;
                        const f32x4 v0 = acc[ai][bj][m][0], v1 = acc[ai][bj][m][1];
                        if (MODE == E_GLU) {
                            const u32x4 g = gw[mm][bj]; const f32x4 b0 = gb0[bj], b1 = gb1[bj];
                            float o[8];
                            o[0] = bflo(g.x) * sigmoidf_(v0[0] + b0[0]); o[1] = bfhi(g.x) * sigmoidf_(v0[1] + b0[1]);
                            o[2] = bflo(g.y) * sigmoidf_(v0[2] + b0[2]); o[3] = bfhi(g.y) * sigmoidf_(v0[3] + b0[3]);
                            o[4] = bflo(g.z) * sigmoidf_(v1[0] + b1[0]); o[5] = bfhi(g.z) * sigmoidf_(v1[1] + b1[1]);
                            o[6] = bflo(g.w) * sigmoidf_(v1[2] + b1[2]); o[7] = bfhi(g.w) * sigmoidf_(v1[3] + b1[3]);
                            u32x4 w; w.x = cvt_pk_bf16(o[0], o[1]); w.y = cvt_pk_bf16(o[2], o[3]); w.z = cvt_pk_bf16(o[4], o[5]); w.w = cvt_pk_bf16(o[6], o[7]);
                            *(u32x4*)(a.O + (size_t)row * a.ldc + col) = w;
                        } else if (MODE == E_MERGE) {
                            const u32x4 g = gw[mm][bj];
                            f32x4 p0, p1;
                            p0[0] = bflo(g.x) * v0[0]; p0[1] = bfhi(g.x) * v0[1]; p0[2] = bflo(g.y) * v0[2]; p0[3] = bfhi(g.y) * v0[3];
                            p1[0] = bflo(g.z) * v1[0]; p1[1] = bfhi(g.z) * v1[1]; p1[2] = bflo(g.w) * v1[2]; p1[3] = bfhi(g.w) * v1[3];
                            if (nbr != 0) { p0 = p0 + xa[mm][bj]; p1 = p1 + xb[mm][bj]; }
                            u32x4 w; w.x = cvt_pk_bf16(p0[0], p0[1]); w.y = cvt_pk_bf16(p0[2], p0[3]); w.z = cvt_pk_bf16(p1[0], p1[1]); w.w = cvt_pk_bf16(p1[2], p1[3]);
                            if (nbr != 3) *(u32x4*)((bf16_t*)a.MF + (size_t)row * 1024 + col) = w;
                            else *(u32x4*)(a.O + (size_t)row * a.ldc + col) = w;
                        } else if (MODE == E_RESID) {
                            const int lr = row - pm * BM;
                            *(f32x4*)(xout + (size_t)lr * DM + col) = xa[mm][bj] + gb0[bj] * v0;
                            *(f32x4*)(xout + (size_t)lr * DM + col + 4) = xb[mm][bj] + gb1[bj] * v1;
                        }
                    }
            }
    }
};

template <class EpiT, class Sched>
__device__ __forceinline__ void gemm_phase(LAS unsigned char* lds, const Gemm g, const Sched& S, const EpiT& E) {
    int tid_ = threadIdx.x; asm volatile("" : "+v"(tid_));
    const int tid = tid_, wid = __builtin_amdgcn_readfirstlane(tid >> 6), lane = tid & 63, wr = wid >> 2, wc = wid & 3, fr = lane & 15, fq = lane >> 4;
    const int K = g.K, nt = K / BK;
    unsigned voffA[2], voffB[2];
#pragma unroll
    for (int i = 0; i < 2; ++i) { int R, C; stage_rc(tid * 16 + i * 8192, R, C); const int Rb = (R & ~31) + perm32(R & 31);
        voffA[i] = (unsigned)(R * K + C) * 2u; voffB[i] = (unsigned)(Rb * K + C) * 2u; }
    const size_t kstep = (size_t)(BK * 2);
    const size_t hstep = (size_t)HALF * K * 2;
    const size_t tstep = 2 * hstep;
    const unsigned ldsw = (unsigned)wid * 1024u;
    const int aoff = lds_byte(wr * 64 + fr, fq * 8), boff = lds_byte(wc * 32 + fr, fq * 8);
#define PG8_SA(b, h) (((b) * 2 + (h)) * HTB)
#define PG8_SB(b, h) ((4 + (b) * 2 + (h)) * HTB)
#define PG8_STAGE(bufoff, gbase, voff) do { _Pragma("unroll") for (int _i = 0; _i < 2; ++_i) \
        __builtin_amdgcn_global_load_lds((const unsigned*)((const char*)(gbase) + (voff)[_i]), (LAS unsigned*)(lds + (bufoff) + ldsw + _i * 8192), 16, 0, 0); } while (0)
#define PG8_LDA(dst, b, h) do { _Pragma("unroll") for (int m = 0; m < 4; ++m) _Pragma("unroll") for (int k = 0; k < 2; ++k) dst[m][k] = *(const LAS bf16x8*)(lds + PG8_SA(b, h) + aoff + m * 2048 + k * 1024); } while (0)
#define PG8_LDB(dst, b, h) do { _Pragma("unroll") for (int n = 0; n < 2; ++n) _Pragma("unroll") for (int k = 0; k < 2; ++k) dst[n][k] = *(const LAS bf16x8*)(lds + PG8_SB(b, h) + boff + n * 2048 + k * 1024); } while (0)
#define PG8_MMA(ai, bj, At, Bt) do { __builtin_amdgcn_s_setprio(1); _Pragma("unroll") for (int m = 0; m < 4; ++m) _Pragma("unroll") for (int n = 0; n < 2; ++n) _Pragma("unroll") for (int k = 0; k < 2; ++k) \
        acc[ai][bj][m][n] = __builtin_amdgcn_mfma_f32_16x16x32_bf16(Bt[n][k], At[m][k], acc[ai][bj][m][n], 0, 0, 0); __builtin_amdgcn_s_setprio(0); } while (0)
#define PG8_WAIT_V(n) asm volatile("s_waitcnt vmcnt(" #n ")" ::: "memory")
#define PG8_WAIT_L(n) asm volatile("s_waitcnt lgkmcnt(" #n ")" ::: "memory")
#define PG8_BAR __builtin_amdgcn_s_barrier()
#define PG8_SCHED __builtin_amdgcn_sched_barrier(0)
    Unit cur, nxt; int ui = 0;
    if (!S.next(0, cur)) return;
    f32x4 acc[2][2][4][2];
#pragma unroll
    for (int a = 0; a < 2; ++a)
#pragma unroll
        for (int b = 0; b < 2; ++b)
#pragma unroll
            for (int m = 0; m < 4; ++m)
#pragma unroll
                for (int n = 0; n < 2; ++n) acc[a][b][m][n] = (f32x4){0.f, 0.f, 0.f, 0.f};
    bf16x8 At[4][2], B0[2][2], B1[2][2];
    const char* cA = (const char*)g.A + (size_t)cur.pm * tstep; const char* cB = (const char*)g.Bt + (size_t)cur.pn * tstep;
    PG8_STAGE(PG8_SB(0, 0), cB, voffB); PG8_STAGE(PG8_SB(0, 1), cB + hstep, voffB); PG8_STAGE(PG8_SA(0, 0), cA, voffA); PG8_STAGE(PG8_SA(0, 1), cA + hstep, voffA);
    if (wr == 1) PG8_BAR;
    PG8_WAIT_V(2); PG8_BAR;
    PG8_STAGE(PG8_SB(1, 0), cB + kstep, voffB); PG8_STAGE(PG8_SA(1, 0), cA + kstep, voffA); PG8_STAGE(PG8_SB(1, 1), cB + hstep + kstep, voffB);
    PG8_WAIT_V(6); PG8_BAR;
    for (;;) {
        const bool has_next = S.next(ui + 1, nxt);
        const char* nA = has_next ? (const char*)g.A + (size_t)nxt.pm * tstep : cA; const char* nB = has_next ? (const char*)g.Bt + (size_t)nxt.pn * tstep : cB;
        for (int t = 0; t < nt; t += 2) {
            const bool last = (t == nt - 2);
            const char* a1 = cA + (size_t)(t + 1) * kstep;
            const char* a2 = last ? nA : cA + (size_t)(t + 2) * kstep; const char* b2 = last ? nB : cB + (size_t)(t + 2) * kstep;
            const char* a3 = a2 + kstep; const char* b3 = b2 + kstep;
            PG8_LDB(B0, 0, 0); PG8_LDB(B1, 0, 1); PG8_SCHED; PG8_LDA(At, 0, 0); PG8_STAGE(PG8_SA(1, 1), a1 + hstep, voffA);
            PG8_WAIT_V(8); PG8_WAIT_L(0); PG8_BAR; PG8_MMA(0, 0, At, B0); PG8_MMA(0, 1, At, B1); PG8_BAR; PG8_SCHED;
            PG8_LDA(At, 0, 1); PG8_STAGE(PG8_SB(0, 0), b2, voffB); PG8_STAGE(PG8_SB(0, 1), b2 + hstep, voffB); PG8_STAGE(PG8_SA(0, 0), a2, voffA);
            PG8_WAIT_V(8); PG8_WAIT_L(0); PG8_BAR; PG8_MMA(1, 0, At, B0); PG8_MMA(1, 1, At, B1); PG8_BAR; PG8_SCHED;
            PG8_LDB(B0, 1, 0); PG8_LDB(B1, 1, 1); PG8_SCHED; PG8_LDA(At, 1, 0); PG8_STAGE(PG8_SA(0, 1), a2 + hstep, voffA);
            PG8_WAIT_V(8); PG8_WAIT_L(0); PG8_BAR; PG8_MMA(0, 0, At, B0); PG8_MMA(0, 1, At, B1); PG8_BAR; PG8_SCHED;
            PG8_LDA(At, 1, 1); PG8_STAGE(PG8_SB(1, 0), b3, voffB); PG8_STAGE(PG8_SB(1, 1), b3 + hstep, voffB); PG8_STAGE(PG8_SA(1, 0), a3, voffA);
            PG8_WAIT_V(8); PG8_WAIT_L(0); PG8_BAR; PG8_MMA(1, 0, At, B0); PG8_MMA(1, 1, At, B1); PG8_BAR; PG8_SCHED;
        }
        if (wr == 0) PG8_BAR;
        E(acc, cur, wr, wc, fr, fq);
        if (!has_next) break;
#pragma unroll
        for (int a = 0; a < 2; ++a)
#pragma unroll
            for (int b = 0; b < 2; ++b)
#pragma unroll
                for (int m = 0; m < 4; ++m)
#pragma unroll
                    for (int n = 0; n < 2; ++n) acc[a][b][m][n] = (f32x4){0.f, 0.f, 0.f, 0.f};
        cur = nxt; cA = nA; cB = nB; ++ui;
        if (wr == 1) PG8_BAR;
    }
    PG8_WAIT_V(0);
    PG8_BAR;
#undef PG8_SA
#undef PG8_SB
#undef PG8_STAGE
#undef PG8_LDA
#undef PG8_LDB
#undef PG8_MMA
#undef PG8_WAIT_V
#undef PG8_WAIT_L
#undef PG8_BAR
#undef PG8_SCHED
}
}

#ifndef QKT_SB_FROM
#define QKT_SB_FROM 100000
#endif
#ifndef QKT_SB_EVERY
#define QKT_SB_EVERY 4
#endif
#ifndef ATT_SD1_FROM
#define ATT_SD1_FROM 128
#endif
namespace att {
constexpr int NW = 8, QBLK = 32, KVBLK = 64;
constexpr float THR = 8.f;
constexpr int SHM_V = KVBLK * 128 * 2;
#define SBAR() __builtin_amdgcn_sched_barrier(0)
__device__ __forceinline__ int crow(int r, int hi) { return (r & 3) + 8 * (r >> 2) + 4 * hi; }
template <int DQK> __device__ __forceinline__ constexpr float scale_of() { return DQK == 64 ? 0.125f : (DQK == 128 ? 0.088388347648318440f : 0.072168783648703220f); }

template <int DQK>
__device__ __forceinline__ void partialSM(f32x16& p0, f32x16& p1, float& m_reg, float& mn, float& alpha) {
    constexpr float SCALE = scale_of<DQK>();
    constexpr float C = SCALE * 1.4426950408889634f;
    float pmax = p0[0];
#pragma unroll
    for (int r = 1; r < 16; ++r) pmax = fmaxf(pmax, p0[r]);
#pragma unroll
    for (int r = 0; r < 16; ++r) pmax = fmaxf(pmax, p1[r]);
    { auto rr = __builtin_amdgcn_permlane32_swap(__float_as_uint(pmax), __float_as_uint(pmax), false, false);
      pmax = fmaxf(__uint_as_float(rr[0]), __uint_as_float(rr[1])); }
    if (__builtin_expect(__all(pmax - m_reg <= THR / SCALE), 1)) { mn = m_reg; alpha = 1.f; }
    else { mn = fmaxf(m_reg, pmax); alpha = __builtin_amdgcn_exp2f((m_reg - mn) * C); m_reg = mn; }
    float mnC = -mn * C;
#pragma unroll
    for (int r = 0; r < 16; ++r) p0[r] = fmaf(p0[r], C, mnC);
#pragma unroll
    for (int r = 0; r < 16; ++r) p1[r] = fmaf(p1[r], C, mnC);
#pragma unroll
    for (int r = 0; r < 16; ++r) p0[r] = __builtin_amdgcn_exp2f(p0[r]);
}
__device__ __forceinline__ void finishSM(f32x16& p0, f32x16& p1, float alpha, float& l_reg, bf16x8& pa0, bf16x8& pa1, bf16x8& pa2, bf16x8& pa3) {
#pragma unroll
    for (int r = 0; r < 16; ++r) p1[r] = __builtin_amdgcn_exp2f(p1[r]);
    float ps = 0;
#pragma unroll
    for (int r = 0; r < 16; ++r) ps += p0[r];
#pragma unroll
    for (int r = 0; r < 16; ++r) ps += p1[r];
    { auto rr = __builtin_amdgcn_permlane32_swap(__float_as_uint(ps), __float_as_uint(ps), false, false);
      ps = __uint_as_float(rr[0]) + __uint_as_float(rr[1]); }
    l_reg = l_reg * alpha + ps;
#define PK4(P, BASE, OUT) do { unsigned a0 = cvt_pk_bf16(P[BASE + 0], P[BASE + 1]), a1 = cvt_pk_bf16(P[BASE + 2], P[BASE + 3]);   \
    unsigned b0 = cvt_pk_bf16(P[BASE + 4], P[BASE + 5]), b1 = cvt_pk_bf16(P[BASE + 6], P[BASE + 7]);                              \
    auto r0 = __builtin_amdgcn_permlane32_swap(a0, b0, false, false); auto r1 = __builtin_amdgcn_permlane32_swap(a1, b1, false, false); \
    u32x4 w = {r0[0], r1[0], r0[1], r1[1]}; OUT = *reinterpret_cast<bf16x8*>(&w); } while (0)
    PK4(p0, 0, pa0); PK4(p0, 8, pa1); PK4(p1, 0, pa2); PK4(p1, 8, pa3);
#undef PK4
}
template <int DQK, int QL = 0>
__device__ __forceinline__ void qkt(f32x16& p0, f32x16& p1, const char* Ks, const bf16x8* qr, int r32, int hi, const char* Qs = nullptr) {
    p0 = f32x16{}; p1 = f32x16{};
#pragma unroll
    for (int d0 = 0; d0 < DQK / 16; ++d0) { const int cb = (d0 * 16 + hi * 8) * 2;
        bf16x8 b0 = *reinterpret_cast<const bf16x8*>(Ks + r32 * (DQK * 2) + (cb ^ ((r32 & 7) << 4)));
        bf16x8 b1 = *reinterpret_cast<const bf16x8*>(Ks + (32 + r32) * (DQK * 2) + (cb ^ ((r32 & 7) << 4)));
        bf16x8 q;
        if (d0 < DQK / 16 - QL) q = qr[d0]; else q = *reinterpret_cast<const bf16x8*>(Qs + (d0 - (DQK / 16 - QL)) * 1024);
        p0 = __builtin_amdgcn_mfma_f32_32x32x16_bf16(b0, q, p0, 0, 0, 0);
        p1 = __builtin_amdgcn_mfma_f32_32x32x16_bf16(b1, q, p1, 0, 0, 0);
        if (DQK > QKT_SB_FROM && (d0 % QKT_SB_EVERY) == QKT_SB_EVERY - 1) SBAR(); }
}
__device__ __forceinline__ int v_st(int k, int c) { const int kk = (k & ~0xC) | ((k & 4) << 1) | ((k & 8) >> 1); return ((kk >> 3) * 4 + (c >> 5)) * 512 + ((kk & 7) * 32 + (c & 31)) * 2; }
__device__ __forceinline__ int v_rd_base(int lane) { return ((lane & 3) << 3) | (((lane >> 2) & 3) << 6) | (((lane >> 4) & 1) << 5) | (((lane >> 5) & 1) << 8); }
constexpr int v_rd_off(int d0, int ks, int half) { return d0 * 512 + ks * 4096 + half * 2048; }
template <int OFF> __device__ __forceinline__ s16x4 tr_read(int vb) {
    s16x4 r; asm volatile("ds_read_b64_tr_b16 %0, %1 offset:%2" : "=&v"(r) : "v"(vb), "i"(OFF) : "memory"); return r;
}
template <int D0> __device__ __forceinline__ void pv_one(f32x16& od, int vb, bf16x8 pa0, bf16x8 pa1, bf16x8 pa2, bf16x8 pa3) {
    const s16x4 l0 = tr_read<v_rd_off(D0, 0, 0)>(vb), h0 = tr_read<v_rd_off(D0, 0, 1)>(vb), l1 = tr_read<v_rd_off(D0, 1, 0)>(vb), h1 = tr_read<v_rd_off(D0, 1, 1)>(vb);
    const s16x4 l2 = tr_read<v_rd_off(D0, 2, 0)>(vb), h2 = tr_read<v_rd_off(D0, 2, 1)>(vb), l3 = tr_read<v_rd_off(D0, 3, 0)>(vb), h3 = tr_read<v_rd_off(D0, 3, 1)>(vb);
    asm volatile("s_waitcnt lgkmcnt(0)" ::: "memory"); SBAR();
#define PK(L, H) (bf16x8){L[0], L[1], L[2], L[3], H[0], H[1], H[2], H[3]}
    od = __builtin_amdgcn_mfma_f32_32x32x16_bf16(pa0, PK(l0, h0), od, 0, 0, 0);
    od = __builtin_amdgcn_mfma_f32_32x32x16_bf16(pa1, PK(l1, h1), od, 0, 0, 0);
    od = __builtin_amdgcn_mfma_f32_32x32x16_bf16(pa2, PK(l2, h2), od, 0, 0, 0);
    od = __builtin_amdgcn_mfma_f32_32x32x16_bf16(pa3, PK(l3, h3), od, 0, 0, 0);
#undef PK
}
__device__ __forceinline__ void pv_d0(f32x16* o, int vb, bf16x8 pa0, bf16x8 pa1, bf16x8 pa2, bf16x8 pa3) {
    pv_one<0>(o[0], vb, pa0, pa1, pa2, pa3); pv_one<1>(o[1], vb, pa0, pa1, pa2, pa3); pv_one<2>(o[2], vb, pa0, pa1, pa2, pa3); pv_one<3>(o[3], vb, pa0, pa1, pa2, pa3);
}

template <int DQK, int ldq, int ldk, int ldv, int ldo, int QL = 0>
__device__ __forceinline__ void attn_body(const bf16_t* __restrict__ Qb, const bf16_t* __restrict__ Kh, const bf16_t* __restrict__ Vh,
                                          bf16_t* __restrict__ Ob, int seq, char* lds) {
    constexpr int SHM_K = KVBLK * DQK * 2, NKC = DQK / 64, SD = (DQK >= ATT_SD1_FROM) ? 1 : 2, CPR = DQK / 8;
    int tid_ = threadIdx.x; asm volatile("" : "+v"(tid_));
    const int tid = tid_, wid = tid >> 6, lane = tid & 63, r32 = lane & 31, hi = lane >> 5;
    char* V_lds = lds; char* K_lds = lds + 2 * SHM_V;
    float* ws = (float*)(lds + 2 * SHM_V + 2 * SHM_K) + wid * 64; float* li_l = ws; float* al_l = ws + 32;
    constexpr int NQR = DQK / 16 - QL;
    float m_reg = -1e30f, l_reg = 0; f32x16 o[4] = {}; bf16x8 qr[NQR];
    const bf16_t* Qw = Qb + (long)(wid * QBLK + r32) * ldq + hi * 8;
#pragma unroll
    for (int d0 = 0; d0 < NQR; ++d0) qr[d0] = *reinterpret_cast<const bf16x8*>(Qw + d0 * 16);
    char* Qs = lds + 2 * SHM_V + 2 * SHM_K + NW * 256 + wid * (QL * 1024) + lane * 16;
#pragma unroll
    for (int d0 = 0; d0 < QL; ++d0) *reinterpret_cast<bf16x8*>(Qs + d0 * 1024) = *reinterpret_cast<const bf16x8*>(Qw + (NQR + d0) * 16);
    const int sr = tid >> 4, sc = (tid & 15) * 8, vst0 = v_st(sr, sc), vst1 = v_st(32 + sr, sc);
    unsigned koff[NKC]; int kdst[NKC];
    const unsigned voffV0 = (unsigned)(sr * ldv + sc) * 2u, voffV1 = (unsigned)((32 + sr) * ldv + sc) * 2u;
#pragma unroll
    for (int kc = 0; kc < NKC; ++kc) { const int ci = tid + 512 * kc; const int krow = ci / CPR, kcol = (ci % CPR) * 8; koff[kc] = (unsigned)(krow * ldk + kcol) * 2u;
        kdst[kc] = krow * (DQK * 2) + ((kcol * 2) ^ ((krow & 7) << 4)); }
    const int vb0 = (int)(uintptr_t)V_lds + v_rd_base(lane);
    struct { bf16x8 vs0, vs1, ks[NKC]; } sr_[SD];
#define SLOAD(i, k0) do { const char* vb_ = (const char*)Vh + (size_t)(k0) * (ldv * 2); const char* kb_ = (const char*)Kh + (size_t)(k0) * (ldk * 2); \
    sr_[i].vs0 = *reinterpret_cast<const bf16x8*>(vb_ + voffV0); sr_[i].vs1 = *reinterpret_cast<const bf16x8*>(vb_ + voffV1); \
    _Pragma("unroll") for (int kc_ = 0; kc_ < NKC; ++kc_) sr_[i].ks[kc_] = *reinterpret_cast<const bf16x8*>(kb_ + koff[kc_]); } while (0)
#define SWRITE(b, i) do { *(bf16x8*)(V_lds + (b) * SHM_V + vst0) = sr_[i].vs0; *(bf16x8*)(V_lds + (b) * SHM_V + vst1) = sr_[i].vs1; \
    _Pragma("unroll") for (int kc_ = 0; kc_ < NKC; ++kc_) *(bf16x8*)(K_lds + (b) * SHM_K + kdst[kc_]) = sr_[i].ks[kc_]; } while (0)
#define SWAIT() do { if constexpr (SD == 2) asm volatile("s_waitcnt vmcnt(%0)" :: "n"(2 + NKC) : "memory"); else asm volatile("s_waitcnt vmcnt(0)" ::: "memory"); } while (0)
#define RESC(a) do { if (__any((a) < 1.f)) { if (hi == 0) al_l[r32] = (a); asm volatile("s_waitcnt lgkmcnt(0)" ::: "memory"); \
    _Pragma("unroll") for (int d = 0; d < 4; ++d) _Pragma("unroll") for (int r = 0; r < 16; ++r) o[d][r] *= al_l[crow(r, hi)]; } } while (0)
    f32x16 pA0, pA1, pB0, pB1; float mnA, mnB, alA, alB; bf16x8 pa0, pa1, pa2, pa3; const int NT = seq / KVBLK;
    constexpr int SE = 0, SO = SD - 1;
    SLOAD(SE, 0); asm volatile("s_waitcnt vmcnt(0)" ::: "memory"); SWRITE(0, SE); __syncthreads();
    qkt<DQK, QL>(pA0, pA1, K_lds, qr, r32, hi, Qs); partialSM<DQK>(pA0, pA1, m_reg, mnA, alA);
    SLOAD(SO, KVBLK); if constexpr (SD == 2) { if (2 < NT) SLOAD(SE, 2 * KVBLK); }
    SWAIT(); SWRITE(1, SO); __syncthreads();
    for (int j = 1; j + 1 < NT; j += 2) {
        SBAR(); qkt<DQK, QL>(pB0, pB1, K_lds + SHM_K, qr, r32, hi, Qs);
        finishSM(pA0, pA1, alA, l_reg, pa0, pa1, pa2, pa3); SBAR();
        SLOAD(SO, (j + SD) * KVBLK); SBAR();
        pv_d0(o, vb0, pa0, pa1, pa2, pa3); partialSM<DQK>(pB0, pB1, m_reg, mnB, alB);
        __syncthreads(); SWAIT(); SWRITE(0, SE);
        RESC(alB); __syncthreads();
        SBAR(); qkt<DQK, QL>(pA0, pA1, K_lds, qr, r32, hi, Qs);
        finishSM(pB0, pB1, alB, l_reg, pa0, pa1, pa2, pa3); SBAR();
        if (SD == 1 || j + 3 < NT) SLOAD(SE, (j + 1 + SD) * KVBLK); SBAR();
        pv_d0(o, vb0 + (int)SHM_V, pa0, pa1, pa2, pa3); partialSM<DQK>(pA0, pA1, m_reg, mnA, alA);
        __syncthreads(); SWAIT(); SWRITE(1, SO);
        RESC(alA); __syncthreads();
    }
    SBAR(); qkt<DQK, QL>(pB0, pB1, K_lds + SHM_K, qr, r32, hi, Qs);
    finishSM(pA0, pA1, alA, l_reg, pa0, pa1, pa2, pa3); SBAR();
    pv_d0(o, vb0, pa0, pa1, pa2, pa3); partialSM<DQK>(pB0, pB1, m_reg, mnB, alB);
    __syncthreads(); RESC(alB);
    finishSM(pB0, pB1, alB, l_reg, pa0, pa1, pa2, pa3); SBAR();
    pv_d0(o, vb0 + (int)SHM_V, pa0, pa1, pa2, pa3);
    if (hi == 0) li_l[r32] = l_reg; asm volatile("s_waitcnt lgkmcnt(0)" ::: "memory");
    float rli[16];
#pragma unroll
    for (int r = 0; r < 16; ++r) rli[r] = __builtin_amdgcn_rcpf(li_l[crow(r, hi)]);
    bf16_t* Ow = Ob + (long)(wid * QBLK) * ldo;
#pragma unroll
    for (int r = 0; r < 16; ++r) { const int orow = crow(r, hi);
#pragma unroll
        for (int d0 = 0; d0 < 4; ++d0) Ow[(long)orow * ldo + d0 * 32 + r32] = f2bf(o[d0][r] * rli[r]); }
    __syncthreads();
#undef SLOAD
#undef SWRITE
#undef SWAIT
#undef RESC
}

template <int DQK, int ldq, int ldk, int ldv, int ldo>
__device__ __forceinline__ void attn_body_simple(const bf16_t* __restrict__ Qb, const bf16_t* __restrict__ Kh, const bf16_t* __restrict__ Vh,
                                                 bf16_t* __restrict__ Ob, int seq, char* lds) {
    constexpr int SHM_K = KVBLK * DQK * 2, NKC = DQK / 64, CPR = DQK / 8;
    int tid_ = threadIdx.x; asm volatile("" : "+v"(tid_));
    const int tid = tid_, wid = tid >> 6, lane = tid & 63, r32 = lane & 31, hi = lane >> 5;
    char* V_lds = lds; char* K_lds = lds + 2 * SHM_V;
    float* ws = (float*)(lds + 2 * SHM_V + 2 * SHM_K) + wid * 64; float* li_l = ws; float* al_l = ws + 32;
    float m_reg = -1e30f, l_reg = 0; f32x16 o[4] = {}; bf16x8 qr[DQK / 16];
    const bf16_t* Qw = Qb + (long)(wid * QBLK + r32) * ldq + hi * 8;
#pragma unroll
    for (int d0 = 0; d0 < DQK / 16; ++d0) qr[d0] = *reinterpret_cast<const bf16x8*>(Qw + d0 * 16);
    const int sr = tid >> 4, sc = (tid & 15) * 8, vst0 = v_st(sr, sc), vst1 = v_st(32 + sr, sc);
    unsigned koff[NKC]; int kdst[NKC];
    const unsigned voffV0 = (unsigned)(sr * ldv + sc) * 2u, voffV1 = (unsigned)((32 + sr) * ldv + sc) * 2u;
#pragma unroll
    for (int kc = 0; kc < NKC; ++kc) { const int ci = tid + 512 * kc; const int krow = ci / CPR, kcol = (ci % CPR) * 8; koff[kc] = (unsigned)(krow * ldk + kcol) * 2u;
        kdst[kc] = krow * (DQK * 2) + ((kcol * 2) ^ ((krow & 7) << 4)); }
    const int vb0 = (int)(uintptr_t)V_lds + v_rd_base(lane);
    bf16x8 vs0, vs1, ks[NKC];
#define SLOAD1(k0) do { const char* vb_ = (const char*)Vh + (size_t)(k0) * (ldv * 2); const char* kb_ = (const char*)Kh + (size_t)(k0) * (ldk * 2); \
    vs0 = *reinterpret_cast<const bf16x8*>(vb_ + voffV0); vs1 = *reinterpret_cast<const bf16x8*>(vb_ + voffV1); \
    _Pragma("unroll") for (int kc_ = 0; kc_ < NKC; ++kc_) ks[kc_] = *reinterpret_cast<const bf16x8*>(kb_ + koff[kc_]); } while (0)
#define SWRITE1(b) do { *(bf16x8*)(V_lds + (b) * SHM_V + vst0) = vs0; *(bf16x8*)(V_lds + (b) * SHM_V + vst1) = vs1; \
    _Pragma("unroll") for (int kc_ = 0; kc_ < NKC; ++kc_) *(bf16x8*)(K_lds + (b) * SHM_K + kdst[kc_]) = ks[kc_]; } while (0)
    f32x16 pA0, pA1; float mnA, alA; bf16x8 pa0, pa1, pa2, pa3; const int NT = seq / KVBLK;
    SLOAD1(0); asm volatile("s_waitcnt vmcnt(0)" ::: "memory"); SWRITE1(0); __syncthreads();
    for (int j = 0; j < NT; ++j) {
        const int buf = j & 1;
        if (j + 1 < NT) SLOAD1((j + 1) * KVBLK);
        SBAR();
        qkt<DQK>(pA0, pA1, K_lds + buf * SHM_K, qr, r32, hi);
        partialSM<DQK>(pA0, pA1, m_reg, mnA, alA);
        if (__any(alA < 1.f)) { if (hi == 0) al_l[r32] = alA; asm volatile("s_waitcnt lgkmcnt(0)" ::: "memory");
#pragma unroll
            for (int d = 0; d < 4; ++d)
#pragma unroll
                for (int r = 0; r < 16; ++r) o[d][r] *= al_l[crow(r, hi)]; }
        finishSM(pA0, pA1, alA, l_reg, pa0, pa1, pa2, pa3); SBAR();
        pv_d0(o, vb0 + buf * (int)SHM_V, pa0, pa1, pa2, pa3);
        if (j + 1 < NT) { asm volatile("s_waitcnt vmcnt(0)" ::: "memory"); SWRITE1(buf ^ 1); }
        __syncthreads();
    }
    if (hi == 0) li_l[r32] = l_reg; asm volatile("s_waitcnt lgkmcnt(0)" ::: "memory");
    float rli[16];
#pragma unroll
    for (int r = 0; r < 16; ++r) rli[r] = __builtin_amdgcn_rcpf(li_l[crow(r, hi)]);
    bf16_t* Ow = Ob + (long)(wid * QBLK) * ldo;
#pragma unroll
    for (int r = 0; r < 16; ++r) { const int orow = crow(r, hi);
#pragma unroll
        for (int d0 = 0; d0 < 4; ++d0) Ow[(long)orow * ldo + d0 * 32 + r32] = f2bf(o[d0][r] * rli[r]); }
    __syncthreads();
#undef SLOAD1
#undef SWRITE1
}
}

__device__ __forceinline__ unsigned pk2(float lo, float hi) { return cvt_pk_bf16(lo, hi); }

__device__ __forceinline__ void transpose_mat(const float* W, int K, int Nsrc, bf16_t* WT, int Ndst, int mode, LAS float* scr, int gw, int NGW, int lane) {
    const int nblk = Ndst / 32, nitems = (K / 64) * nblk;
    for (int item = gw; item < nitems; item += NGW) {
        const int kb = item / nblk, nb = item % nblk, k0 = 64 * kb, n0 = 32 * nb;
        int s0 = n0;
        if (mode == 1) s0 = n0 < 3520 ? n0 : (n0 < 3584 ? -1 : n0 - 64);
        if (mode == 2) { const int pn = n0 >> 8, j = n0 & 255; s0 = j < 128 ? 128 * pn + j : DFF + 128 * pn + (j - 128); }
        float wv[32];
#pragma unroll
        for (int i = 0; i < 32; ++i) { const int kk = 2 * i + (lane >> 5); wv[i] = s0 < 0 ? 0.f : W[(size_t)(k0 + kk) * Nsrc + s0 + (lane & 31)]; }
#pragma unroll
        for (int i = 0; i < 32; ++i) { const int kk = 2 * i + (lane >> 5); scr[kk * 33 + (lane & 31)] = wv[i]; }
        asm volatile("s_waitcnt lgkmcnt(0)" ::: "memory");
        const int c = lane & 7;
#pragma unroll
        for (int j = 0; j < 4; ++j) { const int n = (lane >> 3) + 8 * j; const LAS float* s = scr + (8 * c) * 33 + n;
            u32x4 o; o.x = pk2(s[0 * 33], s[1 * 33]); o.y = pk2(s[2 * 33], s[3 * 33]); o.z = pk2(s[4 * 33], s[5 * 33]); o.w = pk2(s[6 * 33], s[7 * 33]);
            *(u32x4*)(WT + (size_t)(n0 + n) * K + k0 + 8 * c) = o; }
        asm volatile("s_waitcnt lgkmcnt(0)" ::: "memory");
    }
}

__device__ __forceinline__ void ph_prologue(const Params& p, LAS unsigned char* lds) {
    const int tid = otid(), wave = tid >> 6, lane = tid & 63;
    const int gw = obid() * 8 + wave, NGW = gridDim.x * 8;
    LAS float* scr = (LAS float*)(lds + wave * 16384);
    for (int l = 0; l < 2; ++l) {
        bf16_t* Wl = (bf16_t*)(p.ws + WS_W + l * W_LAYER_B);
        transpose_mat(p.in[7] + (size_t)l * 1024 * 7616, 1024, 7616, Wl + W_IN, 7680, 1, scr, gw, NGW, lane);
        transpose_mat(p.in[26] + (size_t)l * 256 * 768, 256, 768, Wl + W_UQ, 768, 0, scr, gw, NGW, lane);
        transpose_mat(p.in[27] + (size_t)l * 128 * 1024, 128, 1024, Wl + W_UKV, 1024, 0, scr, gw, NGW, lane);
        transpose_mat(p.in[16] + (size_t)l * 512 * 512, 512, 512, Wl + W_GLU, 512, 0, scr, gw, NGW, lane);
        for (int n = 0; n < 4; ++n) transpose_mat(p.in[30] + ((size_t)l * 4 + n) * 512 * 1024, 512, 1024, Wl + W_BR + (size_t)n * 1024 * 512, 1024, 0, scr, gw, NGW, lane);
        transpose_mat(p.in[31] + (size_t)l * 1024 * 1024, 1024, 1024, Wl + W_OUT, 1024, 0, scr, gw, NGW, lane);
        transpose_mat(p.in[33] + (size_t)l * 1024 * 5632, 1024, 5632, Wl + W_FI, 5632, 2, scr, gw, NGW, lane);
        transpose_mat(p.in[34] + (size_t)l * 2816 * 1024, 2816, 1024, Wl + W_FO, 1024, 0, scr, gw, NGW, lane);
    }
    {
        typedef float f32x2t __attribute__((ext_vector_type(2)));
        f32x2t* T64 = (f32x2t*)(p.ws + WS_ROPE64); f32x2t* T128 = (f32x2t*)(p.ws + WS_ROPE128);
        for (int idx = obid() * 512 + tid; idx < 128 * 16 + 128 * 32; idx += gridDim.x * 512) {
            if (idx < 128 * 16) { const int pos = idx >> 4, k = idx & 15; const float ang = (float)pos * exp2f(-(float)(4 * k) * (13.287712379549449f / 64)); T64[idx] = (f32x2t){cosf(ang), sinf(ang)}; }
            else { const int i2 = idx - 128 * 16, pos = i2 >> 5, k = i2 & 31; const float ang = (float)pos * exp2f(-(float)(4 * k) * (13.287712379549449f / 128)); T128[i2] = (f32x2t){cosf(ang), sinf(ang)}; }
        }
    }
    __syncthreads();
    LAS float* sc = (LAS float*)lds;
    LAS float* part = (LAS float*)(lds + 32768);
    float* MOD = (float*)(p.ws + WS_MOD);
    for (int it = obid(); it < 2 * 96; it += gridDim.x) {
        const int l = it / 96, cb = it % 96;
        for (int idx = tid; idx < 5 * 1024; idx += 512) { const int mi = idx >> 10, k = idx & 1023; const float v = mi < 4 ? p.in[1][mi * 1024 + k] : p.in[3][k]; sc[idx] = v / (1.f + __expf(-v)); }
        __syncthreads();
        const int j = cb * 64 + lane; const float* wm = p.in[4] + (size_t)l * 1024 * MODW + j;
        float a0 = 0, a1 = 0, a2 = 0, a3 = 0, a4 = 0;
#pragma unroll 32
        for (int kk = 0; kk < 128; ++kk) { const int k = wave * 128 + kk; const float w = wm[(size_t)k * MODW];
            a0 += sc[k] * w; a1 += sc[1024 + k] * w; a2 += sc[2048 + k] * w; a3 += sc[3072 + k] * w; a4 += sc[4096 + k] * w; }
        part[(wave * 5 + 0) * 64 + lane] = a0; part[(wave * 5 + 1) * 64 + lane] = a1; part[(wave * 5 + 2) * 64 + lane] = a2; part[(wave * 5 + 3) * 64 + lane] = a3; part[(wave * 5 + 4) * 64 + lane] = a4;
        __syncthreads();
        if (tid < 320) { const int mi = tid >> 6, jj = tid & 63; float s = 0;
#pragma unroll
            for (int w = 0; w < 8; ++w) s += part[(w * 5 + mi) * 64 + jj];
            MOD[((size_t)l * 5 + mi) * MODW + cb * 64 + jj] = s + p.in[5][l * MODW + cb * 64 + jj]; }
        __syncthreads();
    }
}

__device__ __forceinline__ const float* row_src(int R, const float* xl, const float* xc, int& mi) {
    const int b = R / RB, s = R - b * RB;
    if (s < CTX) { mi = 4; return xc + ((size_t)b * CTX + s) * DM; }
    mi = b; return xl + ((size_t)b * SEQ + (s - CTX)) * DM;
}
__device__ __forceinline__ void nm_finish(const f32x4 (&v)[4], int R, int mi, int lane, const float* gain, const float* modl, int sh_chunk, bf16_t* H) {
    const float* shp = modl + (size_t)mi * MODW + sh_chunk * 1024; const float* scp = shp + 1024;
    float ss = 0.f;
#pragma unroll
    for (int j = 0; j < 4; ++j) ss += (v[j].x * v[j].x + v[j].y * v[j].y) + (v[j].z * v[j].z + v[j].w * v[j].w);
    const float rs = rsqrtf(wave_sum(ss) * (1.f / DM) + EPS);
#pragma unroll
    for (int j = 0; j < 4; ++j) { const int c = j * 256 + lane * 4;
        const f32x4 g = *(const f32x4*)(gain + c), sh = *(const f32x4*)(shp + c), sc = *(const f32x4*)(scp + c);
        const f32x4 y = (v[j] * rs * g) * (sc + 1.0f) + sh;
        u32x2 w; w.x = cvt_pk_bf16(y.x, y.y); w.y = cvt_pk_bf16(y.z, y.w);
        *(u32x2*)(H + (size_t)R * DM + c) = w; }
}
__device__ __forceinline__ void ph_norm_mod(const float* xl, const float* xc, const float* gain, const float* modl, int sh_chunk, bf16_t* H) {
    const int tid = otid(); const int lane = tid & 63, gw = obid() * 8 + (tid >> 6), NGW = gridDim.x * 8;
    for (int R = gw; R < MTOT; R += 2 * NGW) {
        const int R2 = R + NGW; const bool has2 = R2 < MTOT;
        int mi, mi2 = 0; const float* xr = row_src(R, xl, xc, mi); const float* xr2 = has2 ? row_src(R2, xl, xc, mi2) : xr;
        f32x4 v[4], v2[4];
#pragma unroll
        for (int j = 0; j < 4; ++j) v[j] = *(const f32x4*)(xr + j * 256 + lane * 4);
#pragma unroll
        for (int j = 0; j < 4; ++j) v2[j] = *(const f32x4*)(xr2 + j * 256 + lane * 4);
        nm_finish(v, R, mi, lane, gain, modl, sh_chunk, H);
        if (has2) nm_finish(v2, R2, mi2, lane, gain, modl, sh_chunk, H);
    }
}

__device__ __forceinline__ int s5_pos(int i, int dir) { return dir == 0 ? i : (i < CTX ? (CTX - 1 - i) : (RB + CTX - 1 - i)); }
__device__ __forceinline__ void s5_chain(const Params& p, int layer, int unit, LAS unsigned char* lds) {
    const int b = unit >> 6, dir = (unit >> 5) & 1, g = unit & 31;
    const int tid = otid(), wid = tid >> 6, lane = tid & 63, fr = lane & 15, quad = lane >> 4;
    LAS float* BU = (LAS float*)lds;
    LAS bf16_t* Hb = (LAS bf16_t*)(lds + 65536);
    const int ldg = ((layer * 2 + dir) * 32 + g);
    const float* lam_re = p.in[8] + (size_t)ldg * 64; const float* lam_im = p.in[9] + (size_t)ldg * 64;
    const float dt = expf(p.in[10][ldg]);
    const float* bre = p.in[11] + (size_t)ldg * 64 * 16; const float* bim = p.in[12] + (size_t)ldg * 64 * 16;
    const float* cre = p.in[13] + (size_t)ldg * 16 * 64; const float* cim = p.in[14] + (size_t)ldg * 16 * 64;
    const bf16_t* U = (const bf16_t*)(p.ws + WS_G + S_U) + (size_t)b * RB * 512 + g * 16;
    bf16_t* Y = (bf16_t*)(p.ws + WS_G + (dir == 0 ? S_YF : S_YR)) + ((size_t)g * MTOT + (size_t)b * RB) * 16;
    const int cb0 = (wid & 3) * 2;
    bf16x8 bop[2] = {{0, 0, 0, 0, 0, 0, 0, 0}, {0, 0, 0, 0, 0, 0, 0, 0}};
#pragma unroll
    for (int t = 0; t < 2; ++t) {
        const int cb = cb0 + t, pst = (cb & 3) * 16 + fr; const float lr = lam_re[pst], li = lam_im[pst];
        const float mag = expf(lr * dt); const float abr = mag * cosf(li * dt), abi = mag * sinf(li * dt);
        const float den = lr * lr + li * li, nr = abr - 1.f, ni = abi;
        const float cr = (nr * lr + ni * li) / den, ci = (ni * lr - nr * li) / den;
        if (quad < 2) {
#pragma unroll
            for (int j = 0; j < 8; ++j) { const int c = quad * 8 + j; const float br_ = bre[pst * 16 + c], bi_ = bim[pst * 16 + c];
                const float v = (cb < 4) ? cr * br_ - ci * bi_ : cr * bi_ + ci * br_; bop[t][j] = (short)f2bf(v); }
        }
    }
    float ar, ai, hr = 0.f, hi = 0.f;
    { const float lr = lam_re[lane], li = lam_im[lane]; const float mag = expf(lr * dt); ar = mag * cosf(li * dt); ai = mag * sinf(li * dt); }
    bf16x8 cop[4];
#pragma unroll
    for (int ks = 0; ks < 4; ++ks)
#pragma unroll
        for (int j = 0; j < 8; ++j) { const int k = ks * 32 + quad * 8 + j; const float v = (k & 1) ? -cim[fr * 64 + (k >> 1)] : cre[fr * 64 + (k >> 1)]; cop[ks][j] = (short)f2bf(v); }
#define S5_LD(chunk, A_) do { _Pragma("unroll") for (int rb = 0; rb < 4; ++rb) { const int s_ = s5_pos((chunk) * 64 + rb * 16 + fr, dir); \
        A_[rb] = (bf16x8){0, 0, 0, 0, 0, 0, 0, 0}; if (quad < 2) A_[rb] = *(const bf16x8*)(U + (size_t)s_ * 512 + quad * 8); } } while (0)
#define S5_MM(A_, BUb) do { _Pragma("unroll") for (int rb = 0; rb < 4; ++rb) { \
        _Pragma("unroll") for (int t = 0; t < 2; ++t) { f32x4 acc = {0.f, 0.f, 0.f, 0.f}; acc = __builtin_amdgcn_mfma_f32_16x16x32_bf16(A_[rb], bop[t], acc, 0, 0, 0); \
            _Pragma("unroll") for (int j = 0; j < 4; ++j) (BUb)[(rb * 16 + quad * 4 + j) * 128 + (cb0 + t) * 16 + fr] = acc[j]; } } } while (0)
#define S5_C(chunk, Hbb, rb) do { f32x4 acc = {0.f, 0.f, 0.f, 0.f}; \
        _Pragma("unroll") for (int ks = 0; ks < 4; ++ks) { const bf16x8 aop = *(const LAS bf16x8*)((Hbb) + ((rb) * 16 + fr) * 136 + ks * 32 + quad * 8); \
            acc = __builtin_amdgcn_mfma_f32_16x16x32_bf16(aop, cop[ks], acc, 0, 0, 0); } \
        _Pragma("unroll") for (int j = 0; j < 4; ++j) { const int s_ = s5_pos((chunk) * 64 + (rb) * 16 + quad * 4 + j, dir); Y[(size_t)s_ * 16 + fr] = f2bf(acc[j]); } } while (0)
    constexpr int NCH = RB / 64;
    bf16x8 ua[4], ub[4];
    if (wid >= 4) { S5_LD(0, ua); S5_MM(ua, BU); S5_LD(1, ua); }
    __syncthreads();
    for (int k = 0; k < NCH; ++k) {
        LAS float* BUc = BU + (k & 1) * 8192; LAS bf16_t* Hbc = Hb + (k & 1) * (64 * 136);
        if (wid == 0) {
#pragma unroll
            for (int hf = 0; hf < 2; ++hf) {
                float brv[32], biv[32];
#pragma unroll
                for (int i = 0; i < 32; ++i) { brv[i] = BUc[(hf * 32 + i) * 128 + lane]; biv[i] = BUc[(hf * 32 + i) * 128 + 64 + lane]; }
#pragma unroll
                for (int i = 0; i < 32; ++i) {
                    const float nr = fmaf(ar, hr, fmaf(-ai, hi, brv[i])), ni = fmaf(ar, hi, fmaf(ai, hr, biv[i]));
                    hr = nr; hi = ni;
                    *(LAS unsigned*)(Hbc + (hf * 32 + i) * 136 + 2 * lane) = cvt_pk_bf16(hr, hi);
                }
            }
        } else if (wid >= 4) {
            if (k + 1 < NCH) { LAS float* BUn = BU + ((k + 1) & 1) * 8192;
                if (k + 2 < NCH) S5_LD(k + 2, ub);
                S5_MM(ua, BUn);
#pragma unroll
                for (int rb = 0; rb < 4; ++rb) ua[rb] = ub[rb]; }
        } else if (k > 0) {
            LAS bf16_t* Hbp = Hb + ((k - 1) & 1) * (64 * 136);
            S5_C(k - 1, Hbp, wid - 1);
            if (wid == 1) S5_C(k - 1, Hbp, 3);
        }
        __syncthreads();
    }
    if (wid >= 1 && wid < 4) { LAS bf16_t* Hbp = Hb + ((NCH - 1) & 1) * (64 * 136); S5_C(NCH - 1, Hbp, wid - 1); if (wid == 1) S5_C(NCH - 1, Hbp, 3); }
    __syncthreads();
#undef S5_LD
#undef S5_MM
#undef S5_C
}

__device__ __forceinline__ u32x4 gelu8(const u32x4 u, const u32x4 yf, const u32x4 yr, const float* d, int c) {
    float o[8];
#pragma unroll
    for (int e = 0; e < 4; ++e) {
        const float y0 = d[c + 2 * e] * bflo(u[e]) + bflo(yf[e]) + bflo(yr[e]);
        const float y1 = d[c + 2 * e + 1] * bfhi(u[e]) + bfhi(yf[e]) + bfhi(yr[e]);
        o[2 * e] = y0 * sigmoidf_(1.5957691216057308f * (y0 + 0.044715f * y0 * y0 * y0));
        o[2 * e + 1] = y1 * sigmoidf_(1.5957691216057308f * (y1 + 0.044715f * y1 * y1 * y1));
    }
    u32x4 w; w.x = cvt_pk_bf16(o[0], o[1]); w.y = cvt_pk_bf16(o[2], o[3]); w.z = cvt_pk_bf16(o[4], o[5]); w.w = cvt_pk_bf16(o[6], o[7]);
    return w;
}
__device__ __forceinline__ void ph_s5_gelu(const Params& p, int layer) {
    bf16_t* U = (bf16_t*)(p.ws + WS_G + S_U); const bf16_t* YF = (const bf16_t*)(p.ws + WS_G + S_YF); const bf16_t* YR = (const bf16_t*)(p.ws + WS_G + S_YR);
    const float* d = p.in[15] + layer * 512;
    const size_t n8 = (size_t)MTOT * 512 / 8, stride = (size_t)gridDim.x * 512;
    const int tid = otid();
    for (size_t i = (size_t)obid() * 512 + tid; i < n8; i += 2 * stride) {
        const size_t i2 = i + stride; const bool has2 = i2 < n8; const size_t ib = has2 ? i2 : i;
        const int c = (int)(i & 63) * 8, c2 = (int)(ib & 63) * 8;
        const size_t yo = ((size_t)(c >> 4) * MTOT + (i >> 6)) * 16 + (c & 15), yo2 = ((size_t)(c2 >> 4) * MTOT + (ib >> 6)) * 16 + (c2 & 15);
        const u32x4 u = *(const u32x4*)(U + i * 8), yf = *(const u32x4*)(YF + yo), yr = *(const u32x4*)(YR + yo);
        const u32x4 ub = *(const u32x4*)(U + ib * 8), yfb = *(const u32x4*)(YF + yo2), yrb = *(const u32x4*)(YR + yo2);
        *(u32x4*)(U + i * 8) = gelu8(u, yf, yr, d, c);
        if (has2) *(u32x4*)(U + ib * 8) = gelu8(ub, yfb, yrb, d, c2);
    }
}

template <int NP> __device__ __forceinline__ void seg_load(const bf16_t* in, int ncols, int lane, unsigned (&w)[NP]) {
#pragma unroll
    for (int i = 0; i < NP; ++i) w[i] = (128 * i + 2 * lane < ncols) ? *(const unsigned*)(in + 128 * i + 2 * lane) : 0u;
}
template <int CW, int NP>
__device__ __forceinline__ void seg_fin(const unsigned (&w)[NP], bf16_t* out, int ncols, const float* gain, bool rope, int t, int lane, const float* rtab = nullptr) {
#pragma unroll
    for (int i = 0; i < NP; ++i) {
        const bool valid = 128 * i + 2 * lane < ncols;
        const float x0 = bflo(w[i]), x1 = bfhi(w[i]);
        float ss = x0 * x0 + x1 * x1;
        ss = (CW == 64) ? half_sum(ss) : wave_sum(ss);
        const float rs = rsqrtf(ss * (1.f / CW) + EPS);
        const int e = (2 * lane) % CW;
        float y0 = x0 * rs * gain[e], y1 = x1 * rs * gain[e + 1];
        if (rope) {
            const int pi = e >> 1, q = CW / 4; const int k = pi < q ? pi : pi - q; const int pos = pi < q ? (t >> 6) : (t & 63);
            typedef float f32x2t __attribute__((ext_vector_type(2)));
            const f32x2t cssn = ((const f32x2t*)rtab)[pos * q + k]; const float cs = cssn.x, sn = cssn.y;
            const float r0 = y0 * cs - y1 * sn, r1 = y0 * sn + y1 * cs; y0 = r0; y1 = r1;
        }
        if (valid) *(unsigned*)(out + 128 * i + 2 * lane) = cvt_pk_bf16(y0, y1);
    }
}
__device__ __forceinline__ void ph_prep1(const Params& p, int layer) {
    const int tid = otid(); const int lane = tid & 63, gw = obid() * 8 + (tid >> 6), NGW = gridDim.x * 8;
    bf16_t* Z = (bf16_t*)(p.ws + WS_G + G_Z); bf16_t* CQ = (bf16_t*)(p.ws + WS_G + G_CQ); bf16_t* CKV = (bf16_t*)(p.ws + WS_G + G_CKV);
    const float* daq = p.in[18] + layer * 64; const float* dak = p.in[19] + layer * 64; const float* gqq = p.in[22] + layer * 128; const float* gqk = p.in[23] + layer * 128;
    const float* r64 = (const float*)(p.ws + WS_ROPE64); const float* r128 = (const float*)(p.ws + WS_ROPE128);
    const float* cqn = p.in[24] + layer * 256; const float* ckvn = p.in[25] + layer * 128; const float* mlk = p.in[29] + layer * 192;
    for (int r = gw; r < RB; r += NGW) {
        bf16_t* z = Z + (size_t)r * ZW; const bool lat = r >= CTX; const int t = r - CTX;
        unsigned wq[4], wk[4], gq[4], gk[2], kv[1], kr[1];
        seg_load<4>(z + Z_DAQ, 512, lane, wq); seg_load<4>(z + Z_DAK, 512, lane, wk); seg_load<4>(z + Z_GQQ, 512, lane, gq); seg_load<2>(z + Z_GQK, 256, lane, gk);
        seg_load<1>(z + Z_CKV, 128, lane, kv); seg_load<1>(z + Z_KR, 64, lane, kr);
        const u32x2 wc = *(const u32x2*)(z + Z_CQ + 4 * lane);
        seg_fin<64, 4>(wq, z + Z_DAQ, 512, daq, lat, t, lane, r64);
        seg_fin<64, 4>(wk, z + Z_DAK, 512, dak, lat, t, lane, r64);
        seg_fin<128, 4>(gq, z + Z_GQQ, 512, gqq, lat, t, lane, r128);
        seg_fin<128, 2>(gk, z + Z_GQK, 256, gqk, lat, t, lane, r128);
        seg_fin<128, 1>(kv, CKV + (size_t)r * 128, 128, ckvn, false, 0, lane);
        seg_fin<64, 1>(kr, z + Z_KR, 64, mlk + 128, lat, t, lane, r64);
        {
            const float x0 = bflo(wc.x), x1 = bfhi(wc.x), x2 = bflo(wc.y), x3 = bfhi(wc.y);
            const float rs = rsqrtf(wave_sum(x0 * x0 + x1 * x1 + x2 * x2 + x3 * x3) * (1.f / 256) + EPS);
            const f32x4 g = *(const f32x4*)(cqn + 4 * lane);
            u32x2 o; o.x = cvt_pk_bf16(x0 * rs * g.x, x1 * rs * g.y); o.y = cvt_pk_bf16(x2 * rs * g.z, x3 * rs * g.w);
            *(u32x2*)(CQ + (size_t)r * 256 + 4 * lane) = o;
        }
    }
}
__device__ __forceinline__ void ph_prep2(const Params& p, int layer) {
    const int tid = otid(); const int lane = tid & 63, gw = obid() * 8 + (tid >> 6), NGW = gridDim.x * 8;
    const bf16_t* Z = (const bf16_t*)(p.ws + WS_G + G_Z); bf16_t* MLQ = (bf16_t*)(p.ws + WS_G + G_MLQ); const bf16_t* MLKV = (const bf16_t*)(p.ws + WS_G + G_MLKV); bf16_t* KF = (bf16_t*)(p.ws + WS_G + G_KF);
    const float* mlq = p.in[28] + layer * 192; const float* mlk = p.in[29] + layer * 192; const float* r64 = (const float*)(p.ws + WS_ROPE64);
    for (int r = gw; r < RB; r += NGW) {
        const bool lat = r >= CTX; const int t = r - CTX;
        bf16_t* q = MLQ + (size_t)r * 768; const bf16_t* kv = MLKV + (size_t)r * 1024; bf16_t* kf = KF + (size_t)r * 768;
        const unsigned krw = lane < 32 ? *(const unsigned*)(Z + (size_t)r * ZW + Z_KR + 2 * lane) : 0u;
        unsigned qn[4][1], qp[4][1], kn[4][1];
#pragma unroll
        for (int h = 0; h < 4; ++h) { seg_load<1>(q + h * 192, 128, lane, qn[h]); seg_load<1>(q + h * 192 + 128, 64, lane, qp[h]); seg_load<1>(kv + h * 256, 128, lane, kn[h]); }
#pragma unroll
        for (int h = 0; h < 4; ++h) {
            seg_fin<128, 1>(qn[h], q + h * 192, 128, mlq, false, 0, lane);
            seg_fin<64, 1>(qp[h], q + h * 192 + 128, 64, mlq + 128, lat, t, lane, r64);
            seg_fin<128, 1>(kn[h], kf + h * 192, 128, mlk, false, 0, lane);
            if (lane < 32) *(unsigned*)(kf + h * 192 + 128 + 2 * lane) = krw;
        }
    }
}
__device__ __forceinline__ void ph_subln(const Params& p, int layer) {
    const int tid = otid(); const int lane = tid & 63, gw = obid() * 8 + (tid >> 6), NGW = gridDim.x * 8;
    const bf16_t* A1 = (const bf16_t*)(p.ws + WS_G + G_A1); const bf16_t* A2 = (const bf16_t*)(p.ws + WS_G + G_A2); bf16_t* O = (bf16_t*)(p.ws + WS_G + G_BR);
    const float* lam = p.in[20] + layer * 256; const float* sub = p.in[21] + layer * 128;
    int lyr = layer; asm volatile("" : "+s"(lyr));
    const float lam_init = lyr == 0 ? 0.2f : 0.35550907f;
    const float l1 = wave_sum(lam[lane] * lam[64 + lane]), l2 = wave_sum(lam[128 + lane] * lam[192 + lane]);
    const float lam_full = expf(l1) - expf(l2) + lam_init;
    const float g0 = sub[2 * lane] * (1.f - lam_init), g1 = sub[2 * lane + 1] * (1.f - lam_init);
    for (int r = gw; r < RB; r += NGW) {
        unsigned w1[4], w2[4];
#pragma unroll
        for (int h = 0; h < 4; ++h) { const size_t off = (size_t)r * 512 + h * 128 + 2 * lane; w1[h] = *(const unsigned*)(A1 + off); w2[h] = *(const unsigned*)(A2 + off); }
#pragma unroll
        for (int h = 0; h < 4; ++h) {
            const size_t off = (size_t)r * 512 + h * 128 + 2 * lane;
            const float d0 = bflo(w1[h]) - lam_full * bflo(w2[h]), d1 = bfhi(w1[h]) - lam_full * bfhi(w2[h]);
            const float rs = rsqrtf(wave_sum(d0 * d0 + d1 * d1) * (1.f / 128) + EPS);
            *(unsigned*)(O + off) = cvt_pk_bf16(d0 * rs * g0, d1 * rs * g1);
        }
    }
}

__device__ __forceinline__ void attn_unit(const Params& p, int u, char* lds) {
    const bf16_t* Z = (const bf16_t*)(p.ws + WS_G + G_Z);
    int type, hd, qb;
    if (u < 128) { type = 0; hd = u >> 5; qb = 1 + (u & 31); }
    else if (u < 256) { type = 1; hd = (u - 128) >> 5; qb = 1 + (u & 31); }
    else if (u < 512) { type = 2; hd = (u - 256) >> 5; qb = 1 + (u & 31); }
    else { const int k = u - 512; qb = 0; if (k < 4) { type = 0; hd = k; } else if (k < 8) { type = 1; hd = k - 4; } else { type = 2; hd = k - 8; } }
    const int seq = qb == 0 ? CTX : RB; const size_t q0 = (size_t)qb * 256;
#ifndef ATT_TYPES
#define ATT_TYPES 7
#endif
    if (type == 0 && (ATT_TYPES & 1)) {
        const bf16_t* Q = (const bf16_t*)(p.ws + WS_G + G_MLQ) + q0 * 768 + hd * 192;
        const bf16_t* K = (const bf16_t*)(p.ws + WS_G + G_KF) + hd * 192;
        const bf16_t* V = (const bf16_t*)(p.ws + WS_G + G_MLKV) + hd * 256 + 128;
        bf16_t* O = (bf16_t*)(p.ws + WS_G + G_BR) + (size_t)2 * RB * 512 + q0 * 512 + hd * 128;
#ifndef ML_QL
#define ML_QL -1
#endif
        if constexpr (ML_QL < 0) att::attn_body_simple<192, 768, 768, 1024, 512>(Q, K, V, O, seq, lds);
        else att::attn_body<192, 768, 768, 1024, 512, (ML_QL < 0 ? 0 : ML_QL)>(Q, K, V, O, seq, lds);
    } else if (type == 1 && (ATT_TYPES & 2)) {
        const int kvh = hd >> 1;
        const bf16_t* Q = Z + q0 * ZW + Z_GQQ + hd * 128;
        const bf16_t* K = Z + Z_GQK + kvh * 128;
        const bf16_t* V = Z + Z_GQV + kvh * 128;
        bf16_t* O = (bf16_t*)(p.ws + WS_G + G_BR) + (size_t)1 * RB * 512 + q0 * 512 + hd * 128;
#ifndef GQ_SIMPLE
#define GQ_SIMPLE 1
#endif
        if constexpr (GQ_SIMPLE) att::attn_body_simple<128, ZW, ZW, ZW, 512>(Q, K, V, O, seq, lds); else att::attn_body<128, ZW, ZW, ZW, 512>(Q, K, V, O, seq, lds);
    } else if (type == 2 && (ATT_TYPES & 4)) {
        const int h = hd >> 1, m = hd & 1;
        const bf16_t* Q = Z + q0 * ZW + Z_DAQ + h * 128 + m * 64;
        const bf16_t* K = Z + Z_DAK + h * 128 + m * 64;
        const bf16_t* V = Z + Z_DAV + h * 128;
        bf16_t* O = (bf16_t*)(p.ws + WS_G + (m == 0 ? G_A1 : G_A2)) + q0 * 512 + h * 128;
#ifndef DA_SIMPLE
#define DA_SIMPLE 0
#endif
        if constexpr (DA_SIMPLE) att::attn_body_simple<64, ZW, ZW, ZW, 512>(Q, K, V, O, seq, lds); else att::attn_body<64, ZW, ZW, ZW, 512>(Q, K, V, O, seq, lds);
    }
}
#ifndef ATT_REP_TYPES
#define ATT_REP_TYPES 7
#endif
__device__ __forceinline__ void ph_attn(const Params& p, char* lds, int last, int tmask = 7) {
    const int G = gridDim.x, c = obid();
    for (int i = 0; i < 3; ++i) {
        int u;
        const int xcd = c & 7, jq = c >> 3;
        if (G == 256) u = i == 0 ? (xcd < 4 ? xcd * 32 + jq : 128 + (xcd - 4) * 32 + jq) : (i == 1 ? 256 + xcd * 32 + jq : ((c >= 128 && c < 144 && !last) ? 512 + (c - 128) : -1));
        else u = -1;
        if (u >= 0) { const int ty = u < 128 ? 1 : (u < 256 ? 2 : (u < 512 ? 4 : 7)); if (ty & tmask) attn_unit(p, u, lds); }
    }
    if (G != 256) for (int u = c; u < (last ? 512 : 528); u += G) attn_unit(p, u, lds);
}


#define XB_TMO      128
#define XB_XCNT(j)  (256  + 64 * (j))
#define XB_XSUB(j)  (1280 + 64 * (j))
#define XB_XGEN(j)  (2304 + 64 * (j))
#define XB_TOP      3328
#define XB_TOPGEN   3392
#define XCD_BAR_WORDS 3456
#define XB_SPIN_CAP (1u << 23)
#ifndef XB_SLEEP
#define XB_SLEEP 6
#endif
__device__ __forceinline__ unsigned xb_ld(unsigned* p)              { return __hip_atomic_load(p, __ATOMIC_RELAXED, __HIP_MEMORY_SCOPE_AGENT); }
__device__ __forceinline__ unsigned xb_add(unsigned* p, unsigned v) { return __hip_atomic_fetch_add(p, v, __ATOMIC_RELAXED, __HIP_MEMORY_SCOPE_AGENT); }
__device__ __forceinline__ unsigned xb_xcc_id() { return (unsigned)__builtin_amdgcn_s_getreg((3 << 11) | 20) & 0xFu; }
#define XB_SPIN(cond, bar) do { unsigned _sp = 0; while (cond) { __builtin_amdgcn_s_sleep(XB_SLEEP); \
    if ((++_sp & 255u) == 0u) { if (xb_ld(&(bar)[XB_TMO])) break; if (_sp > XB_SPIN_CAP) { atomicAdd(&(bar)[XB_TMO], 1u); break; } } } } while (0)
struct XcdBarrier { unsigned* bar; unsigned x; volatile LAS unsigned* st; };
__device__ __forceinline__ void xcd_barrier_complete(unsigned* bar, unsigned x, unsigned& nloc, unsigned& nx) {
    const unsigned G = gridDim.x * gridDim.y * gridDim.z;
    unsigned sum, cnt, mine, sp = 0u;
    for (;;) {
        sum = 0u; cnt = 0u; mine = 0u;
#pragma unroll
        for (unsigned j = 0; j < 16; ++j) { const unsigned c = xb_ld(&bar[XB_XCNT(j)]); sum += c; cnt += (c > 0u) ? 1u : 0u; mine = (j == x) ? c : mine; }
        if (sum == G) break;
        __builtin_amdgcn_s_sleep(1);
        if ((++sp & 255u) == 0u) { if (xb_ld(&bar[XB_TMO])) break; if (sp > XB_SPIN_CAP) { atomicAdd(&bar[XB_TMO], 1u); break; } }
    }
    nloc = mine > 0u ? mine : 1u; nx = cnt > 0u ? cnt : 1u;
}
__device__ __forceinline__ void xcd_barrier(const XcdBarrier& b) {
    asm volatile("s_waitcnt vmcnt(0)" ::: "memory");
    __syncthreads();
    if (otid() == 0) {
        unsigned* bar = b.bar;
        __builtin_amdgcn_s_waitcnt(0);
        unsigned nloc = b.st[0], nx = b.st[1];
        if (nloc == 0u) { xcd_barrier_complete(bar, b.x, nloc, nx); b.st[0] = nloc; b.st[1] = nx; }
        const unsigned old = xb_add(&bar[XB_XSUB(b.x)], 1u);
        const unsigned gen = old / nloc;
        if (old + 1u == (gen + 1u) * nloc) {
            __builtin_amdgcn_fence(__ATOMIC_RELEASE, "agent");
            asm volatile("s_waitcnt vmcnt(0)" ::: "memory");
            const unsigned og = xb_add(&bar[XB_TOP], 1u);
            const unsigned tg = og / nx;
            if (og + 1u == (tg + 1u) * nx) xb_add(&bar[XB_TOPGEN], 1u);
            else XB_SPIN(xb_ld(&bar[XB_TOPGEN]) == tg, bar);
            __builtin_amdgcn_fence(__ATOMIC_ACQUIRE, "agent");
            xb_add(&bar[XB_XGEN(b.x)], 1u);
            asm volatile("s_waitcnt vmcnt(0)" ::: "memory");
        } else {
            XB_SPIN(xb_ld(&bar[XB_XGEN(b.x)]) == gen, bar);
            __builtin_amdgcn_fence(__ATOMIC_ACQUIRE, "agent");
            asm volatile("s_waitcnt vmcnt(0)" ::: "memory");
        }
    }
    __syncthreads();
}

__global__ void __launch_bounds__(512, 2) mk_fwd(Params p0) {
    extern __shared__ __attribute__((aligned(16))) unsigned char lds_raw[];
    LAS unsigned char* lds = (LAS unsigned char*)lds_raw;
    cg::grid_group grid = cg::this_grid();
#define GSYNC() do { if (hi < 0) { asm volatile("s_waitcnt vmcnt(0) lgkmcnt(0)" ::: "memory"); grid.sync(); }     \
    else { XcdBarrier xb_; xb_.bar = (unsigned*)(load_params().ws + WS_BAR); xb_.x = xb_xcc_id(); xb_.st = (volatile LAS unsigned*)(lds + 131072 + 64); xcd_barrier(xb_); } } while (0)
    if (threadIdx.x == 0) { volatile LAS unsigned* st_ = (volatile LAS unsigned*)(lds + 131072 + 64); st_[0] = 0u; st_[1] = 0u;
        (void)xb_add(&((unsigned*)(p0.ws + WS_BAR))[XB_XCNT(xb_xcc_id())], 1u); }
    __syncthreads();
    const int lo = p0.lo, hi = p0.hi; int ph = 0; int layer = 0;
#ifndef PHASE_MASK
#define PHASE_MASK 0xFFFF
#endif
#ifndef REPEAT_MASK
#define REPEAT_MASK 0
#endif
#define PH_BEGIN(cat) if (ph >= lo && ph < hi) { constexpr int cat_ = (cat); (void)cat_; DIAG_T0(cat) if constexpr ((PHASE_MASK >> (cat)) & 1) for (int rep_ = 0; rep_ < (((REPEAT_MASK >> (cat)) & 1) ? 2 : 1); ++rep_) { if (rep_) GSYNC(); const Params p = load_params(); \
    unsigned char* ws = p.ws; float* MOD = (float*)(ws + WS_MOD); float* ctxb = (float*)(ws + WS_CTXB); bf16_t* H = (bf16_t*)(ws + WS_H); bf16_t* ABR = (bf16_t*)(ws + WS_ABR); \
    const bf16_t* Wl = (const bf16_t*)(ws + WS_W + layer * W_LAYER_B); const float* modl = MOD + (size_t)layer * 5 * MODW; \
    const float* xl_in = layer == 0 ? p.in[0] : p.out; const float* xc_in = layer == 0 ? p.in[2] : ctxb; \
    int lastl = layer; asm volatile("" : "+s"(lastl)); lastl = (lastl == 1) ? 1 : 0; \
    (void)MOD; (void)ctxb; (void)H; (void)ABR; (void)Wl; (void)modl; (void)xl_in; (void)xc_in; (void)lastl;
#if defined(DIAG_A_MASK)
#define DIAG_T0(cat) if (blockIdx.x == 0 && threadIdx.x == 0) { ((LAS unsigned long long*)(lds + LDS_BYTES - 64))[2] = __builtin_amdgcn_s_memrealtime(); }
#define DIAG_T1(cat) if (blockIdx.x == 0 && threadIdx.x == 0) { LAS unsigned long long* ta_ = (LAS unsigned long long*)(lds + LDS_BYTES - 64); const unsigned long long dt_ = __builtin_amdgcn_s_memrealtime() - ta_[2]; \
    if ((DIAG_A_MASK >> (cat)) & 1) ta_[0] += dt_; if ((DIAG_B_MASK >> (cat)) & 1) ta_[1] += dt_; }
#else
#define DIAG_T0(cat)
#define DIAG_T1(cat)
#endif
#define PH_END   } if (ph + 1 < hi) GSYNC(); DIAG_T1(cat_) } ++ph;
    const int G = gridDim.x, c = blockIdx.x;
#if defined(DIAG_A_MASK)
    if (threadIdx.x == 0) { LAS unsigned long long* ta_ = (LAS unsigned long long*)(lds + LDS_BYTES - 64); ta_[0] = 0; ta_[1] = 0; }
#endif

#if defined(EXTRA_SYNCS)
    for (int es = 0; es < EXTRA_SYNCS; ++es) GSYNC();
#endif
    PH_BEGIN(0) ph_prologue(p, lds); PH_END

    for (layer = 0; layer < 2; ++layer) {

        PH_BEGIN(1) ph_norm_mod(xl_in, xc_in, p.in[6] + layer * DM, modl, 0, H); PH_END

        PH_BEGIN(2) {
            pg8::Gemm g{H, Wl + W_IN, MTOT, 512, 1024}; pg8::StaticOrder S; S.init(MTOT, 512, G, c);
            pg8::Epi<pg8::E_STORE> E{}; E.a.O = (bf16_t*)(ws + WS_G + S_U); E.a.ldc = 512;
            pg8::gemm_phase(lds, g, S, E);
            { pg8::Gemm g2{H, Wl + W_IN + (size_t)512 * 1024, RB, ZW, 1024}; pg8::StaticOrder S2; S2.init(RB, ZW, G, (c + 160) % G);
              pg8::Epi<pg8::E_INPROJ> E2{}; E2.a.O = (bf16_t*)(ws + WS_G + G_Z); E2.a.ldc = ZW;
              pg8::gemm_phase(lds, g2, S2, E2); }
        } PH_END

        PH_BEGIN(3) { for (int u = c; u < 256; u += G) s5_chain(p, layer, u, lds); } PH_END

        PH_BEGIN(4) ph_s5_gelu(p, layer); PH_END

        PH_BEGIN(9) {
            pg8::Gemm g{(const bf16_t*)(ws + WS_G + S_U), Wl + W_GLU, MTOT, 512, 512}; pg8::StaticOrder S; S.init(MTOT, 512, G, c);
            pg8::Epi<pg8::E_GLU> E{}; E.a.O = ABR; E.a.ldc = 512; E.a.G = (const bf16_t*)(ws + WS_G + S_U); E.a.ldg = 512; E.a.bias = p.in[17] + layer * 512;
            pg8::gemm_phase(lds, g, S, E);
            ph_prep1(p, layer);
        } PH_END

        for (int gb = 0; gb < NB; ++gb) {
            const size_t grow0 = (size_t)gb * RB;
            if (gb > 0) {
            PH_BEGIN(10) {
                pg8::Gemm g{H + grow0 * DM, Wl + W_IN + (size_t)512 * 1024, RB, ZW, 1024}; pg8::StaticOrder S; S.init(RB, ZW, G, c);
                pg8::Epi<pg8::E_INPROJ> E{}; E.a.O = (bf16_t*)(ws + WS_G + G_Z); E.a.ldc = ZW;
                pg8::gemm_phase(lds, g, S, E);
            } PH_END

            PH_BEGIN(5) ph_prep1(p, layer); PH_END
            }

            PH_BEGIN(11) {
                { pg8::Gemm g{(const bf16_t*)(ws + WS_G + G_CQ), Wl + W_UQ, RB, 768, 256}; pg8::StaticOrder S; S.init(RB, 768, G, c);
                  pg8::Epi<pg8::E_STORE> E{}; E.a.O = (bf16_t*)(ws + WS_G + G_MLQ); E.a.ldc = 768;
                  pg8::gemm_phase(lds, g, S, E); }
                { pg8::Gemm g{(const bf16_t*)(ws + WS_G + G_CKV), Wl + W_UKV, RB, 1024, 128}; pg8::StaticOrder S; S.init(RB, 1024, G, (c + 128) % G);
                  pg8::Epi<pg8::E_STORE> E{}; E.a.O = (bf16_t*)(ws + WS_G + G_MLKV); E.a.ldc = 1024;
                  pg8::gemm_phase(lds, g, S, E); }
            } PH_END

            PH_BEGIN(6) ph_prep2(p, layer); PH_END

            PH_BEGIN(7) ph_attn(p, (char*)lds_raw, lastl, rep_ ? ATT_REP_TYPES : 7); PH_END

            PH_BEGIN(8) ph_subln(p, layer); PH_END

            PH_BEGIN(12) {
                const int vpm0 = gb * TPB, vpm1 = (int)((WS_G + G_BR - WS_ABR) / 262144);
                pg8::Gemm g{ABR, Wl + W_BR, RB, 1024, 512}; pg8::MergeOrder S{G, c, vpm0, vpm1, lastl};
                pg8::Epi<pg8::E_MERGE> E{}; E.a.O = H + grow0 * DM; E.a.ldc = DM; E.a.G = (const bf16_t*)(ws + WS_G + G_Z) + Z_GATE; E.a.ldg = ZW;
                E.a.MF = (float*)(ws + WS_G + G_MF); E.a.vpm0 = vpm0; E.a.vpm1 = vpm1;
                pg8::gemm_phase(lds, g, S, E);
            } PH_END
        }

        PH_BEGIN(13) {
            pg8::Gemm g{H, Wl + W_OUT, MTOT, 1024, 1024}; pg8::StaticOrder S; S.init(MTOT, 1024, G, c, lastl);
            pg8::Epi<pg8::E_RESID> E{}; E.a.xin_l = xl_in; E.a.xin_c = xc_in; E.a.xout_l = p.out; E.a.xout_c = ctxb; E.a.gate = modl + 2 * 1024;
            pg8::gemm_phase(lds, g, S, E);
        } PH_END

        PH_BEGIN(1) ph_norm_mod(p.out, ctxb, p.in[32] + layer * DM, modl, 3, H); PH_END

        PH_BEGIN(14) {
            pg8::Gemm g{H, Wl + W_FI, MTOT, 2 * DFF, 1024}; pg8::StaticOrder S; S.init(MTOT, 2 * DFF, G, c, lastl);
            pg8::Epi<pg8::E_SWIGLU> E{}; E.a.O = (bf16_t*)(ws + WS_G); E.a.ldc = DFF;
            pg8::gemm_phase(lds, g, S, E);
        } PH_END

        PH_BEGIN(15) {
            pg8::Gemm g{(const bf16_t*)(ws + WS_G), Wl + W_FO, MTOT, 1024, DFF}; pg8::StaticOrder S; S.init(MTOT, 1024, G, c, lastl);
            pg8::Epi<pg8::E_RESID> E{}; E.a.xin_l = p.out; E.a.xin_c = ctxb; E.a.xout_l = p.out; E.a.xout_c = ctxb; E.a.gate = modl + 5 * 1024;
            pg8::gemm_phase(lds, g, S, E);
        } PH_END
    }
#if defined(DIAG_A_MASK)
    GSYNC();
    if (blockIdx.x == 0) { LAS unsigned long long* ta_ = (LAS unsigned long long*)(lds + LDS_BYTES - 64);
        const float A = (float)ta_[0] * 0.01f, B = (float)ta_[1] * 0.01f;
        if (threadIdx.x == 0) p0.out[0] = A; else p0.out[threadIdx.x] = B; if (threadIdx.x > 0) p0.out[threadIdx.x + 511] = B; }
#endif
#undef PH_BEGIN
#undef PH_END
}
constexpr int N_PHASES = 1 + 2 * (5 + 4 * 7 + 4 - 2);

extern "C" void kernel_launch(void* const* d_in, const int* in_sizes, int n_in, void* d_out, int out_size, void* d_ws, size_t ws_size, hipStream_t stream) {
    static int grid = 0;
    if (grid == 0) {
        if (n_in != 35 || out_size != NB * SEQ * DM || ws_size < WS_END) { fprintf(stderr, "kernel_launch: bad shapes: n_in %d out %d ws %zu (need %zu)\n", n_in, out_size, ws_size, (size_t)WS_END); grid = -1; return; }
        int dev = 0, cus = 0, per_cu = 0;
        (void)hipGetDevice(&dev); (void)hipDeviceGetAttribute(&cus, hipDeviceAttributeMultiprocessorCount, dev);
        if (hipFuncSetAttribute((const void*)mk_fwd, hipFuncAttributeMaxDynamicSharedMemorySize, LDS_BYTES) != hipSuccess) { fprintf(stderr, "kernel_launch: hipFuncSetAttribute failed\n"); grid = -1; return; }
        (void)hipOccupancyMaxActiveBlocksPerMultiprocessor(&per_cu, (const void*)mk_fwd, 512, LDS_BYTES);
        (void)hipGetLastError();
        if (per_cu < 1) per_cu = 1;
        grid = cus;
    }
    if (grid < 0) return;
    if (hipMemsetAsync((char*)d_ws + WS_BAR, 0, 16384, stream) != hipSuccess) { fprintf(stderr, "kernel_launch: memset failed\n"); return; }
    Params p{};
    for (int i = 0; i < 35; ++i) p.in[i] = (const float*)d_in[i];
    p.out = (float*)d_out; p.ws = (unsigned char*)d_ws;
#if MK_MODE == 0
    p.lo = 0; p.hi = N_PHASES;
    void* args[] = {&p};
    hipError_t e = hipLaunchCooperativeKernel((const void*)mk_fwd, dim3(grid), dim3(512), args, LDS_BYTES, stream);
    if (e != hipSuccess) fprintf(stderr, "cooperative launch failed: %s (grid %d)\n", hipGetErrorString(e), grid);
#else
    for (int ph = 0; ph < N_PHASES; ++ph) {
        p.lo = ph; p.hi = ph + 1;
        hipLaunchKernelGGL(mk_fwd, dim3(grid), dim3(512), LDS_BYTES, stream, p);
    }
#endif
}
```

```cpp
#include <hip/hip_runtime.h>
#include <hip/hip_cooperative_groups.h>
#include <cstdio>
#include <cstdint>
namespace cg = cooperative_groups;

#ifndef MK_MODE
#define MK_MODE 0
#endif

#define LAS __attribute__((address_space(3)))
typedef unsigned short bf16_t;
typedef short bf16x8 __attribute__((ext_vector_type(8)));
typedef short s16x4 __attribute__((ext_vector_type(4)));
typedef float f32x4 __attribute__((ext_vector_type(4)));
typedef float f32x16 __attribute__((ext_vector_type(16)));
typedef unsigned u32x4 __attribute__((ext_vector_type(4)));
typedef unsigned u32x2 __attribute__((ext_vector_type(2)));

constexpr int DM = 1024, NB = 4, SEQ = 8192, CTX = 256, RB = SEQ + CTX  , MTOT = NB * RB  ;
constexpr int TPB = RB / 256;
constexpr int ZW = 7168;
constexpr int Z_DAQ = 0, Z_DAK = 512, Z_DAV = 1024, Z_GQQ = 1536, Z_GQK = 2048, Z_GQV = 2304, Z_CQ = 2560, Z_CKV = 2816, Z_KR = 2944, Z_GATE = 3072;
constexpr int DFF = 2816, MODW = 6144;
constexpr float EPS = 1e-6f;

constexpr size_t MiB = 1u << 20;
constexpr size_t al(size_t x) { return (x + MiB - 1) / MiB * MiB; }
constexpr size_t WS_MOD = 0;
constexpr size_t WS_ROPE64 = 256 * 1024, WS_ROPE128 = WS_ROPE64 + 128 * 16 * 8;
constexpr size_t WS_BAR = 512 * 1024;
constexpr size_t WS_CTXB = al(WS_MOD + 2 * 5 * MODW * 4);
constexpr size_t WS_W = WS_CTXB + 4 * MiB;
constexpr size_t W_IN = 0, W_UQ = W_IN + (size_t)7680 * 1024, W_UKV = W_UQ + 768 * 256, W_GLU = W_UKV + 1024 * 128, W_BR = W_GLU + 512 * 512,
                 W_OUT = W_BR + (size_t)4 * 1024 * 512, W_FI = W_OUT + (size_t)1024 * 1024, W_FO = W_FI + (size_t)5632 * 1024, W_LAYER = W_FO + (size_t)1024 * 2816;
constexpr size_t W_LAYER_B = al(W_LAYER * 2);
constexpr size_t WS_H = WS_W + 2 * W_LAYER_B;
constexpr size_t WS_ABR = WS_H + al((size_t)MTOT * 1024 * 2);
constexpr size_t WS_G = WS_ABR + al((size_t)MTOT * 512 * 2);
constexpr size_t G_Z = 0;
constexpr size_t G_CQ = al(G_Z + (size_t)RB * ZW * 2);
constexpr size_t G_CKV = al(G_CQ + (size_t)RB * 256 * 2);
constexpr size_t G_MLQ = al(G_CKV + (size_t)RB * 128 * 2);
constexpr size_t G_MLKV = al(G_MLQ + (size_t)RB * 768 * 2);
constexpr size_t G_KF = al(G_MLKV + (size_t)RB * 1024 * 2);
constexpr size_t G_A1 = al(G_KF + (size_t)RB * 768 * 2);
constexpr size_t G_A2 = al(G_A1 + (size_t)RB * 512 * 2);
constexpr size_t G_BR = al(G_A2 + (size_t)RB * 512 * 2);
constexpr size_t G_MF = al(G_BR + (size_t)3 * RB * 512 * 2);
constexpr size_t G_END = al(G_MF + (size_t)RB * 1024 * 4);
constexpr size_t S_SZ = al((size_t)MTOT * 512 * 2), S_U = G_MLQ  , S_YF = S_U + S_SZ, S_YR = S_YF + S_SZ, S_END = S_YR + S_SZ;
constexpr size_t HID_B = (size_t)MTOT * DFF * 2;
static_assert(S_END <= G_END && HID_B <= G_END, "aliases fit");
constexpr size_t WS_END = WS_G + G_END;
static_assert(WS_END <= (size_t)512 * MiB, "workspace budget");
static_assert((WS_G + G_BR - WS_ABR) % 262144 == 0, "merge virtual tiles");

constexpr int LDS_BYTES = 147456;

typedef __bf16 bf16x2n __attribute__((ext_vector_type(2)));
typedef float f32x2n __attribute__((ext_vector_type(2)));
__device__ __forceinline__ unsigned cvt_pk_bf16(float lo, float hi) { f32x2n v = {lo, hi}; bf16x2n b = __builtin_convertvector(v, bf16x2n); return __builtin_bit_cast(unsigned, b); }
__device__ __forceinline__ float bf2f(unsigned v) { return __uint_as_float(v << 16); }
__device__ __forceinline__ float bflo(unsigned w) { return __uint_as_float(w << 16); }
__device__ __forceinline__ float bfhi(unsigned w) { return __uint_as_float(w & 0xffff0000u); }
__device__ __forceinline__ bf16_t f2bf(float f) { return (bf16_t)(cvt_pk_bf16(f, 0.f) & 0xffffu); }
template <int O> __device__ __forceinline__ float swz_xor(float v) { return __int_as_float(__builtin_amdgcn_ds_swizzle(__float_as_int(v), 0x1f | (O << 10))); }
__device__ __forceinline__ float half_sum(float v) {
    v += swz_xor<1>(v); v += swz_xor<2>(v); v += swz_xor<4>(v); v += swz_xor<8>(v); v += swz_xor<16>(v); return v;
}
__device__ __forceinline__ float wave_sum(float v) {
    v = half_sum(v);
    auto rr = __builtin_amdgcn_permlane32_swap(__float_as_uint(v), __float_as_uint(v), false, false);
    return __uint_as_float(rr[0]) + __uint_as_float(rr[1]);
}
__device__ __forceinline__ int otid() { int t = threadIdx.x; asm volatile("" : "+v"(t)); return t; }
__device__ __forceinline__ float sigmoidf_(float x) { return __builtin_amdgcn_rcpf(1.f + __expf(-x)); }

__device__ __forceinline__ int obid() { int b = blockIdx.x; asm volatile("" : "+s"(b)); return b; }
struct Params { const float* in[35]; float* out; unsigned char* ws; int lo, hi; };
__device__ __forceinline__ Params load_params() {
#if defined(__HIP_DEVICE_COMPILE__)
    typedef const __attribute__((address_space(4))) Params* CP;
    CP q = (CP)__builtin_amdgcn_kernarg_segment_ptr(); asm volatile("" : "+s"(q));
    Params r;
#pragma unroll
    for (int i = 0; i < 35; ++i) r.in[i] = q->in[i];
    r.out = q->out; r.ws = q->ws; r.lo = q->lo; r.hi = q->hi; return r;
#else
    return Params{};
#endif
}

namespace pg8 {
constexpr int BM = 256, BK = 64, HALF = 128, HTB = HALF * BK * 2, STAGE_BYTES = 8 * HTB, NXCD = 8, WGM = 8;
__host__ __device__ __forceinline__ int lds_byte(int r, int c) { const int st = (r >> 4) * 2 + (c >> 5), rr = r & 15, cc = c & 31, ob = rr * 64 + cc * 2; return st * 1024 + (ob ^ (((ob >> 9) & 1) << 5)); }
__host__ __device__ __forceinline__ void stage_rc(int b, int& R, int& C) { const int st = b / 1024, sb = b % 1024, swz = sb ^ (((sb >> 9) & 1) << 5); R = (st >> 1) * 16 + swz / 64; C = (st & 1) * 32 + (swz % 64) / 2; }
__host__ __device__ __forceinline__ int perm32(int rho) { const int n = rho >> 4, i = rho & 15; return 8 * (i >> 2) + 4 * n + (i & 3); }
struct Unit { int pm, pn; };
struct Gemm { const bf16_t* A; const bf16_t* Bt; int M, N, K; };
struct StaticOrder {
    int nM, nN, nwg, G, c;
    int skip;
    __device__ void init(int M, int N, int G_, int c_, int skip_ = 0) { skip = skip_; nM = skip_ ? NB * (TPB - 1) : M / BM; nN = N / BM; nwg = nM * nN; G = G_; c = c_; }
    __device__ bool next(int i, Unit& u) const {
        const long L = (long)i * G + c; if (L >= nwg) return false;
        int wgid = (int)L; { const int q = nwg / NXCD, r = nwg % NXCD, xcd = wgid % NXCD, off = wgid / NXCD; wgid = (xcd < r ? xcd * (q + 1) : r * (q + 1) + (xcd - r) * q) + off; }
        const int nig = WGM * nN, gid = wgid / nig, fm = gid * WGM, gsz = (nM - fm) < WGM ? (nM - fm) : WGM;
        u.pm = fm + ((wgid % nig) % gsz); u.pn = (wgid % nig) / gsz; if (skip) u.pm += u.pm / (TPB - 1) + 1; return true;
    }
};
struct MergeOrder {
    int G, c, vpm0, vpm1, skip;
    __device__ bool next(int i, Unit& u) const {
        const int j = i >> 2, n = i & 3; const int L = j * G + c; if (L >= (TPB - skip) * 4) return false;
        const int pm = (L >> 2) + skip, pn = L & 3; u.pm = (n == 0 ? vpm0 : vpm1 + (n - 1) * TPB) + pm; u.pn = n * 4 + pn; return true;
    }
};

enum { E_STORE = 0, E_INPROJ = 1, E_GLU = 2, E_MERGE = 3, E_RESID = 4, E_SWIGLU = 5 };
struct EpiArgs {
    bf16_t* O; int ldc;
    const bf16_t* G; int ldg;
    const float* bias;
    float* MF;
    int vpm0, vpm1;
    const float* xin_l; const float* xin_c; float* xout_l; float* xout_c; const float* gate;
};
template <int MODE> struct Epi {
    EpiArgs a;
    __device__ __forceinline__ void operator()(const f32x4 (&acc)[2][2][4][2], const Unit& u, int, int, int, int) const {
        const int t_ = otid(), wid_ = __builtin_amdgcn_readfirstlane(t_ >> 6), wr = wid_ >> 2, wc = wid_ & 3, fr = t_ & 15, fq = (t_ & 63) >> 4;
        int pm = u.pm, pn = u.pn, nbr = 0;
        if (MODE == E_MERGE) { nbr = u.pn >> 2; pn = u.pn & 3; pm = u.pm - (nbr == 0 ? a.vpm0 : a.vpm1 + (nbr - 1) * TPB); }
        const int row0 = pm * BM + wr * 64 + fr;
        const int col0 = (MODE == E_SWIGLU ? pn * 128 : pn * BM) + wc * 32 + 8 * fq;
        const float* xin = nullptr; float* xout = nullptr; const float* gv = nullptr;
        if (MODE == E_RESID) {
            const int b = pm / TPB, t = pm - b * TPB;
            if (t == 0) { xin = a.xin_c + (size_t)b * CTX * DM; xout = a.xout_c + (size_t)b * CTX * DM; gv = a.gate + 4 * MODW; }
            else { xin = a.xin_l + ((size_t)b * SEQ + (size_t)(t - 1) * 256) * DM; xout = a.xout_l + ((size_t)b * SEQ + (size_t)(t - 1) * 256) * DM; gv = a.gate + b * MODW; }
        }
        if (MODE == E_SWIGLU || MODE == E_STORE || MODE == E_INPROJ) {
#pragma unroll
            for (int ai = 0; ai < 2; ++ai)
#pragma unroll
                for (int m = 0; m < 4; ++m) {
                    const int row = row0 + ai * HALF + m * 16;
                    if (MODE == E_SWIGLU) {
                        const f32x4 g0 = acc[ai][0][m][0], g1 = acc[ai][0][m][1], u0 = acc[ai][1][m][0], u1 = acc[ai][1][m][1];
                        float h[8];
#pragma unroll
                        for (int e = 0; e < 4; ++e) { h[e] = g0[e] * sigmoidf_(g0[e]) * u0[e]; h[4 + e] = g1[e] * sigmoidf_(g1[e]) * u1[e]; }
                        u32x4 w; w.x = cvt_pk_bf16(h[0], h[1]); w.y = cvt_pk_bf16(h[2], h[3]); w.z = cvt_pk_bf16(h[4], h[5]); w.w = cvt_pk_bf16(h[6], h[7]);
                        *(u32x4*)(a.O + (size_t)row * a.ldc + col0) = w;
                        continue;
                    }
#pragma unroll
                    for (int bj = 0; bj < 2; ++bj) {
                        const int col = col0 + bj * HALF;
                        f32x4 v0 = acc[ai][bj][m][0], v1 = acc[ai][bj][m][1];
                        if (MODE == E_INPROJ && pn >= 12) {
#pragma unroll
                            for (int e = 0; e < 4; ++e) { v0[e] = sigmoidf_(v0[e]); v1[e] = sigmoidf_(v1[e]); }
                        }
                        u32x4 w; w.x = cvt_pk_bf16(v0[0], v0[1]); w.y = cvt_pk_bf16(v0[2], v0[3]); w.z = cvt_pk_bf16(v1[0], v1[1]); w.w = cvt_pk_bf16(v1[2], v1[3]);
                        *(u32x4*)(a.O + (size_t)row * a.ldc + col) = w;
                    }
                }
            return;
        }
        f32x4 gb0[2], gb1[2];
#pragma unroll
        for (int bj = 0; bj < 2; ++bj) {
            const int col = col0 + bj * HALF;
            if (MODE == E_GLU) { gb0[bj] = *(const f32x4*)(a.bias + col); gb1[bj] = *(const f32x4*)(a.bias + col + 4); }
            else if (MODE == E_RESID) { gb0[bj] = *(const f32x4*)(gv + col); gb1[bj] = *(const f32x4*)(gv + col + 4); }
            else { gb0[bj] = (f32x4){0.f, 0.f, 0.f, 0.f}; gb1[bj] = gb0[bj]; }
        }
#pragma unroll
        for (int ai = 0; ai < 2; ++ai)
#pragma unroll
            for (int mp = 0; mp < 2; ++mp) {
                u32x4 gw[2][2]; f32x4 xa[2][2], xb[2][2];
#pragma unroll
                for (int mm = 0; mm < 2; ++mm)
#pragma unroll
                    for (int bj = 0; bj < 2; ++bj) {
                        const int row = row0 + ai * HALF + (mp * 2 + mm) * 16, col = col0 + bj * HALF;
                        if (MODE == E_GLU) gw[mm][bj] = *(const u32x4*)(a.G + (size_t)row * a.ldg + col);
                        if (MODE == E_MERGE) { gw[mm][bj] = *(const u32x4*)(a.G + (size_t)row * a.ldg + nbr * 1024 + col);
                            if (nbr != 0) { const u32x4 mw = *(const u32x4*)((const bf16_t*)a.MF + (size_t)row * 1024 + col);
                                xa[mm][bj] = (f32x4){bflo(mw.x), bfhi(mw.x), bflo(mw.y), bfhi(mw.y)}; xb[mm][bj] = (f32x4){bflo(mw.z), bfhi(mw.z), bflo(mw.w), bfhi(mw.w)}; } }
                        if (MODE == E_RESID) { const int lr = row - pm * BM; xa[mm][bj] = *(const f32x4*)(xin + (size_t)lr * DM + col); xb[mm][bj] = *(const f32x4*)(xin + (size_t)lr * DM + col + 4); }
                    }
#pragma unroll
                for (int mm = 0; mm < 2; ++mm)
#pragma unroll
                    for (int bj = 0; bj < 2; ++bj) {
                        const int m = mp * 2 + mm; const int row = row0 + ai * HALF + m * 16, col = col0 + bj * HALF;
                        const f32x4 v0 = acc[ai][bj][m][0], v1 = acc[ai][bj][m][1];
                        if (MODE == E_GLU) {
                            const u32x4 g = gw[mm][bj]; const f32x4 b0 = gb0[bj], b1 = gb1[bj];
                            float o[8];
                            o[0] = bflo(g.x) * sigmoidf_(v0[0] + b0[0]); o[1] = bfhi(g.x) * sigmoidf_(v0[1] + b0[1]);
                            o[2] = bflo(g.y) * sigmoidf_(v0[2] + b0[2]); o[3] = bfhi(g.y) * sigmoidf_(v0[3] + b0[3]);
                            o[4] = bflo(g.z) * sigmoidf_(v1[0] + b1[0]); o[5] = bfhi(g.z) * sigmoidf_(v1[1] + b1[1]);
                            o[6] = bflo(g.w) * sigmoidf_(v1[2] + b1[2]); o[7] = bfhi(g.w) * sigmoidf_(v1[3] + b1[3]);
                            u32x4 w; w.x = cvt_pk_bf16(o[0], o[1]); w.y = cvt_pk_bf16(o[2], o[3]); w.z = cvt_pk_bf16(o[4], o[5]); w.w = cvt_pk_bf16(o[6], o[7]);
                            *(u32x4*)(a.O + (size_t)row * a.ldc + col) = w;
                        } else if (MODE == E_MERGE) {
                            const u32x4 g = gw[mm][bj];
                            f32x4 p0, p1;
                            p0[0] = bflo(g.x) * v0[0]; p0[1] = bfhi(g.x) * v0[1]; p0[2] = bflo(g.y) * v0[2]; p0[3] = bfhi(g.y) * v0[3];
                            p1[0] = bflo(g.z) * v1[0]; p1[1] = bfhi(g.z) * v1[1]; p1[2] = bflo(g.w) * v1[2]; p1[3] = bfhi(g.w) * v1[3];
                            if (nbr != 0) { p0 = p0 + xa[mm][bj]; p1 = p1 + xb[mm][bj]; }
                            u32x4 w; w.x = cvt_pk_bf16(p0[0], p0[1]); w.y = cvt_pk_bf16(p0[2], p0[3]); w.z = cvt_pk_bf16(p1[0], p1[1]); w.w = cvt_pk_bf16(p1[2], p1[3]);
                            if (nbr != 3) *(u32x4*)((bf16_t*)a.MF + (size_t)row * 1024 + col) = w;
                            else *(u32x4*)(a.O + (size_t)row * a.ldc + col) = w;
                        } else if (MODE == E_RESID) {
                            const int lr = row - pm * BM;
                            *(f32x4*)(xout + (size_t)lr * DM + col) = xa[mm][bj] + gb0[bj] * v0;
                            *(f32x4*)(xout + (size_t)lr * DM + col + 4) = xb[mm][bj] + gb1[bj] * v1;
                        }
                    }
            }
    }
};

template <class EpiT, class Sched>
__device__ __forceinline__ void gemm_phase(LAS unsigned char* lds, const Gemm g, const Sched& S, const EpiT& E) {
    int tid_ = threadIdx.x; asm volatile("" : "+v"(tid_));
    const int tid = tid_, wid = __builtin_amdgcn_readfirstlane(tid >> 6), lane = tid & 63, wr = wid >> 2, wc = wid & 3, fr = lane & 15, fq = lane >> 4;
    const int K = g.K, nt = K / BK;
    unsigned voffA[2], voffB[2];
#pragma unroll
    for (int i = 0; i < 2; ++i) { int R, C; stage_rc(tid * 16 + i * 8192, R, C); const int Rb = (R & ~31) + perm32(R & 31);
        voffA[i] = (unsigned)(R * K + C) * 2u; voffB[i] = (unsigned)(Rb * K + C) * 2u; }
    const size_t kstep = (size_t)(BK * 2);
    const size_t hstep = (size_t)HALF * K * 2;
    const size_t tstep = 2 * hstep;
    const unsigned ldsw = (unsigned)wid * 1024u;
    const int aoff = lds_byte(wr * 64 + fr, fq * 8), boff = lds_byte(wc * 32 + fr, fq * 8);
#define PG8_SA(b, h) (((b) * 2 + (h)) * HTB)
#define PG8_SB(b, h) ((4 + (b) * 2 + (h)) * HTB)
#define PG8_STAGE(bufoff, gbase, voff) do { _Pragma("unroll") for (int _i = 0; _i < 2; ++_i) \
        __builtin_amdgcn_global_load_lds((const unsigned*)((const char*)(gbase) + (voff)[_i]), (LAS unsigned*)(lds + (bufoff) + ldsw + _i * 8192), 16, 0, 0); } while (0)
#define PG8_LDA(dst, b, h) do { _Pragma("unroll") for (int m = 0; m < 4; ++m) _Pragma("unroll") for (int k = 0; k < 2; ++k) dst[m][k] = *(const LAS bf16x8*)(lds + PG8_SA(b, h) + aoff + m * 2048 + k * 1024); } while (0)
#define PG8_LDB(dst, b, h) do { _Pragma("unroll") for (int n = 0; n < 2; ++n) _Pragma("unroll") for (int k = 0; k < 2; ++k) dst[n][k] = *(const LAS bf16x8*)(lds + PG8_SB(b, h) + boff + n * 2048 + k * 1024); } while (0)
#define PG8_MMA(ai, bj, At, Bt) do { __builtin_amdgcn_s_setprio(1); _Pragma("unroll") for (int m = 0; m < 4; ++m) _Pragma("unroll") for (int n = 0; n < 2; ++n) _Pragma("unroll") for (int k = 0; k < 2; ++k) \
        acc[ai][bj][m][n] = __builtin_amdgcn_mfma_f32_16x16x32_bf16(Bt[n][k], At[m][k], acc[ai][bj][m][n], 0, 0, 0); __builtin_amdgcn_s_setprio(0); } while (0)
#define PG8_WAIT_V(n) asm volatile("s_waitcnt vmcnt(" #n ")" ::: "memory")
#define PG8_WAIT_L(n) asm volatile("s_waitcnt lgkmcnt(" #n ")" ::: "memory")
#define PG8_BAR __builtin_amdgcn_s_barrier()
#define PG8_SCHED __builtin_amdgcn_sched_barrier(0)
    Unit cur, nxt; int ui = 0;
    if (!S.next(0, cur)) return;
    f32x4 acc[2][2][4][2];
#pragma unroll
    for (int a = 0; a < 2; ++a)
#pragma unroll
        for (int b = 0; b < 2; ++b)
#pragma unroll
            for (int m = 0; m < 4; ++m)
#pragma unroll
                for (int n = 0; n < 2; ++n) acc[a][b][m][n] = (f32x4){0.f, 0.f, 0.f, 0.f};
    bf16x8 At[4][2], B0[2][2], B1[2][2];
    const char* cA = (const char*)g.A + (size_t)cur.pm * tstep; const char* cB = (const char*)g.Bt + (size_t)cur.pn * tstep;
    PG8_STAGE(PG8_SB(0, 0), cB, voffB); PG8_STAGE(PG8_SB(0, 1), cB + hstep, voffB); PG8_STAGE(PG8_SA(0, 0), cA, voffA); PG8_STAGE(PG8_SA(0, 1), cA + hstep, voffA);
    if (wr == 1) PG8_BAR;
    PG8_WAIT_V(2); PG8_BAR;
    PG8_STAGE(PG8_SB(1, 0), cB + kstep, voffB); PG8_STAGE(PG8_SA(1, 0), cA + kstep, voffA); PG8_STAGE(PG8_SB(1, 1), cB + hstep + kstep, voffB);
    PG8_WAIT_V(6); PG8_BAR;
    for (;;) {
        const bool has_next = S.next(ui + 1, nxt);
        const char* nA = has_next ? (const char*)g.A + (size_t)nxt.pm * tstep : cA; const char* nB = has_next ? (const char*)g.Bt + (size_t)nxt.pn * tstep : cB;
        for (int t = 0; t < nt; t += 2) {
            const bool last = (t == nt - 2);
            const char* a1 = cA + (size_t)(t + 1) * kstep;
            const char* a2 = last ? nA : cA + (size_t)(t + 2) * kstep; const char* b2 = last ? nB : cB + (size_t)(t + 2) * kstep;
            const char* a3 = a2 + kstep; const char* b3 = b2 + kstep;
            PG8_LDB(B0, 0, 0); PG8_LDB(B1, 0, 1); PG8_SCHED; PG8_LDA(At, 0, 0); PG8_STAGE(PG8_SA(1, 1), a1 + hstep, voffA);
            PG8_WAIT_V(8); PG8_WAIT_L(0); PG8_BAR; PG8_MMA(0, 0, At, B0); PG8_MMA(0, 1, At, B1); PG8_BAR; PG8_SCHED;
            PG8_LDA(At, 0, 1); PG8_STAGE(PG8_SB(0, 0), b2, voffB); PG8_STAGE(PG8_SB(0, 1), b2 + hstep, voffB); PG8_STAGE(PG8_SA(0, 0), a2, voffA);
            PG8_WAIT_V(8); PG8_WAIT_L(0); PG8_BAR; PG8_MMA(1, 0, At, B0); PG8_MMA(1, 1, At, B1); PG8_BAR; PG8_SCHED;
            PG8_LDB(B0, 1, 0); PG8_LDB(B1, 1, 1); PG8_SCHED; PG8_LDA(At, 1, 0); PG8_STAGE(PG8_SA(0, 1), a2 + hstep, voffA);
            PG8_WAIT_V(8); PG8_WAIT_L(0); PG8_BAR; PG8_MMA(0, 0, At, B0); PG8_MMA(0, 1, At, B1); PG8_BAR; PG8_SCHED;
            PG8_LDA(At, 1, 1); PG8_STAGE(PG8_SB(1, 0), b3, voffB); PG8_STAGE(PG8_SB(1, 1), b3 + hstep, voffB); PG8_STAGE(PG8_SA(1, 0), a3, voffA);
            PG8_WAIT_V(8); PG8_WAIT_L(0); PG8_BAR; PG8_MMA(1, 0, At, B0); PG8_MMA(1, 1, At, B1); PG8_BAR; PG8_SCHED;
        }
        if (wr == 0) PG8_BAR;
        E(acc, cur, wr, wc, fr, fq);
        if (!has_next) break;
#pragma unroll
        for (int a = 0; a < 2; ++a)
#pragma unroll
            for (int b = 0; b < 2; ++b)
#pragma unroll
                for (int m = 0; m < 4; ++m)
#pragma unroll
                    for (int n = 0; n < 2; ++n) acc[a][b][m][n] = (f32x4){0.f, 0.f, 0.f, 0.f};
        cur = nxt; cA = nA; cB = nB; ++ui;
        if (wr == 1) PG8_BAR;
    }
    PG8_WAIT_V(0);
    PG8_BAR;
#undef PG8_SA
#undef PG8_SB
#undef PG8_STAGE
#undef PG8_LDA
#undef PG8_LDB
#undef PG8_MMA
#undef PG8_WAIT_V
#undef PG8_WAIT_L
#undef PG8_BAR
#undef PG8_SCHED
}
}

#ifndef QKT_SB_FROM
#define QKT_SB_FROM 100000
#endif
#ifndef QKT_SB_EVERY
#define QKT_SB_EVERY 4
#endif
#ifndef ATT_SD1_FROM
#define ATT_SD1_FROM 128
#endif
namespace att {
constexpr int NW = 8, QBLK = 32, KVBLK = 64;
constexpr float THR = 8.f;
constexpr int SHM_V = KVBLK * 128 * 2;
#define SBAR() __builtin_amdgcn_sched_barrier(0)
__device__ __forceinline__ int crow(int r, int hi) { return (r & 3) + 8 * (r >> 2) + 4 * hi; }
template <int DQK> __device__ __forceinline__ constexpr float scale_of() { return DQK == 64 ? 0.125f : (DQK == 128 ? 0.088388347648318440f : 0.072168783648703220f); }

template <int DQK>
__device__ __forceinline__ void partialSM(f32x16& p0, f32x16& p1, float& m_reg, float& mn, float& alpha) {
    constexpr float SCALE = scale_of<DQK>();
    constexpr float C = SCALE * 1.4426950408889634f;
    float pmax = p0[0];
#pragma unroll
    for (int r = 1; r < 16; ++r) pmax = fmaxf(pmax, p0[r]);
#pragma unroll
    for (int r = 0; r < 16; ++r) pmax = fmaxf(pmax, p1[r]);
    { auto rr = __builtin_amdgcn_permlane32_swap(__float_as_uint(pmax), __float_as_uint(pmax), false, false);
      pmax = fmaxf(__uint_as_float(rr[0]), __uint_as_float(rr[1])); }
    if (__builtin_expect(__all(pmax - m_reg <= THR / SCALE), 1)) { mn = m_reg; alpha = 1.f; }
    else { mn = fmaxf(m_reg, pmax); alpha = __builtin_amdgcn_exp2f((m_reg - mn) * C); m_reg = mn; }
    float mnC = -mn * C;
#pragma unroll
    for (int r = 0; r < 16; ++r) p0[r] = fmaf(p0[r], C, mnC);
#pragma unroll
    for (int r = 0; r < 16; ++r) p1[r] = fmaf(p1[r], C, mnC);
#pragma unroll
    for (int r = 0; r < 16; ++r) p0[r] = __builtin_amdgcn_exp2f(p0[r]);
}
__device__ __forceinline__ void finishSM(f32x16& p0, f32x16& p1, float alpha, float& l_reg, bf16x8& pa0, bf16x8& pa1, bf16x8& pa2, bf16x8& pa3) {
#pragma unroll
    for (int r = 0; r < 16; ++r) p1[r] = __builtin_amdgcn_exp2f(p1[r]);
    float ps = 0;
#pragma unroll
    for (int r = 0; r < 16; ++r) ps += p0[r];
#pragma unroll
    for (int r = 0; r < 16; ++r) ps += p1[r];
    { auto rr = __builtin_amdgcn_permlane32_swap(__float_as_uint(ps), __float_as_uint(ps), false, false);
      ps = __uint_as_float(rr[0]) + __uint_as_float(rr[1]); }
    l_reg = l_reg * alpha + ps;
#define PK4(P, BASE, OUT) do { unsigned a0 = cvt_pk_bf16(P[BASE + 0], P[BASE + 1]), a1 = cvt_pk_bf16(P[BASE + 2], P[BASE + 3]);   \
    unsigned b0 = cvt_pk_bf16(P[BASE + 4], P[BASE + 5]), b1 = cvt_pk_bf16(P[BASE + 6], P[BASE + 7]);                              \
    auto r0 = __builtin_amdgcn_permlane32_swap(a0, b0, false, false); auto r1 = __builtin_amdgcn_permlane32_swap(a1, b1, false, false); \
    u32x4 w = {r0[0], r1[0], r0[1], r1[1]}; OUT = *reinterpret_cast<bf16x8*>(&w); } while (0)
    PK4(p0, 0, pa0); PK4(p0, 8, pa1); PK4(p1, 0, pa2); PK4(p1, 8, pa3);
#undef PK4
}
template <int DQK, int QL = 0>
__device__ __forceinline__ void qkt(f32x16& p0, f32x16& p1, const char* Ks, const bf16x8* qr, int r32, int hi, const char* Qs = nullptr) {
    p0 = f32x16{}; p1 = f32x16{};
#pragma unroll
    for (int d0 = 0; d0 < DQK / 16; ++d0) { const int cb = (d0 * 16 + hi * 8) * 2;
        bf16x8 b0 = *reinterpret_cast<const bf16x8*>(Ks + r32 * (DQK * 2) + (cb ^ ((r32 & 7) << 4)));
        bf16x8 b1 = *reinterpret_cast<const bf16x8*>(Ks + (32 + r32) * (DQK * 2) + (cb ^ ((r32 & 7) << 4)));
        bf16x8 q;
        if (d0 < DQK / 16 - QL) q = qr[d0]; else q = *reinterpret_cast<const bf16x8*>(Qs + (d0 - (DQK / 16 - QL)) * 1024);
        p0 = __builtin_amdgcn_mfma_f32_32x32x16_bf16(b0, q, p0, 0, 0, 0);
        p1 = __builtin_amdgcn_mfma_f32_32x32x16_bf16(b1, q, p1, 0, 0, 0);
        if (DQK > QKT_SB_FROM && (d0 % QKT_SB_EVERY) == QKT_SB_EVERY - 1) SBAR(); }
}
__device__ __forceinline__ int v_st(int k, int c) { const int kk = (k & ~0xC) | ((k & 4) << 1) | ((k & 8) >> 1); return ((kk >> 3) * 4 + (c >> 5)) * 512 + ((kk & 7) * 32 + (c & 31)) * 2; }
__device__ __forceinline__ int v_rd_base(int lane) { return ((lane & 3) << 3) | (((lane >> 2) & 3) << 6) | (((lane >> 4) & 1) << 5) | (((lane >> 5) & 1) << 8); }
constexpr int v_rd_off(int d0, int ks, int half) { return d0 * 512 + ks * 4096 + half * 2048; }
template <int OFF> __device__ __forceinline__ s16x4 tr_read(int vb) {
    s16x4 r; asm volatile("ds_read_b64_tr_b16 %0, %1 offset:%2" : "=&v"(r) : "v"(vb), "i"(OFF) : "memory"); return r;
}
template <int D0> __device__ __forceinline__ void pv_one(f32x16& od, int vb, bf16x8 pa0, bf16x8 pa1, bf16x8 pa2, bf16x8 pa3) {
    const s16x4 l0 = tr_read<v_rd_off(D0, 0, 0)>(vb), h0 = tr_read<v_rd_off(D0, 0, 1)>(vb), l1 = tr_read<v_rd_off(D0, 1, 0)>(vb), h1 = tr_read<v_rd_off(D0, 1, 1)>(vb);
    const s16x4 l2 = tr_read<v_rd_off(D0, 2, 0)>(vb), h2 = tr_read<v_rd_off(D0, 2, 1)>(vb), l3 = tr_read<v_rd_off(D0, 3, 0)>(vb), h3 = tr_read<v_rd_off(D0, 3, 1)>(vb);
    asm volatile("s_waitcnt lgkmcnt(0)" ::: "memory"); SBAR();
#define PK(L, H) (bf16x8){L[0], L[1], L[2], L[3], H[0], H[1], H[2], H[3]}
    od = __builtin_amdgcn_mfma_f32_32x32x16_bf16(pa0, PK(l0, h0), od, 0, 0, 0);
    od = __builtin_amdgcn_mfma_f32_32x32x16_bf16(pa1, PK(l1, h1), od, 0, 0, 0);
    od = __builtin_amdgcn_mfma_f32_32x32x16_bf16(pa2, PK(l2, h2), od, 0, 0, 0);
    od = __builtin_amdgcn_mfma_f32_32x32x16_bf16(pa3, PK(l3, h3), od, 0, 0, 0);
#undef PK
}
__device__ __forceinline__ void pv_d0(f32x16* o, int vb, bf16x8 pa0, bf16x8 pa1, bf16x8 pa2, bf16x8 pa3) {
    pv_one<0>(o[0], vb, pa0, pa1, pa2, pa3); pv_one<1>(o[1], vb, pa0, pa1, pa2, pa3); pv_one<2>(o[2], vb, pa0, pa1, pa2, pa3); pv_one<3>(o[3], vb, pa0, pa1, pa2, pa3);
}

template <int DQK, int ldq, int ldk, int ldv, int ldo, int QL = 0>
__device__ __forceinline__ void attn_body(const bf16_t* __restrict__ Qb, const bf16_t* __restrict__ Kh, const bf16_t* __restrict__ Vh,
                                          bf16_t* __restrict__ Ob, int seq, char* lds) {
    constexpr int SHM_K = KVBLK * DQK * 2, NKC = DQK / 64, SD = (DQK >= ATT_SD1_FROM) ? 1 : 2, CPR = DQK / 8;
    int tid_ = threadIdx.x; asm volatile("" : "+v"(tid_));
    const int tid = tid_, wid = tid >> 6, lane = tid & 63, r32 = lane & 31, hi = lane >> 5;
    char* V_lds = lds; char* K_lds = lds + 2 * SHM_V;
    float* ws = (float*)(lds + 2 * SHM_V + 2 * SHM_K) + wid * 64; float* li_l = ws; float* al_l = ws + 32;
    constexpr int NQR = DQK / 16 - QL;
    float m_reg = -1e30f, l_reg = 0; f32x16 o[4] = {}; bf16x8 qr[NQR];
    const bf16_t* Qw = Qb + (long)(wid * QBLK + r32) * ldq + hi * 8;
#pragma unroll
    for (int d0 = 0; d0 < NQR; ++d0) qr[d0] = *reinterpret_cast<const bf16x8*>(Qw + d0 * 16);
    char* Qs = lds + 2 * SHM_V + 2 * SHM_K + NW * 256 + wid * (QL * 1024) + lane * 16;
#pragma unroll
    for (int d0 = 0; d0 < QL; ++d0) *reinterpret_cast<bf16x8*>(Qs + d0 * 1024) = *reinterpret_cast<const bf16x8*>(Qw + (NQR + d0) * 16);
    const int sr = tid >> 4, sc = (tid & 15) * 8, vst0 = v_st(sr, sc), vst1 = v_st(32 + sr, sc);
    unsigned koff[NKC]; int kdst[NKC];
    const unsigned voffV0 = (unsigned)(sr * ldv + sc) * 2u, voffV1 = (unsigned)((32 + sr) * ldv + sc) * 2u;
#pragma unroll
    for (int kc = 0; kc < NKC; ++kc) { const int ci = tid + 512 * kc; const int krow = ci / CPR, kcol = (ci % CPR) * 8; koff[kc] = (unsigned)(krow * ldk + kcol) * 2u;
        kdst[kc] = krow * (DQK * 2) + ((kcol * 2) ^ ((krow & 7) << 4)); }
    const int vb0 = (int)(uintptr_t)V_lds + v_rd_base(lane);
    struct { bf16x8 vs0, vs1, ks[NKC]; } sr_[SD];
#define SLOAD(i, k0) do { const char* vb_ = (const char*)Vh + (size_t)(k0) * (ldv * 2); const char* kb_ = (const char*)Kh + (size_t)(k0) * (ldk * 2); \
    sr_[i].vs0 = *reinterpret_cast<const bf16x8*>(vb_ + voffV0); sr_[i].vs1 = *reinterpret_cast<const bf16x8*>(vb_ + voffV1); \
    _Pragma("unroll") for (int kc_ = 0; kc_ < NKC; ++kc_) sr_[i].ks[kc_] = *reinterpret_cast<const bf16x8*>(kb_ + koff[kc_]); } while (0)
#define SWRITE(b, i) do { *(bf16x8*)(V_lds + (b) * SHM_V + vst0) = sr_[i].vs0; *(bf16x8*)(V_lds + (b) * SHM_V + vst1) = sr_[i].vs1; \
    _Pragma("unroll") for (int kc_ = 0; kc_ < NKC; ++kc_) *(bf16x8*)(K_lds + (b) * SHM_K + kdst[kc_]) = sr_[i].ks[kc_]; } while (0)
#define SWAIT() do { if constexpr (SD == 2) asm volatile("s_waitcnt vmcnt(%0)" :: "n"(2 + NKC) : "memory"); else asm volatile("s_waitcnt vmcnt(0)" ::: "memory"); } while (0)
#define RESC(a) do { if (__any((a) < 1.f)) { if (hi == 0) al_l[r32] = (a); asm volatile("s_waitcnt lgkmcnt(0)" ::: "memory"); \
    _Pragma("unroll") for (int d = 0; d < 4; ++d) _Pragma("unroll") for (int r = 0; r < 16; ++r) o[d][r] *= al_l[crow(r, hi)]; } } while (0)
    f32x16 pA0, pA1, pB0, pB1; float mnA, mnB, alA, alB; bf16x8 pa0, pa1, pa2, pa3; const int NT = seq / KVBLK;
    constexpr int SE = 0, SO = SD - 1;
    SLOAD(SE, 0); asm volatile("s_waitcnt vmcnt(0)" ::: "memory"); SWRITE(0, SE); __syncthreads();
    qkt<DQK, QL>(pA0, pA1, K_lds, qr, r32, hi, Qs); partialSM<DQK>(pA0, pA1, m_reg, mnA, alA);
    SLOAD(SO, KVBLK); if constexpr (SD == 2) { if (2 < NT) SLOAD(SE, 2 * KVBLK); }
    SWAIT(); SWRITE(1, SO); __syncthreads();
    for (int j = 1; j + 1 < NT; j += 2) {
        SBAR(); qkt<DQK, QL>(pB0, pB1, K_lds + SHM_K, qr, r32, hi, Qs);
        finishSM(pA0, pA1, alA, l_reg, pa0, pa1, pa2, pa3); SBAR();
        SLOAD(SO, (j + SD) * KVBLK); SBAR();
        pv_d0(o, vb0, pa0, pa1, pa2, pa3); partialSM<DQK>(pB0, pB1, m_reg, mnB, alB);
        __syncthreads(); SWAIT(); SWRITE(0, SE);
        RESC(alB); __syncthreads();
        SBAR(); qkt<DQK, QL>(pA0, pA1, K_lds, qr, r32, hi, Qs);
        finishSM(pB0, pB1, alB, l_reg, pa0, pa1, pa2, pa3); SBAR();
        if (SD == 1 || j + 3 < NT) SLOAD(SE, (j + 1 + SD) * KVBLK); SBAR();
        pv_d0(o, vb0 + (int)SHM_V, pa0, pa1, pa2, pa3); partialSM<DQK>(pA0, pA1, m_reg, mnA, alA);
        __syncthreads(); SWAIT(); SWRITE(1, SO);
        RESC(alA); __syncthreads();
    }
    SBAR(); qkt<DQK, QL>(pB0, pB1, K_lds + SHM_K, qr, r32, hi, Qs);
    finishSM(pA0, pA1, alA, l_reg, pa0, pa1, pa2, pa3); SBAR();
    pv_d0(o, vb0, pa0, pa1, pa2, pa3); partialSM<DQK>(pB0, pB1, m_reg, mnB, alB);
    __syncthreads(); RESC(alB);
    finishSM(pB0, pB1, alB, l_reg, pa0, pa1, pa2, pa3); SBAR();
    pv_d0(o, vb0 + (int)SHM_V, pa0, pa1, pa2, pa3);
    if (hi == 0) li_l[r32] = l_reg; asm volatile("s_waitcnt lgkmcnt(0)" ::: "memory");
    float rli[16];
#pragma unroll
    for (int r = 0; r < 16; ++r) rli[r] = __builtin_amdgcn_rcpf(li_l[crow(r, hi)]);
    bf16_t* Ow = Ob + (long)(wid * QBLK) * ldo;
#pragma unroll
    for (int r = 0; r < 16; ++r) { const int orow = crow(r, hi);
#pragma unroll
        for (int d0 = 0; d0 < 4; ++d0) Ow[(long)orow * ldo + d0 * 32 + r32] = f2bf(o[d0][r] * rli[r]); }
    __syncthreads();
#undef SLOAD
#undef SWRITE
#undef SWAIT
#undef RESC
}

template <int DQK, int ldq, int ldk, int ldv, int ldo>
__device__ __forceinline__ void attn_body_simple(const bf16_t* __restrict__ Qb, const bf16_t* __restrict__ Kh, const bf16_t* __restrict__ Vh,
                                                 bf16_t* __restrict__ Ob, int seq, char* lds) {
    constexpr int SHM_K = KVBLK * DQK * 2, NKC = DQK / 64, CPR = DQK / 8;
    int tid_ = threadIdx.x; asm volatile("" : "+v"(tid_));
    const int tid = tid_, wid = tid >> 6, lane = tid & 63, r32 = lane & 31, hi = lane >> 5;
    char* V_lds = lds; char* K_lds = lds + 2 * SHM_V;
    float* ws = (float*)(lds + 2 * SHM_V + 2 * SHM_K) + wid * 64; float* li_l = ws; float* al_l = ws + 32;
    float m_reg = -1e30f, l_reg = 0; f32x16 o[4] = {}; bf16x8 qr[DQK / 16];
    const bf16_t* Qw = Qb + (long)(wid * QBLK + r32) * ldq + hi * 8;
#pragma unroll
    for (int d0 = 0; d0 < DQK / 16; ++d0) qr[d0] = *reinterpret_cast<const bf16x8*>(Qw + d0 * 16);
    const int sr = tid >> 4, sc = (tid & 15) * 8, vst0 = v_st(sr, sc), vst1 = v_st(32 + sr, sc);
    unsigned koff[NKC]; int kdst[NKC];
    const unsigned voffV0 = (unsigned)(sr * ldv + sc) * 2u, voffV1 = (unsigned)((32 + sr) * ldv + sc) * 2u;
#pragma unroll
    for (int kc = 0; kc < NKC; ++kc) { const int ci = tid + 512 * kc; const int krow = ci / CPR, kcol = (ci % CPR) * 8; koff[kc] = (unsigned)(krow * ldk + kcol) * 2u;
        kdst[kc] = krow * (DQK * 2) + ((kcol * 2) ^ ((krow & 7) << 4)); }
    const int vb0 = (int)(uintptr_t)V_lds + v_rd_base(lane);
    bf16x8 vs0, vs1, ks[NKC];
#define SLOAD1(k0) do { const char* vb_ = (const char*)Vh + (size_t)(k0) * (ldv * 2); const char* kb_ = (const char*)Kh + (size_t)(k0) * (ldk * 2); \
    vs0 = *reinterpret_cast<const bf16x8*>(vb_ + voffV0); vs1 = *reinterpret_cast<const bf16x8*>(vb_ + voffV1); \
    _Pragma("unroll") for (int kc_ = 0; kc_ < NKC; ++kc_) ks[kc_] = *reinterpret_cast<const bf16x8*>(kb_ + koff[kc_]); } while (0)
#define SWRITE1(b) do { *(bf16x8*)(V_lds + (b) * SHM_V + vst0) = vs0; *(bf16x8*)(V_lds + (b) * SHM_V + vst1) = vs1; \
    _Pragma("unroll") for (int kc_ = 0; kc_ < NKC; ++kc_) *(bf16x8*)(K_lds + (b) * SHM_K + kdst[kc_]) = ks[kc_]; } while (0)
    f32x16 pA0, pA1; float mnA, alA; bf16x8 pa0, pa1, pa2, pa3; const int NT = seq / KVBLK;
    SLOAD1(0); asm volatile("s_waitcnt vmcnt(0)" ::: "memory"); SWRITE1(0); __syncthreads();
    for (int j = 0; j < NT; ++j) {
        const int buf = j & 1;
        if (j + 1 < NT) SLOAD1((j + 1) * KVBLK);
        SBAR();
        qkt<DQK>(pA0, pA1, K_lds + buf * SHM_K, qr, r32, hi);
        partialSM<DQK>(pA0, pA1, m_reg, mnA, alA);
        if (__any(alA < 1.f)) { if (hi == 0) al_l[r32] = alA; asm volatile("s_waitcnt lgkmcnt(0)" ::: "memory");
#pragma unroll
            for (int d = 0; d < 4; ++d)
#pragma unroll
                for (int r = 0; r < 16; ++r) o[d][r] *= al_l[crow(r, hi)]; }
        finishSM(pA0, pA1, alA, l_reg, pa0, pa1, pa2, pa3); SBAR();
        pv_d0(o, vb0 + buf * (int)SHM_V, pa0, pa1, pa2, pa3);
        if (j + 1 < NT) { asm volatile("s_waitcnt vmcnt(0)" ::: "memory"); SWRITE1(buf ^ 1); }
        __syncthreads();
    }
    if (hi == 0) li_l[r32] = l_reg; asm volatile("s_waitcnt lgkmcnt(0)" ::: "memory");
    float rli[16];
#pragma unroll
    for (int r = 0; r < 16; ++r) rli[r] = __builtin_amdgcn_rcpf(li_l[crow(r, hi)]);
    bf16_t* Ow = Ob + (long)(wid * QBLK) * ldo;
#pragma unroll
    for (int r = 0; r < 16; ++r) { const int orow = crow(r, hi);
#pragma unroll
        for (int d0 = 0; d0 < 4; ++d0) Ow[(long)orow * ldo + d0 * 32 + r32] = f2bf(o[d0][r] * rli[r]); }
    __syncthreads();
#undef SLOAD1
#undef SWRITE1
}

template <int DQK, int ldq, int ldk, int ldv, int ldo>
__device__ __forceinline__ void attn_body_dma(const bf16_t* __restrict__ Qb, const bf16_t* __restrict__ Kh, const bf16_t* __restrict__ Vh,
                                              bf16_t* __restrict__ Ob, int seq, char* lds) {
    constexpr int SHM_K = KVBLK * DQK * 2, NKC = DQK / 64;
    int tid_ = threadIdx.x; asm volatile("" : "+v"(tid_));
    const int tid = tid_, wid = __builtin_amdgcn_readfirstlane(tid >> 6), lane = tid & 63, r32 = lane & 31, hi = lane >> 5;
    char* V_lds = lds; char* K_lds = lds + 2 * SHM_V;
    float* ws = (float*)(lds + 2 * SHM_V + 2 * SHM_K) + wid * 64; float* li_l = ws; float* al_l = ws + 32;
    float m_reg = -1e30f, l_reg = 0; f32x16 o[4] = {}; bf16x8 qr[DQK / 16];
    const bf16_t* Qw = Qb + (long)(wid * QBLK + r32) * ldq + hi * 8;
#pragma unroll
    for (int d0 = 0; d0 < DQK / 16; ++d0) qr[d0] = *reinterpret_cast<const bf16x8*>(Qw + d0 * 16);
    unsigned vsrc[2], ksrc[NKC];
#pragma unroll
    for (int i = 0; i < 2; ++i) { const int o_ = i * 8192 + tid * 16; const int sub = o_ >> 9, w_ = (o_ & 511) >> 1; const int kk = (sub >> 2) * 8 + (w_ >> 5), c = (sub & 3) * 32 + (w_ & 31);
        const int k = (kk & ~0xC) | ((kk & 4) << 1) | ((kk & 8) >> 1); vsrc[i] = (unsigned)(k * ldv + c) * 2u; }
#pragma unroll
    for (int i = 0; i < NKC; ++i) { const int o_ = i * 8192 + tid * 16; const int row = o_ / (DQK * 2), b = o_ % (DQK * 2); const int cb = b ^ ((row & 7) << 4);
        ksrc[i] = (unsigned)(row * ldk) * 2u + (unsigned)cb; }
    const unsigned vdst = (unsigned)(uintptr_t)V_lds + (unsigned)wid * 1024u, kdst0 = (unsigned)(uintptr_t)K_lds + (unsigned)wid * 1024u;
    const int vb0 = (int)(uintptr_t)V_lds + v_rd_base(lane);
#define DMA_TILE(k0, b) do { const char* vb_ = (const char*)Vh + (size_t)(k0) * (ldv * 2); const char* kb_ = (const char*)Kh + (size_t)(k0) * (ldk * 2); \
    _Pragma("unroll") for (int i_ = 0; i_ < 2; ++i_) __builtin_amdgcn_global_load_lds((const unsigned*)(vb_ + vsrc[i_]), (LAS unsigned*)(vdst + (b) * SHM_V + i_ * 8192), 16, 0, 0); \
    _Pragma("unroll") for (int i_ = 0; i_ < NKC; ++i_) __builtin_amdgcn_global_load_lds((const unsigned*)(kb_ + ksrc[i_]), (LAS unsigned*)(kdst0 + (b) * SHM_K + i_ * 8192), 16, 0, 0); } while (0)
    f32x16 pA0, pA1; float mnA, alA; bf16x8 pa0, pa1, pa2, pa3; const int NT = seq / KVBLK;
    DMA_TILE(0, 0); asm volatile("s_waitcnt vmcnt(0)" ::: "memory"); __syncthreads();
    for (int j = 0; j < NT; ++j) {
        const int buf = j & 1;
        if (j + 1 < NT) DMA_TILE((j + 1) * KVBLK, buf ^ 1);
        SBAR();
        qkt<DQK>(pA0, pA1, K_lds + buf * SHM_K, qr, r32, hi);
        partialSM<DQK>(pA0, pA1, m_reg, mnA, alA);
        if (__any(alA < 1.f)) { if (hi == 0) al_l[r32] = alA; asm volatile("s_waitcnt lgkmcnt(0)" ::: "memory");
#pragma unroll
            for (int d = 0; d < 4; ++d)
#pragma unroll
                for (int r = 0; r < 16; ++r) o[d][r] *= al_l[crow(r, hi)]; }
        finishSM(pA0, pA1, alA, l_reg, pa0, pa1, pa2, pa3); SBAR();
        pv_d0(o, vb0 + buf * (int)SHM_V, pa0, pa1, pa2, pa3);
        asm volatile("s_waitcnt vmcnt(0)" ::: "memory");
        __syncthreads();
    }
    if (hi == 0) li_l[r32] = l_reg; asm volatile("s_waitcnt lgkmcnt(0)" ::: "memory");
    float rli[16];
#pragma unroll
    for (int r = 0; r < 16; ++r) rli[r] = __builtin_amdgcn_rcpf(li_l[crow(r, hi)]);
    bf16_t* Ow = Ob + (long)(wid * QBLK) * ldo;
#pragma unroll
    for (int r = 0; r < 16; ++r) { const int orow = crow(r, hi);
#pragma unroll
        for (int d0 = 0; d0 < 4; ++d0) Ow[(long)orow * ldo + d0 * 32 + r32] = f2bf(o[d0][r] * rli[r]); }
    __syncthreads();
#undef DMA_TILE
}
}

__device__ __forceinline__ unsigned pk2(float lo, float hi) { return cvt_pk_bf16(lo, hi); }

__device__ __forceinline__ void transpose_mat(const float* W, int K, int Nsrc, bf16_t* WT, int Ndst, int mode, LAS float* scr, int gw, int NGW, int lane) {
    const int nblk = Ndst / 32, nitems = (K / 64) * nblk;
    for (int item = gw; item < nitems; item += NGW) {
        const int kb = item / nblk, nb = item % nblk, k0 = 64 * kb, n0 = 32 * nb;
        int s0 = n0;
        if (mode == 1) s0 = n0 < 3520 ? n0 : (n0 < 3584 ? -1 : n0 - 64);
        if (mode == 2) { const int pn = n0 >> 8, j = n0 & 255; s0 = j < 128 ? 128 * pn + j : DFF + 128 * pn + (j - 128); }
        float wv[32];
#pragma unroll
        for (int i = 0; i < 32; ++i) { const int kk = 2 * i + (lane >> 5); wv[i] = s0 < 0 ? 0.f : W[(size_t)(k0 + kk) * Nsrc + s0 + (lane & 31)]; }
#pragma unroll
        for (int i = 0; i < 32; ++i) { const int kk = 2 * i + (lane >> 5); scr[kk * 33 + (lane & 31)] = wv[i]; }
        asm volatile("s_waitcnt lgkmcnt(0)" ::: "memory");
        const int c = lane & 7;
#pragma unroll
        for (int j = 0; j < 4; ++j) { const int n = (lane >> 3) + 8 * j; const LAS float* s = scr + (8 * c) * 33 + n;
            u32x4 o; o.x = pk2(s[0 * 33], s[1 * 33]); o.y = pk2(s[2 * 33], s[3 * 33]); o.z = pk2(s[4 * 33], s[5 * 33]); o.w = pk2(s[6 * 33], s[7 * 33]);
            *(u32x4*)(WT + (size_t)(n0 + n) * K + k0 + 8 * c) = o; }
        asm volatile("s_waitcnt lgkmcnt(0)" ::: "memory");
    }
}

__device__ __forceinline__ void ph_prologue(const Params& p, LAS unsigned char* lds) {
    const int tid = otid(), wave = tid >> 6, lane = tid & 63;
    const int gw = obid() * 8 + wave, NGW = gridDim.x * 8;
    LAS float* scr = (LAS float*)(lds + wave * 16384);
    for (int l = 0; l < 2; ++l) {
        bf16_t* Wl = (bf16_t*)(p.ws + WS_W + l * W_LAYER_B);
        transpose_mat(p.in[7] + (size_t)l * 1024 * 7616, 1024, 7616, Wl + W_IN, 7680, 1, scr, gw, NGW, lane);
        transpose_mat(p.in[26] + (size_t)l * 256 * 768, 256, 768, Wl + W_UQ, 768, 0, scr, gw, NGW, lane);
        transpose_mat(p.in[27] + (size_t)l * 128 * 1024, 128, 1024, Wl + W_UKV, 1024, 0, scr, gw, NGW, lane);
        transpose_mat(p.in[16] + (size_t)l * 512 * 512, 512, 512, Wl + W_GLU, 512, 0, scr, gw, NGW, lane);
        for (int n = 0; n < 4; ++n) transpose_mat(p.in[30] + ((size_t)l * 4 + n) * 512 * 1024, 512, 1024, Wl + W_BR + (size_t)n * 1024 * 512, 1024, 0, scr, gw, NGW, lane);
        transpose_mat(p.in[31] + (size_t)l * 1024 * 1024, 1024, 1024, Wl + W_OUT, 1024, 0, scr, gw, NGW, lane);
        transpose_mat(p.in[33] + (size_t)l * 1024 * 5632, 1024, 5632, Wl + W_FI, 5632, 2, scr, gw, NGW, lane);
        transpose_mat(p.in[34] + (size_t)l * 2816 * 1024, 2816, 1024, Wl + W_FO, 1024, 0, scr, gw, NGW, lane);
    }
    {
        typedef float f32x2t __attribute__((ext_vector_type(2)));
        f32x2t* T64 = (f32x2t*)(p.ws + WS_ROPE64); f32x2t* T128 = (f32x2t*)(p.ws + WS_ROPE128);
        for (int idx = obid() * 512 + tid; idx < 128 * 16 + 128 * 32; idx += gridDim.x * 512) {
            if (idx < 128 * 16) { const int pos = idx >> 4, k = idx & 15; const float ang = (float)pos * exp2f(-(float)(4 * k) * (13.287712379549449f / 64)); T64[idx] = (f32x2t){cosf(ang), sinf(ang)}; }
            else { const int i2 = idx - 128 * 16, pos = i2 >> 5, k = i2 & 31; const float ang = (float)pos * exp2f(-(float)(4 * k) * (13.287712379549449f / 128)); T128[i2] = (f32x2t){cosf(ang), sinf(ang)}; }
        }
    }
    __syncthreads();
    LAS float* sc = (LAS float*)lds;
    LAS float* part = (LAS float*)(lds + 32768);
    float* MOD = (float*)(p.ws + WS_MOD);
    for (int it = obid(); it < 2 * 96; it += gridDim.x) {
        const int l = it / 96, cb = it % 96;
        for (int idx = tid; idx < 5 * 1024; idx += 512) { const int mi = idx >> 10, k = idx & 1023; const float v = mi < 4 ? p.in[1][mi * 1024 + k] : p.in[3][k]; sc[idx] = v / (1.f + __expf(-v)); }
        __syncthreads();
        const int j = cb * 64 + lane; const float* wm = p.in[4] + (size_t)l * 1024 * MODW + j;
        float a0 = 0, a1 = 0, a2 = 0, a3 = 0, a4 = 0;
#pragma unroll 32
        for (int kk = 0; kk < 128; ++kk) { const int k = wave * 128 + kk; const float w = wm[(size_t)k * MODW];
            a0 += sc[k] * w; a1 += sc[1024 + k] * w; a2 += sc[2048 + k] * w; a3 += sc[3072 + k] * w; a4 += sc[4096 + k] * w; }
        part[(wave * 5 + 0) * 64 + lane] = a0; part[(wave * 5 + 1) * 64 + lane] = a1; part[(wave * 5 + 2) * 64 + lane] = a2; part[(wave * 5 + 3) * 64 + lane] = a3; part[(wave * 5 + 4) * 64 + lane] = a4;
        __syncthreads();
        if (tid < 320) { const int mi = tid >> 6, jj = tid & 63; float s = 0;
#pragma unroll
            for (int w = 0; w < 8; ++w) s += part[(w * 5 + mi) * 64 + jj];
            MOD[((size_t)l * 5 + mi) * MODW + cb * 64 + jj] = s + p.in[5][l * MODW + cb * 64 + jj]; }
        __syncthreads();
    }
}

__device__ __forceinline__ const float* row_src(int R, const float* xl, const float* xc, int& mi) {
    const int b = R / RB, s = R - b * RB;
    if (s < CTX) { mi = 4; return xc + ((size_t)b * CTX + s) * DM; }
    mi = b; return xl + ((size_t)b * SEQ + (s - CTX)) * DM;
}
__device__ __forceinline__ void nm_finish(const f32x4 (&v)[4], int R, int mi, int lane, const float* gain, const float* modl, int sh_chunk, bf16_t* H) {
    const float* shp = modl + (size_t)mi * MODW + sh_chunk * 1024; const float* scp = shp + 1024;
    float ss = 0.f;
#pragma unroll
    for (int j = 0; j < 4; ++j) ss += (v[j].x * v[j].x + v[j].y * v[j].y) + (v[j].z * v[j].z + v[j].w * v[j].w);
    const float rs = rsqrtf(wave_sum(ss) * (1.f / DM) + EPS);
#pragma unroll
    for (int j = 0; j < 4; ++j) { const int c = j * 256 + lane * 4;
        const f32x4 g = *(const f32x4*)(gain + c), sh = *(const f32x4*)(shp + c), sc = *(const f32x4*)(scp + c);
        const f32x4 y = (v[j] * rs * g) * (sc + 1.0f) + sh;
        u32x2 w; w.x = cvt_pk_bf16(y.x, y.y); w.y = cvt_pk_bf16(y.z, y.w);
        *(u32x2*)(H + (size_t)R * DM + c) = w; }
}
__device__ __forceinline__ void ph_norm_mod(const float* xl, const float* xc, const float* gain, const float* modl, int sh_chunk, bf16_t* H) {
    const int tid = otid(); const int lane = tid & 63, gw = obid() * 8 + (tid >> 6), NGW = gridDim.x * 8;
    for (int R = gw; R < MTOT; R += 2 * NGW) {
        const int R2 = R + NGW; const bool has2 = R2 < MTOT;
        int mi, mi2 = 0; const float* xr = row_src(R, xl, xc, mi); const float* xr2 = has2 ? row_src(R2, xl, xc, mi2) : xr;
        f32x4 v[4], v2[4];
#pragma unroll
        for (int j = 0; j < 4; ++j) v[j] = *(const f32x4*)(xr + j * 256 + lane * 4);
#pragma unroll
        for (int j = 0; j < 4; ++j) v2[j] = *(const f32x4*)(xr2 + j * 256 + lane * 4);
        nm_finish(v, R, mi, lane, gain, modl, sh_chunk, H);
        if (has2) nm_finish(v2, R2, mi2, lane, gain, modl, sh_chunk, H);
    }
}

__device__ __forceinline__ int s5_pos(int i, int dir) { return dir == 0 ? i : (i < CTX ? (CTX - 1 - i) : (RB + CTX - 1 - i)); }
__device__ __forceinline__ void s5_chain(const Params& p, int layer, int unit, LAS unsigned char* lds) {
    const int b = unit >> 6, dir = (unit >> 5) & 1, g = unit & 31;
    const int tid = otid(), wid = tid >> 6, lane = tid & 63, fr = lane & 15, quad = lane >> 4;
    LAS float* BU = (LAS float*)lds;
    LAS bf16_t* Hb = (LAS bf16_t*)(lds + 65536);
    const int ldg = ((layer * 2 + dir) * 32 + g);
    const float* lam_re = p.in[8] + (size_t)ldg * 64; const float* lam_im = p.in[9] + (size_t)ldg * 64;
    const float dt = expf(p.in[10][ldg]);
    const float* bre = p.in[11] + (size_t)ldg * 64 * 16; const float* bim = p.in[12] + (size_t)ldg * 64 * 16;
    const float* cre = p.in[13] + (size_t)ldg * 16 * 64; const float* cim = p.in[14] + (size_t)ldg * 16 * 64;
    const bf16_t* U = (const bf16_t*)(p.ws + WS_G + S_U) + (size_t)b * RB * 512 + g * 16;
    bf16_t* Y = (bf16_t*)(p.ws + WS_G + (dir == 0 ? S_YF : S_YR)) + ((size_t)g * MTOT + (size_t)b * RB) * 16;
    const int cb0 = (wid & 3) * 2;
    bf16x8 bop[2] = {{0, 0, 0, 0, 0, 0, 0, 0}, {0, 0, 0, 0, 0, 0, 0, 0}};
#pragma unroll
    for (int t = 0; t < 2; ++t) {
        const int cb = cb0 + t, pst = (cb & 3) * 16 + fr; const float lr = lam_re[pst], li = lam_im[pst];
        const float mag = expf(lr * dt); const float abr = mag * cosf(li * dt), abi = mag * sinf(li * dt);
        const float den = lr * lr + li * li, nr = abr - 1.f, ni = abi;
        const float cr = (nr * lr + ni * li) / den, ci = (ni * lr - nr * li) / den;
        if (quad < 2) {
#pragma unroll
            for (int j = 0; j < 8; ++j) { const int c = quad * 8 + j; const float br_ = bre[pst * 16 + c], bi_ = bim[pst * 16 + c];
                const float v = (cb < 4) ? cr * br_ - ci * bi_ : cr * bi_ + ci * br_; bop[t][j] = (short)f2bf(v); }
        }
    }
    float ar, ai, hr = 0.f, hi = 0.f;
    { const float lr = lam_re[lane], li = lam_im[lane]; const float mag = expf(lr * dt); ar = mag * cosf(li * dt); ai = mag * sinf(li * dt); }
    bf16x8 cop[4];
#pragma unroll
    for (int ks = 0; ks < 4; ++ks)
#pragma unroll
        for (int j = 0; j < 8; ++j) { const int k = ks * 32 + quad * 8 + j; const float v = (k & 1) ? -cim[fr * 64 + (k >> 1)] : cre[fr * 64 + (k >> 1)]; cop[ks][j] = (short)f2bf(v); }
#define S5_LD(chunk, A_) do { _Pragma("unroll") for (int rb = 0; rb < 4; ++rb) { const int s_ = s5_pos((chunk) * 64 + rb * 16 + fr, dir); \
        A_[rb] = (bf16x8){0, 0, 0, 0, 0, 0, 0, 0}; if (quad < 2) A_[rb] = *(const bf16x8*)(U + (size_t)s_ * 512 + quad * 8); } } while (0)
#define S5_MM(A_, BUb) do { _Pragma("unroll") for (int rb = 0; rb < 4; ++rb) { \
        _Pragma("unroll") for (int t = 0; t < 2; ++t) { f32x4 acc = {0.f, 0.f, 0.f, 0.f}; acc = __builtin_amdgcn_mfma_f32_16x16x32_bf16(A_[rb], bop[t], acc, 0, 0, 0); \
            _Pragma("unroll") for (int j = 0; j < 4; ++j) (BUb)[(rb * 16 + quad * 4 + j) * 128 + (cb0 + t) * 16 + fr] = acc[j]; } } } while (0)
#define S5_C(chunk, Hbb, rb) do { f32x4 acc = {0.f, 0.f, 0.f, 0.f}; \
        _Pragma("unroll") for (int ks = 0; ks < 4; ++ks) { const bf16x8 aop = *(const LAS bf16x8*)((Hbb) + ((rb) * 16 + fr) * 136 + ks * 32 + quad * 8); \
            acc = __builtin_amdgcn_mfma_f32_16x16x32_bf16(aop, cop[ks], acc, 0, 0, 0); } \
        _Pragma("unroll") for (int j = 0; j < 4; ++j) { const int s_ = s5_pos((chunk) * 64 + (rb) * 16 + quad * 4 + j, dir); Y[(size_t)s_ * 16 + fr] = f2bf(acc[j]); } } while (0)
    constexpr int NCH = RB / 64;
    bf16x8 ua[4], ub[4];
    if (wid >= 4) { S5_LD(0, ua); S5_MM(ua, BU); S5_LD(1, ua); }
    __syncthreads();
    for (int k = 0; k < NCH; ++k) {
        LAS float* BUc = BU + (k & 1) * 8192; LAS bf16_t* Hbc = Hb + (k & 1) * (64 * 136);
        if (wid == 0) {
#pragma unroll
            for (int hf = 0; hf < 2; ++hf) {
                float brv[32], biv[32];
#pragma unroll
                for (int i = 0; i < 32; ++i) { brv[i] = BUc[(hf * 32 + i) * 128 + lane]; biv[i] = BUc[(hf * 32 + i) * 128 + 64 + lane]; }
#pragma unroll
                for (int i = 0; i < 32; ++i) {
                    const float nr = fmaf(ar, hr, fmaf(-ai, hi, brv[i])), ni = fmaf(ar, hi, fmaf(ai, hr, biv[i]));
                    hr = nr; hi = ni;
                    *(LAS unsigned*)(Hbc + (hf * 32 + i) * 136 + 2 * lane) = cvt_pk_bf16(hr, hi);
                }
            }
        } else if (wid >= 4) {
            if (k + 1 < NCH) { LAS float* BUn = BU + ((k + 1) & 1) * 8192;
                if (k + 2 < NCH) S5_LD(k + 2, ub);
                S5_MM(ua, BUn);
#pragma unroll
                for (int rb = 0; rb < 4; ++rb) ua[rb] = ub[rb]; }
        } else if (k > 0) {
            LAS bf16_t* Hbp = Hb + ((k - 1) & 1) * (64 * 136);
            S5_C(k - 1, Hbp, wid - 1);
            if (wid == 1) S5_C(k - 1, Hbp, 3);
        }
        __syncthreads();
    }
    if (wid >= 1 && wid < 4) { LAS bf16_t* Hbp = Hb + ((NCH - 1) & 1) * (64 * 136); S5_C(NCH - 1, Hbp, wid - 1); if (wid == 1) S5_C(NCH - 1, Hbp, 3); }
    __syncthreads();
#undef S5_LD
#undef S5_MM
#undef S5_C
}

__device__ __forceinline__ u32x4 gelu8(const u32x4 u, const u32x4 yf, const u32x4 yr, const float* d, int c) {
    float o[8];
#pragma unroll
    for (int e = 0; e < 4; ++e) {
        const float y0 = d[c + 2 * e] * bflo(u[e]) + bflo(yf[e]) + bflo(yr[e]);
        const float y1 = d[c + 2 * e + 1] * bfhi(u[e]) + bfhi(yf[e]) + bfhi(yr[e]);
        o[2 * e] = y0 * sigmoidf_(1.5957691216057308f * (y0 + 0.044715f * y0 * y0 * y0));
        o[2 * e + 1] = y1 * sigmoidf_(1.5957691216057308f * (y1 + 0.044715f * y1 * y1 * y1));
    }
    u32x4 w; w.x = cvt_pk_bf16(o[0], o[1]); w.y = cvt_pk_bf16(o[2], o[3]); w.z = cvt_pk_bf16(o[4], o[5]); w.w = cvt_pk_bf16(o[6], o[7]);
    return w;
}
__device__ __forceinline__ void ph_s5_gelu(const Params& p, int layer) {
    bf16_t* U = (bf16_t*)(p.ws + WS_G + S_U); const bf16_t* YF = (const bf16_t*)(p.ws + WS_G + S_YF); const bf16_t* YR = (const bf16_t*)(p.ws + WS_G + S_YR);
    const float* d = p.in[15] + layer * 512;
    const size_t n8 = (size_t)MTOT * 512 / 8, stride = (size_t)gridDim.x * 512;
    const int tid = otid();
    for (size_t i = (size_t)obid() * 512 + tid; i < n8; i += 2 * stride) {
        const size_t i2 = i + stride; const bool has2 = i2 < n8; const size_t ib = has2 ? i2 : i;
        const int c = (int)(i & 63) * 8, c2 = (int)(ib & 63) * 8;
        const size_t yo = ((size_t)(c >> 4) * MTOT + (i >> 6)) * 16 + (c & 15), yo2 = ((size_t)(c2 >> 4) * MTOT + (ib >> 6)) * 16 + (c2 & 15);
        const u32x4 u = *(const u32x4*)(U + i * 8), yf = *(const u32x4*)(YF + yo), yr = *(const u32x4*)(YR + yo);
        const u32x4 ub = *(const u32x4*)(U + ib * 8), yfb = *(const u32x4*)(YF + yo2), yrb = *(const u32x4*)(YR + yo2);
        *(u32x4*)(U + i * 8) = gelu8(u, yf, yr, d, c);
        if (has2) *(u32x4*)(U + ib * 8) = gelu8(ub, yfb, yrb, d, c2);
    }
}

template <int NP> __device__ __forceinline__ void seg_load(const bf16_t* in, int ncols, int lane, unsigned (&w)[NP]) {
#pragma unroll
    for (int i = 0; i < NP; ++i) w[i] = (128 * i + 2 * lane < ncols) ? *(const unsigned*)(in + 128 * i + 2 * lane) : 0u;
}
template <int CW, int NP>
__device__ __forceinline__ void seg_fin(const unsigned (&w)[NP], bf16_t* out, int ncols, const float* gain, bool rope, int t, int lane, const float* rtab = nullptr) {
#pragma unroll
    for (int i = 0; i < NP; ++i) {
        const bool valid = 128 * i + 2 * lane < ncols;
        const float x0 = bflo(w[i]), x1 = bfhi(w[i]);
        float ss = x0 * x0 + x1 * x1;
        ss = (CW == 64) ? half_sum(ss) : wave_sum(ss);
        const float rs = rsqrtf(ss * (1.f / CW) + EPS);
        const int e = (2 * lane) % CW;
        float y0 = x0 * rs * gain[e], y1 = x1 * rs * gain[e + 1];
        if (rope) {
            const int pi = e >> 1, q = CW / 4; const int k = pi < q ? pi : pi - q; const int pos = pi < q ? (t >> 6) : (t & 63);
            typedef float f32x2t __attribute__((ext_vector_type(2)));
            const f32x2t cssn = ((const f32x2t*)rtab)[pos * q + k]; const float cs = cssn.x, sn = cssn.y;
            const float r0 = y0 * cs - y1 * sn, r1 = y0 * sn + y1 * cs; y0 = r0; y1 = r1;
        }
        if (valid) *(unsigned*)(out + 128 * i + 2 * lane) = cvt_pk_bf16(y0, y1);
    }
}
__device__ __forceinline__ void ph_prep1(const Params& p, int layer) {
    const int tid = otid(); const int lane = tid & 63, gw = obid() * 8 + (tid >> 6), NGW = gridDim.x * 8;
    bf16_t* Z = (bf16_t*)(p.ws + WS_G + G_Z); bf16_t* CQ = (bf16_t*)(p.ws + WS_G + G_CQ); bf16_t* CKV = (bf16_t*)(p.ws + WS_G + G_CKV);
    const float* daq = p.in[18] + layer * 64; const float* dak = p.in[19] + layer * 64; const float* gqq = p.in[22] + layer * 128; const float* gqk = p.in[23] + layer * 128;
    const float* r64 = (const float*)(p.ws + WS_ROPE64); const float* r128 = (const float*)(p.ws + WS_ROPE128);
    const float* cqn = p.in[24] + layer * 256; const float* ckvn = p.in[25] + layer * 128; const float* mlk = p.in[29] + layer * 192;
    for (int r = gw; r < RB; r += NGW) {
        bf16_t* z = Z + (size_t)r * ZW; const bool lat = r >= CTX; const int t = r - CTX;
        unsigned wq[4], wk[4], gq[4], gk[2], kv[1], kr[1];
        seg_load<4>(z + Z_DAQ, 512, lane, wq); seg_load<4>(z + Z_DAK, 512, lane, wk); seg_load<4>(z + Z_GQQ, 512, lane, gq); seg_load<2>(z + Z_GQK, 256, lane, gk);
        seg_load<1>(z + Z_CKV, 128, lane, kv); seg_load<1>(z + Z_KR, 64, lane, kr);
        const u32x2 wc = *(const u32x2*)(z + Z_CQ + 4 * lane);
        seg_fin<64, 4>(wq, z + Z_DAQ, 512, daq, lat, t, lane, r64);
        seg_fin<64, 4>(wk, z + Z_DAK, 512, dak, lat, t, lane, r64);
        seg_fin<128, 4>(gq, z + Z_GQQ, 512, gqq, lat, t, lane, r128);
        seg_fin<128, 2>(gk, z + Z_GQK, 256, gqk, lat, t, lane, r128);
        seg_fin<128, 1>(kv, CKV + (size_t)r * 128, 128, ckvn, false, 0, lane);
        seg_fin<64, 1>(kr, z + Z_KR, 64, mlk + 128, lat, t, lane, r64);
        {
            const float x0 = bflo(wc.x), x1 = bfhi(wc.x), x2 = bflo(wc.y), x3 = bfhi(wc.y);
            const float rs = rsqrtf(wave_sum(x0 * x0 + x1 * x1 + x2 * x2 + x3 * x3) * (1.f / 256) + EPS);
            const f32x4 g = *(const f32x4*)(cqn + 4 * lane);
            u32x2 o; o.x = cvt_pk_bf16(x0 * rs * g.x, x1 * rs * g.y); o.y = cvt_pk_bf16(x2 * rs * g.z, x3 * rs * g.w);
            *(u32x2*)(CQ + (size_t)r * 256 + 4 * lane) = o;
        }
    }
}
__device__ __forceinline__ void ph_prep2(const Params& p, int layer) {
    const int tid = otid(); const int lane = tid & 63, gw = obid() * 8 + (tid >> 6), NGW = gridDim.x * 8;
    const bf16_t* Z = (const bf16_t*)(p.ws + WS_G + G_Z); bf16_t* MLQ = (bf16_t*)(p.ws + WS_G + G_MLQ); const bf16_t* MLKV = (const bf16_t*)(p.ws + WS_G + G_MLKV); bf16_t* KF = (bf16_t*)(p.ws + WS_G + G_KF);
    const float* mlq = p.in[28] + layer * 192; const float* mlk = p.in[29] + layer * 192; const float* r64 = (const float*)(p.ws + WS_ROPE64);
    for (int r = gw; r < RB; r += NGW) {
        const bool lat = r >= CTX; const int t = r - CTX;
        bf16_t* q = MLQ + (size_t)r * 768; const bf16_t* kv = MLKV + (size_t)r * 1024; bf16_t* kf = KF + (size_t)r * 768;
        const unsigned krw = lane < 32 ? *(const unsigned*)(Z + (size_t)r * ZW + Z_KR + 2 * lane) : 0u;
        unsigned qn[4][1], qp[4][1], kn[4][1];
#pragma unroll
        for (int h = 0; h < 4; ++h) { seg_load<1>(q + h * 192, 128, lane, qn[h]); seg_load<1>(q + h * 192 + 128, 64, lane, qp[h]); seg_load<1>(kv + h * 256, 128, lane, kn[h]); }
#pragma unroll
        for (int h = 0; h < 4; ++h) {
            seg_fin<128, 1>(qn[h], q + h * 192, 128, mlq, false, 0, lane);
            seg_fin<64, 1>(qp[h], q + h * 192 + 128, 64, mlq + 128, lat, t, lane, r64);
            seg_fin<128, 1>(kn[h], kf + h * 192, 128, mlk, false, 0, lane);
            if (lane < 32) *(unsigned*)(kf + h * 192 + 128 + 2 * lane) = krw;
        }
    }
}
__device__ __forceinline__ void ph_subln(const Params& p, int layer) {
    const int tid = otid(); const int lane = tid & 63, gw = obid() * 8 + (tid >> 6), NGW = gridDim.x * 8;
    const bf16_t* A1 = (const bf16_t*)(p.ws + WS_G + G_A1); const bf16_t* A2 = (const bf16_t*)(p.ws + WS_G + G_A2); bf16_t* O = (bf16_t*)(p.ws + WS_G + G_BR);
    const float* lam = p.in[20] + layer * 256; const float* sub = p.in[21] + layer * 128;
    int lyr = layer; asm volatile("" : "+s"(lyr));
    const float lam_init = lyr == 0 ? 0.2f : 0.35550907f;
    const float l1 = wave_sum(lam[lane] * lam[64 + lane]), l2 = wave_sum(lam[128 + lane] * lam[192 + lane]);
    const float lam_full = expf(l1) - expf(l2) + lam_init;
    const float g0 = sub[2 * lane] * (1.f - lam_init), g1 = sub[2 * lane + 1] * (1.f - lam_init);
    for (int r = gw; r < RB; r += NGW) {
        unsigned w1[4], w2[4];
#pragma unroll
        for (int h = 0; h < 4; ++h) { const size_t off = (size_t)r * 512 + h * 128 + 2 * lane; w1[h] = *(const unsigned*)(A1 + off); w2[h] = *(const unsigned*)(A2 + off); }
#pragma unroll
        for (int h = 0; h < 4; ++h) {
            const size_t off = (size_t)r * 512 + h * 128 + 2 * lane;
            const float d0 = bflo(w1[h]) - lam_full * bflo(w2[h]), d1 = bfhi(w1[h]) - lam_full * bfhi(w2[h]);
            const float rs = rsqrtf(wave_sum(d0 * d0 + d1 * d1) * (1.f / 128) + EPS);
            *(unsigned*)(O + off) = cvt_pk_bf16(d0 * rs * g0, d1 * rs * g1);
        }
    }
}

__device__ __forceinline__ void attn_unit(const Params& p, int u, char* lds) {
    const bf16_t* Z = (const bf16_t*)(p.ws + WS_G + G_Z);
    int type, hd, qb;
    if (u < 128) { type = 0; hd = u >> 5; qb = 1 + (u & 31); }
    else if (u < 256) { type = 1; hd = (u - 128) >> 5; qb = 1 + (u & 31); }
    else if (u < 512) { type = 2; hd = (u - 256) >> 5; qb = 1 + (u & 31); }
    else { const int k = u - 512; qb = 0; if (k < 4) { type = 0; hd = k; } else if (k < 8) { type = 1; hd = k - 4; } else { type = 2; hd = k - 8; } }
    const int seq = qb == 0 ? CTX : RB; const size_t q0 = (size_t)qb * 256;
#ifndef ATT_TYPES
#define ATT_TYPES 7
#endif
    if (type == 0 && (ATT_TYPES & 1)) {
        const bf16_t* Q = (const bf16_t*)(p.ws + WS_G + G_MLQ) + q0 * 768 + hd * 192;
        const bf16_t* K = (const bf16_t*)(p.ws + WS_G + G_KF) + hd * 192;
        const bf16_t* V = (const bf16_t*)(p.ws + WS_G + G_MLKV) + hd * 256 + 128;
        bf16_t* O = (bf16_t*)(p.ws + WS_G + G_BR) + (size_t)2 * RB * 512 + q0 * 512 + hd * 128;
#ifndef ML_QL
#define ML_QL -1
#endif
#ifndef ATT_DMA
#define ATT_DMA 3
#endif
        if constexpr (ATT_DMA & 1) att::attn_body_dma<192, 768, 768, 1024, 512>(Q, K, V, O, seq, lds);
        else if constexpr (ML_QL < 0) att::attn_body_simple<192, 768, 768, 1024, 512>(Q, K, V, O, seq, lds);
        else att::attn_body<192, 768, 768, 1024, 512, (ML_QL < 0 ? 0 : ML_QL)>(Q, K, V, O, seq, lds);
    } else if (type == 1 && (ATT_TYPES & 2)) {
        const int kvh = hd >> 1;
        const bf16_t* Q = Z + q0 * ZW + Z_GQQ + hd * 128;
        const bf16_t* K = Z + Z_GQK + kvh * 128;
        const bf16_t* V = Z + Z_GQV + kvh * 128;
        bf16_t* O = (bf16_t*)(p.ws + WS_G + G_BR) + (size_t)1 * RB * 512 + q0 * 512 + hd * 128;
#ifndef GQ_SIMPLE
#define GQ_SIMPLE 1
#endif
        if constexpr (ATT_DMA & 2) att::attn_body_dma<128, ZW, ZW, ZW, 512>(Q, K, V, O, seq, lds);
        else if constexpr (GQ_SIMPLE) att::attn_body_simple<128, ZW, ZW, ZW, 512>(Q, K, V, O, seq, lds); else att::attn_body<128, ZW, ZW, ZW, 512>(Q, K, V, O, seq, lds);
    } else if (type == 2 && (ATT_TYPES & 4)) {
        const int h = hd >> 1, m = hd & 1;
        const bf16_t* Q = Z + q0 * ZW + Z_DAQ + h * 128 + m * 64;
        const bf16_t* K = Z + Z_DAK + h * 128 + m * 64;
        const bf16_t* V = Z + Z_DAV + h * 128;
        bf16_t* O = (bf16_t*)(p.ws + WS_G + (m == 0 ? G_A1 : G_A2)) + q0 * 512 + h * 128;
#ifndef DA_SIMPLE
#define DA_SIMPLE 0
#endif
        if constexpr (DA_SIMPLE) att::attn_body_simple<64, ZW, ZW, ZW, 512>(Q, K, V, O, seq, lds); else att::attn_body<64, ZW, ZW, ZW, 512>(Q, K, V, O, seq, lds);
    }
}
#ifndef ATT_REP_TYPES
#define ATT_REP_TYPES 7
#endif
__device__ __forceinline__ void ph_attn(const Params& p, char* lds, int last, int tmask = 7) {
    const int G = gridDim.x, c = obid();
    for (int i = 0; i < 3; ++i) {
        int u;
        const int xcd = c & 7, jq = c >> 3;
        if (G == 256) u = i == 0 ? (xcd < 4 ? xcd * 32 + jq : 128 + (xcd - 4) * 32 + jq) : (i == 1 ? 256 + xcd * 32 + jq : ((c >= 128 && c < 144 && !last) ? 512 + (c - 128) : -1));
        else u = -1;
        if (u >= 0) { const int ty = u < 128 ? 1 : (u < 256 ? 2 : (u < 512 ? 4 : 7)); if (ty & tmask) attn_unit(p, u, lds); }
    }
    if (G != 256) for (int u = c; u < (last ? 512 : 528); u += G) attn_unit(p, u, lds);
}


#define XB_TMO      128
#define XB_XCNT(j)  (256  + 64 * (j))
#define XB_XSUB(j)  (1280 + 64 * (j))
#define XB_XGEN(j)  (2304 + 64 * (j))
#define XB_TOP      3328
#define XB_TOPGEN   3392
#define XCD_BAR_WORDS 3456
#define XB_SPIN_CAP (1u << 23)
__device__ __forceinline__ unsigned xb_ld(unsigned* p)              { return __hip_atomic_load(p, __ATOMIC_RELAXED, __HIP_MEMORY_SCOPE_AGENT); }
__device__ __forceinline__ unsigned xb_add(unsigned* p, unsigned v) { return __hip_atomic_fetch_add(p, v, __ATOMIC_RELAXED, __HIP_MEMORY_SCOPE_AGENT); }
__device__ __forceinline__ unsigned xb_xcc_id() { return (unsigned)__builtin_amdgcn_s_getreg((3 << 11) | 20) & 0xFu; }
#define XB_SPIN(cond, bar) do { unsigned _sp = 0; while (cond) { __builtin_amdgcn_s_sleep(1); \
    if ((++_sp & 255u) == 0u) { if (xb_ld(&(bar)[XB_TMO])) break; if (_sp > XB_SPIN_CAP) { atomicAdd(&(bar)[XB_TMO], 1u); break; } } } } while (0)
struct XcdBarrier { unsigned* bar; unsigned x; volatile LAS unsigned* st; };
__device__ __forceinline__ void xcd_barrier_complete(unsigned* bar, unsigned x, unsigned& nloc, unsigned& nx) {
    const unsigned G = gridDim.x * gridDim.y * gridDim.z;
    unsigned sum, cnt, mine, sp = 0u;
    for (;;) {
        sum = 0u; cnt = 0u; mine = 0u;
#pragma unroll
        for (unsigned j = 0; j < 16; ++j) { const unsigned c = xb_ld(&bar[XB_XCNT(j)]); sum += c; cnt += (c > 0u) ? 1u : 0u; mine = (j == x) ? c : mine; }
        if (sum == G) break;
        __builtin_amdgcn_s_sleep(1);
        if ((++sp & 255u) == 0u) { if (xb_ld(&bar[XB_TMO])) break; if (sp > XB_SPIN_CAP) { atomicAdd(&bar[XB_TMO], 1u); break; } }
    }
    nloc = mine > 0u ? mine : 1u; nx = cnt > 0u ? cnt : 1u;
}
__device__ __forceinline__ void xcd_barrier(const XcdBarrier& b) {
    asm volatile("s_waitcnt vmcnt(0)" ::: "memory");
    __syncthreads();
    if (otid() == 0) {
        unsigned* bar = b.bar;
        __builtin_amdgcn_s_waitcnt(0);
        unsigned nloc = b.st[0], nx = b.st[1];
        if (nloc == 0u) { xcd_barrier_complete(bar, b.x, nloc, nx); b.st[0] = nloc; b.st[1] = nx; }
        const unsigned old = xb_add(&bar[XB_XSUB(b.x)], 1u);
        const unsigned gen = old / nloc;
        if (old + 1u == (gen + 1u) * nloc) {
            __builtin_amdgcn_fence(__ATOMIC_RELEASE, "agent");
            asm volatile("s_waitcnt vmcnt(0)" ::: "memory");
            const unsigned og = xb_add(&bar[XB_TOP], 1u);
            const unsigned tg = og / nx;
            if (og + 1u == (tg + 1u) * nx) xb_add(&bar[XB_TOPGEN], 1u);
            else XB_SPIN(xb_ld(&bar[XB_TOPGEN]) == tg, bar);
            __builtin_amdgcn_fence(__ATOMIC_ACQUIRE, "agent");
            xb_add(&bar[XB_XGEN(b.x)], 1u);
            asm volatile("s_waitcnt vmcnt(0)" ::: "memory");
        } else {
            XB_SPIN(xb_ld(&bar[XB_XGEN(b.x)]) == gen, bar);
            __builtin_amdgcn_fence(__ATOMIC_ACQUIRE, "agent");
            asm volatile("s_waitcnt vmcnt(0)" ::: "memory");
        }
    }
    __syncthreads();
}

__global__ void __launch_bounds__(512, 2) mk_fwd(Params p0) {
    extern __shared__ __attribute__((aligned(16))) unsigned char lds_raw[];
    LAS unsigned char* lds = (LAS unsigned char*)lds_raw;
    cg::grid_group grid = cg::this_grid();
#define GSYNC() do { if (hi < 0) { asm volatile("s_waitcnt vmcnt(0) lgkmcnt(0)" ::: "memory"); grid.sync(); }     \
    else { XcdBarrier xb_; xb_.bar = (unsigned*)(load_params().ws + WS_BAR); xb_.x = xb_xcc_id(); xb_.st = (volatile LAS unsigned*)(lds + 131072 + 64); xcd_barrier(xb_); } } while (0)
    if (threadIdx.x == 0) { volatile LAS unsigned* st_ = (volatile LAS unsigned*)(lds + 131072 + 64); st_[0] = 0u; st_[1] = 0u;
        (void)xb_add(&((unsigned*)(p0.ws + WS_BAR))[XB_XCNT(xb_xcc_id())], 1u); }
    __syncthreads();
    const int lo = p0.lo, hi = p0.hi; int ph = 0; int layer = 0;
#ifndef PHASE_MASK
#define PHASE_MASK 0xFFFF
#endif
#ifndef REPEAT_MASK
#define REPEAT_MASK 0
#endif
#define PH_BEGIN(cat) if (ph >= lo && ph < hi) { constexpr int cat_ = (cat); (void)cat_; DIAG_T0(cat) if constexpr ((PHASE_MASK >> (cat)) & 1) for (int rep_ = 0; rep_ < (((REPEAT_MASK >> (cat)) & 1) ? 2 : 1); ++rep_) { if (rep_) GSYNC(); const Params p = load_params(); \
    unsigned char* ws = p.ws; float* MOD = (float*)(ws + WS_MOD); float* ctxb = (float*)(ws + WS_CTXB); bf16_t* H = (bf16_t*)(ws + WS_H); bf16_t* ABR = (bf16_t*)(ws + WS_ABR); \
    const bf16_t* Wl = (const bf16_t*)(ws + WS_W + layer * W_LAYER_B); const float* modl = MOD + (size_t)layer * 5 * MODW; \
    const float* xl_in = layer == 0 ? p.in[0] : p.out; const float* xc_in = layer == 0 ? p.in[2] : ctxb; \
    int lastl = layer; asm volatile("" : "+s"(lastl)); lastl = (lastl == 1) ? 1 : 0; \
    (void)MOD; (void)ctxb; (void)H; (void)ABR; (void)Wl; (void)modl; (void)xl_in; (void)xc_in; (void)lastl;
#if defined(DIAG_A_MASK)
#define DIAG_T0(cat) if (blockIdx.x == 0 && threadIdx.x == 0) { ((LAS unsigned long long*)(lds + LDS_BYTES - 64))[2] = __builtin_amdgcn_s_memrealtime(); }
#define DIAG_T1(cat) if (blockIdx.x == 0 && threadIdx.x == 0) { LAS unsigned long long* ta_ = (LAS unsigned long long*)(lds + LDS_BYTES - 64); const unsigned long long dt_ = __builtin_amdgcn_s_memrealtime() - ta_[2]; \
    if ((DIAG_A_MASK >> (cat)) & 1) ta_[0] += dt_; if ((DIAG_B_MASK >> (cat)) & 1) ta_[1] += dt_; }
#else
#define DIAG_T0(cat)
#define DIAG_T1(cat)
#endif
#define PH_END   } if (ph + 1 < hi) GSYNC(); DIAG_T1(cat_) } ++ph;
    const int G = gridDim.x, c = blockIdx.x;
#if defined(DIAG_A_MASK)
    if (threadIdx.x == 0) { LAS unsigned long long* ta_ = (LAS unsigned long long*)(lds + LDS_BYTES - 64); ta_[0] = 0; ta_[1] = 0; }
#endif

#if defined(EXTRA_SYNCS)
    for (int es = 0; es < EXTRA_SYNCS; ++es) GSYNC();
#endif
    PH_BEGIN(0) ph_prologue(p, lds); PH_END

    for (layer = 0; layer < 2; ++layer) {

        PH_BEGIN(1) ph_norm_mod(xl_in, xc_in, p.in[6] + layer * DM, modl, 0, H); PH_END

        PH_BEGIN(2) {
            pg8::Gemm g{H, Wl + W_IN, MTOT, 512, 1024}; pg8::StaticOrder S; S.init(MTOT, 512, G, c);
            pg8::Epi<pg8::E_STORE> E{}; E.a.O = (bf16_t*)(ws + WS_G + S_U); E.a.ldc = 512;
            pg8::gemm_phase(lds, g, S, E);
            { pg8::Gemm g2{H, Wl + W_IN + (size_t)512 * 1024, RB, ZW, 1024}; pg8::StaticOrder S2; S2.init(RB, ZW, G, (c + 160) % G);
              pg8::Epi<pg8::E_INPROJ> E2{}; E2.a.O = (bf16_t*)(ws + WS_G + G_Z); E2.a.ldc = ZW;
              pg8::gemm_phase(lds, g2, S2, E2); }
        } PH_END

        PH_BEGIN(3) { for (int u = c; u < 256; u += G) s5_chain(p, layer, u, lds); } PH_END

        PH_BEGIN(4) ph_s5_gelu(p, layer); PH_END

        PH_BEGIN(9) {
            pg8::Gemm g{(const bf16_t*)(ws + WS_G + S_U), Wl + W_GLU, MTOT, 512, 512}; pg8::StaticOrder S; S.init(MTOT, 512, G, c);
            pg8::Epi<pg8::E_GLU> E{}; E.a.O = ABR; E.a.ldc = 512; E.a.G = (const bf16_t*)(ws + WS_G + S_U); E.a.ldg = 512; E.a.bias = p.in[17] + layer * 512;
            pg8::gemm_phase(lds, g, S, E);
            ph_prep1(p, layer);
        } PH_END

        for (int gb = 0; gb < NB; ++gb) {
            const size_t grow0 = (size_t)gb * RB;
            if (gb > 0) {
            PH_BEGIN(10) {
                pg8::Gemm g{H + grow0 * DM, Wl + W_IN + (size_t)512 * 1024, RB, ZW, 1024}; pg8::StaticOrder S; S.init(RB, ZW, G, c);
                pg8::Epi<pg8::E_INPROJ> E{}; E.a.O = (bf16_t*)(ws + WS_G + G_Z); E.a.ldc = ZW;
                pg8::gemm_phase(lds, g, S, E);
            } PH_END

            PH_BEGIN(5) ph_prep1(p, layer); PH_END
            }

            PH_BEGIN(11) {
                { pg8::Gemm g{(const bf16_t*)(ws + WS_G + G_CQ), Wl + W_UQ, RB, 768, 256}; pg8::StaticOrder S; S.init(RB, 768, G, c);
                  pg8::Epi<pg8::E_STORE> E{}; E.a.O = (bf16_t*)(ws + WS_G + G_MLQ); E.a.ldc = 768;
                  pg8::gemm_phase(lds, g, S, E); }
                { pg8::Gemm g{(const bf16_t*)(ws + WS_G + G_CKV), Wl + W_UKV, RB, 1024, 128}; pg8::StaticOrder S; S.init(RB, 1024, G, (c + 128) % G);
                  pg8::Epi<pg8::E_STORE> E{}; E.a.O = (bf16_t*)(ws + WS_G + G_MLKV); E.a.ldc = 1024;
                  pg8::gemm_phase(lds, g, S, E); }
            } PH_END

            PH_BEGIN(6) ph_prep2(p, layer); PH_END

            PH_BEGIN(7) ph_attn(p, (char*)lds_raw, lastl, rep_ ? ATT_REP_TYPES : 7); PH_END

            PH_BEGIN(8) ph_subln(p, layer); PH_END

            PH_BEGIN(12) {
                const int vpm0 = gb * TPB, vpm1 = (int)((WS_G + G_BR - WS_ABR) / 262144);
                pg8::Gemm g{ABR, Wl + W_BR, RB, 1024, 512}; pg8::MergeOrder S{G, c, vpm0, vpm1, lastl};
                pg8::Epi<pg8::E_MERGE> E{}; E.a.O = H + grow0 * DM; E.a.ldc = DM; E.a.G = (const bf16_t*)(ws + WS_G + G_Z) + Z_GATE; E.a.ldg = ZW;
                E.a.MF = (float*)(ws + WS_G + G_MF); E.a.vpm0 = vpm0; E.a.vpm1 = vpm1;
                pg8::gemm_phase(lds, g, S, E);
            } PH_END
        }

        PH_BEGIN(13) {
            pg8::Gemm g{H, Wl + W_OUT, MTOT, 1024, 1024}; pg8::StaticOrder S; S.init(MTOT, 1024, G, c, lastl);
            pg8::Epi<pg8::E_RESID> E{}; E.a.xin_l = xl_in; E.a.xin_c = xc_in; E.a.xout_l = p.out; E.a.xout_c = ctxb; E.a.gate = modl + 2 * 1024;
            pg8::gemm_phase(lds, g, S, E);
        } PH_END

        PH_BEGIN(1) ph_norm_mod(p.out, ctxb, p.in[32] + layer * DM, modl, 3, H); PH_END

        PH_BEGIN(14) {
            pg8::Gemm g{H, Wl + W_FI, MTOT, 2 * DFF, 1024}; pg8::StaticOrder S; S.init(MTOT, 2 * DFF, G, c, lastl);
            pg8::Epi<pg8::E_SWIGLU> E{}; E.a.O = (bf16_t*)(ws + WS_G); E.a.ldc = DFF;
            pg8::gemm_phase(lds, g, S, E);
        } PH_END

        PH_BEGIN(15) {
            pg8::Gemm g{(const bf16_t*)(ws + WS_G), Wl + W_FO, MTOT, 1024, DFF}; pg8::StaticOrder S; S.init(MTOT, 1024, G, c, lastl);
            pg8::Epi<pg8::E_RESID> E{}; E.a.xin_l = p.out; E.a.xin_c = ctxb; E.a.xout_l = p.out; E.a.xout_c = ctxb; E.a.gate = modl + 5 * 1024;
            pg8::gemm_phase(lds, g, S, E);
        } PH_END
    }
#if defined(DIAG_A_MASK)
    GSYNC();
    if (blockIdx.x == 0) { LAS unsigned long long* ta_ = (LAS unsigned long long*)(lds + LDS_BYTES - 64);
        const float A = (float)ta_[0] * 0.01f, B = (float)ta_[1] * 0.01f;
        if (threadIdx.x == 0) p0.out[0] = A; else p0.out[threadIdx.x] = B; if (threadIdx.x > 0) p0.out[threadIdx.x + 511] = B; }
#endif
#undef PH_BEGIN
#undef PH_END
}
constexpr int N_PHASES = 1 + 2 * (5 + 4 * 7 + 4 - 2);

extern "C" void kernel_launch(void* const* d_in, const int* in_sizes, int n_in, void* d_out, int out_size, void* d_ws, size_t ws_size, hipStream_t stream) {
    static int grid = 0;
    if (grid == 0) {
        if (n_in != 35 || out_size != NB * SEQ * DM || ws_size < WS_END) { fprintf(stderr, "kernel_launch: bad shapes: n_in %d out %d ws %zu (need %zu)\n", n_in, out_size, ws_size, (size_t)WS_END); grid = -1; return; }
        int dev = 0, cus = 0, per_cu = 0;
        (void)hipGetDevice(&dev); (void)hipDeviceGetAttribute(&cus, hipDeviceAttributeMultiprocessorCount, dev);
        if (hipFuncSetAttribute((const void*)mk_fwd, hipFuncAttributeMaxDynamicSharedMemorySize, LDS_BYTES) != hipSuccess) { fprintf(stderr, "kernel_launch: hipFuncSetAttribute failed\n"); grid = -1; return; }
        (void)hipOccupancyMaxActiveBlocksPerMultiprocessor(&per_cu, (const void*)mk_fwd, 512, LDS_BYTES);
        (void)hipGetLastError();
        if (per_cu < 1) per_cu = 1;
        grid = cus;
    }
    if (grid < 0) return;
    if (hipMemsetAsync((char*)d_ws + WS_BAR, 0, 16384, stream) != hipSuccess) { fprintf(stderr, "kernel_launch: memset failed\n"); return; }
    Params p{};
    for (int i = 0; i < 35; ++i) p.in[i] = (const float*)d_in[i];
    p.out = (float*)d_out; p.ws = (unsigned char*)d_ws;
#if MK_MODE == 0
    p.lo = 0; p.hi = N_PHASES;
    void* args[] = {&p};
    hipError_t e = hipLaunchCooperativeKernel((const void*)mk_fwd, dim3(grid), dim3(512), args, LDS_BYTES, stream);
    if (e != hipSuccess) fprintf(stderr, "cooperative launch failed: %s (grid %d)\n", hipGetErrorString(e), grid);
#else
    for (int ph = 0; ph < N_PHASES; ++ph) {
        p.lo = ph; p.hi = ph + 1;
        hipLaunchKernelGGL(mk_fwd, dim3(grid), dim3(512), LDS_BYTES, stream, p);
    }
#endif
}
```

```cpp
#include <hip/hip_runtime.h>
#include <hip/hip_cooperative_groups.h>
#include <cstdio>
#include <cstdint>
namespace cg = cooperative_groups;

#ifndef MK_MODE
#define MK_MODE 0
#endif

#define LAS __attribute__((address_space(3)))
typedef unsigned short bf16_t;
typedef short bf16x8 __attribute__((ext_vector_type(8)));
typedef short s16x4 __attribute__((ext_vector_type(4)));
typedef float f32x4 __attribute__((ext_vector_type(4)));
typedef float f32x16 __attribute__((ext_vector_type(16)));
typedef unsigned u32x4 __attribute__((ext_vector_type(4)));
typedef unsigned u32x2 __attribute__((ext_vector_type(2)));

constexpr int DM = 1024, NB = 4, SEQ = 8192, CTX = 256, RB = SEQ + CTX  , MTOT = NB * RB  ;
constexpr int TPB = RB / 256;
constexpr int ZW = 7168;
constexpr int Z_DAQ = 0, Z_DAK = 512, Z_DAV = 1024, Z_GQQ = 1536, Z_GQK = 2048, Z_GQV = 2304, Z_CQ = 2560, Z_CKV = 2816, Z_KR = 2944, Z_GATE = 3072;
constexpr int DFF = 2816, MODW = 6144;
constexpr float EPS = 1e-6f;

constexpr size_t MiB = 1u << 20;
constexpr size_t al(size_t x) { return (x + MiB - 1) / MiB * MiB; }
constexpr size_t WS_MOD = 0;
constexpr size_t WS_ROPE64 = 256 * 1024, WS_ROPE128 = WS_ROPE64 + 128 * 16 * 8;
constexpr size_t WS_BAR = 512 * 1024;
constexpr size_t WS_CTXB = al(WS_MOD + 2 * 5 * MODW * 4);
constexpr size_t WS_W = WS_CTXB + 4 * MiB;
constexpr size_t W_IN = 0, W_UQ = W_IN + (size_t)7680 * 1024, W_UKV = W_UQ + 768 * 256, W_GLU = W_UKV + 1024 * 128, W_BR = W_GLU + 512 * 512,
                 W_OUT = W_BR + (size_t)4 * 1024 * 512, W_FI = W_OUT + (size_t)1024 * 1024, W_FO = W_FI + (size_t)5632 * 1024, W_LAYER = W_FO + (size_t)1024 * 2816;
constexpr size_t W_LAYER_B = al(W_LAYER * 2);
constexpr size_t WS_H = WS_W + 2 * W_LAYER_B;
constexpr size_t WS_ABR = WS_H + al((size_t)MTOT * 1024 * 2);
constexpr size_t WS_G = WS_ABR + al((size_t)MTOT * 512 * 2);
constexpr size_t G_Z = 0;
constexpr size_t G_CQ = al(G_Z + (size_t)RB * ZW * 2);
constexpr size_t G_CKV = al(G_CQ + (size_t)RB * 256 * 2);
constexpr size_t G_MLQ = al(G_CKV + (size_t)RB * 128 * 2);
constexpr size_t G_MLKV = al(G_MLQ + (size_t)RB * 768 * 2);
constexpr size_t G_KF = al(G_MLKV + (size_t)RB * 1024 * 2);
constexpr size_t G_A1 = al(G_KF + (size_t)RB * 768 * 2);
constexpr size_t G_A2 = al(G_A1 + (size_t)RB * 512 * 2);
constexpr size_t G_BR = al(G_A2 + (size_t)RB * 512 * 2);
constexpr size_t G_MF = al(G_BR + (size_t)3 * RB * 512 * 2);
constexpr size_t G_END = al(G_MF + (size_t)RB * 1024 * 4);
constexpr size_t S_SZ = al((size_t)MTOT * 512 * 2), S_U = G_MLQ  , S_YF = S_U + S_SZ, S_YR = S_YF + S_SZ, S_END = S_YR + S_SZ;
constexpr size_t HID_B = (size_t)MTOT * DFF * 2;
static_assert(S_END <= G_END && HID_B <= G_END, "aliases fit");
constexpr size_t WS_END = WS_G + G_END;
static_assert(WS_END <= (size_t)512 * MiB, "workspace budget");
static_assert((WS_G + G_BR - WS_ABR) % 262144 == 0, "merge virtual tiles");

constexpr int LDS_BYTES = 147456;

typedef __bf16 bf16x2n __attribute__((ext_vector_type(2)));
typedef float f32x2n __attribute__((ext_vector_type(2)));
__device__ __forceinline__ unsigned cvt_pk_bf16(float lo, float hi) { f32x2n v = {lo, hi}; bf16x2n b = __builtin_convertvector(v, bf16x2n); return __builtin_bit_cast(unsigned, b); }
__device__ __forceinline__ float bf2f(unsigned v) { return __uint_as_float(v << 16); }
__device__ __forceinline__ float bflo(unsigned w) { return __uint_as_float(w << 16); }
__device__ __forceinline__ float bfhi(unsigned w) { return __uint_as_float(w & 0xffff0000u); }
__device__ __forceinline__ bf16_t f2bf(float f) { return (bf16_t)(cvt_pk_bf16(f, 0.f) & 0xffffu); }
template <int O> __device__ __forceinline__ float swz_xor(float v) { return __int_as_float(__builtin_amdgcn_ds_swizzle(__float_as_int(v), 0x1f | (O << 10))); }
__device__ __forceinline__ float half_sum(float v) {
    v += swz_xor<1>(v); v += swz_xor<2>(v); v += swz_xor<4>(v); v += swz_xor<8>(v); v += swz_xor<16>(v); return v;
}
__device__ __forceinline__ float wave_sum(float v) {
    v = half_sum(v);
    auto rr = __builtin_amdgcn_permlane32_swap(__float_as_uint(v), __float_as_uint(v), false, false);
    return __uint_as_float(rr[0]) + __uint_as_float(rr[1]);
}
__device__ __forceinline__ int otid() { int t = threadIdx.x; asm volatile("" : "+v"(t)); return t; }
__device__ __forceinline__ float sigmoidf_(float x) { return __builtin_amdgcn_rcpf(1.f + __expf(-x)); }

__device__ __forceinline__ int obid() { int b = blockIdx.x; asm volatile("" : "+s"(b)); return b; }
struct Params { const float* in[35]; float* out; unsigned char* ws; int lo, hi; };
__device__ __forceinline__ Params load_params() {
#if defined(__HIP_DEVICE_COMPILE__)
    typedef const __attribute__((address_space(4))) Params* CP;
    CP q = (CP)__builtin_amdgcn_kernarg_segment_ptr(); asm volatile("" : "+s"(q));
    Params r;
#pragma unroll
    for (int i = 0; i < 35; ++i) r.in[i] = q->in[i];
    r.out = q->out; r.ws = q->ws; r.lo = q->lo; r.hi = q->hi; return r;
#else
    return Params{};
#endif
}

namespace pg8 {
constexpr int BM = 256, BK = 64, HALF = 128, HTB = HALF * BK * 2, STAGE_BYTES = 8 * HTB, NXCD = 8, WGM = 8;
__host__ __device__ __forceinline__ int lds_byte(int r, int c) { const int st = (r >> 4) * 2 + (c >> 5), rr = r & 15, cc = c & 31, ob = rr * 64 + cc * 2; return st * 1024 + (ob ^ (((ob >> 9) & 1) << 5)); }
__host__ __device__ __forceinline__ void stage_rc(int b, int& R, int& C) { const int st = b / 1024, sb = b % 1024, swz = sb ^ (((sb >> 9) & 1) << 5); R = (st >> 1) * 16 + swz / 64; C = (st & 1) * 32 + (swz % 64) / 2; }
__host__ __device__ __forceinline__ int perm32(int rho) { const int n = rho >> 4, i = rho & 15; return 8 * (i >> 2) + 4 * n + (i & 3); }
struct Unit { int pm, pn; };
struct Gemm { const bf16_t* A; const bf16_t* Bt; int M, N, K; };
struct StaticOrder {
    int nM, nN, nwg, G, c;
    int skip;
    __device__ void init(int M, int N, int G_, int c_, int skip_ = 0) { skip = skip_; nM = skip_ ? NB * (TPB - 1) : M / BM; nN = N / BM; nwg = nM * nN; G = G_; c = c_; }
    __device__ bool next(int i, Unit& u) const {
        const long L = (long)i * G + c; if (L >= nwg) return false;
        int wgid = (int)L; { const int q = nwg / NXCD, r = nwg % NXCD, xcd = wgid % NXCD, off = wgid / NXCD; wgid = (xcd < r ? xcd * (q + 1) : r * (q + 1) + (xcd - r) * q) + off; }
        const int nig = WGM * nN, gid = wgid / nig, fm = gid * WGM, gsz = (nM - fm) < WGM ? (nM - fm) : WGM;
        u.pm = fm + ((wgid % nig) % gsz); u.pn = (wgid % nig) / gsz; if (skip) u.pm += u.pm / (TPB - 1) + 1; return true;
    }
};
struct MergeOrder {
    int G, c, vpm0, vpm1, skip;
    __device__ bool next(int i, Unit& u) const {
        const int j = i >> 2, n = i & 3; const int L = j * G + c; if (L >= (TPB - skip) * 4) return false;
        const int pm = (L >> 2) + skip, pn = L & 3; u.pm = (n == 0 ? vpm0 : vpm1 + (n - 1) * TPB) + pm; u.pn = n * 4 + pn; return true;
    }
};

enum { E_STORE = 0, E_INPROJ = 1, E_GLU = 2, E_MERGE = 3, E_RESID = 4, E_SWIGLU = 5 };
struct EpiArgs {
    bf16_t* O; int ldc;
    const bf16_t* G; int ldg;
    const float* bias;
    float* MF;
    int vpm0, vpm1;
    const float* xin_l; const float* xin_c; float* xout_l; float* xout_c; const float* gate;
};
template <int MODE> struct Epi {
    EpiArgs a;
    __device__ __forceinline__ void operator()(const f32x4 (&acc)[2][2][4][2], const Unit& u, int, int, int, int) const {
        const int t_ = otid(), wid_ = __builtin_amdgcn_readfirstlane(t_ >> 6), wr = wid_ >> 2, wc = wid_ & 3, fr = t_ & 15, fq = (t_ & 63) >> 4;
        int pm = u.pm, pn = u.pn, nbr = 0;
        if (MODE == E_MERGE) { nbr = u.pn >> 2; pn = u.pn & 3; pm = u.pm - (nbr == 0 ? a.vpm0 : a.vpm1 + (nbr - 1) * TPB); }
        const int row0 = pm * BM + wr * 64 + fr;
        const int col0 = (MODE == E_SWIGLU ? pn * 128 : pn * BM) + wc * 32 + 8 * fq;
        const float* xin = nullptr; float* xout = nullptr; const float* gv = nullptr;
        if (MODE == E_RESID) {
            const int b = pm / TPB, t = pm - b * TPB;
            if (t == 0) { xin = a.xin_c + (size_t)b * CTX * DM; xout = a.xout_c + (size_t)b * CTX * DM; gv = a.gate + 4 * MODW; }
            else { xin = a.xin_l + ((size_t)b * SEQ + (size_t)(t - 1) * 256) * DM; xout = a.xout_l + ((size_t)b * SEQ + (size_t)(t - 1) * 256) * DM; gv = a.gate + b * MODW; }
        }
        if (MODE == E_SWIGLU || MODE == E_STORE || MODE == E_INPROJ) {
#pragma unroll
            for (int ai = 0; ai < 2; ++ai)
#pragma unroll
                for (int m = 0; m < 4; ++m) {
                    const int row = row0 + ai * HALF + m * 16;
                    if (MODE == E_SWIGLU) {
                        const f32x4 g0 = acc[ai][0][m][0], g1 = acc[ai][0][m][1], u0 = acc[ai][1][m][0], u1 = acc[ai][1][m][1];
                        float h[8];
#pragma unroll
                        for (int e = 0; e < 4; ++e) { h[e] = g0[e] * sigmoidf_(g0[e]) * u0[e]; h[4 + e] = g1[e] * sigmoidf_(g1[e]) * u1[e]; }
                        u32x4 w; w.x = cvt_pk_bf16(h[0], h[1]); w.y = cvt_pk_bf16(h[2], h[3]); w.z = cvt_pk_bf16(h[4], h[5]); w.w = cvt_pk_bf16(h[6], h[7]);
                        *(u32x4*)(a.O + (size_t)row * a.ldc + col0) = w;
                        continue;
                    }
#pragma unroll
                    for (int bj = 0; bj < 2; ++bj) {
                        const int col = col0 + bj * HALF;
                        f32x4 v0 = acc[ai][bj][m][0], v1 = acc[ai][bj][m][1];
                        if (MODE == E_INPROJ && pn >= 12) {
#pragma unroll
                            for (int e = 0; e < 4; ++e) { v0[e] = sigmoidf_(v0[e]); v1[e] = sigmoidf_(v1[e]); }
                        }
                        u32x4 w; w.x = cvt_pk_bf16(v0[0], v0[1]); w.y = cvt_pk_bf16(v0[2], v0[3]); w.z = cvt_pk_bf16(v1[0], v1[1]); w.w = cvt_pk_bf16(v1[2], v1[3]);
                        *(u32x4*)(a.O + (size_t)row * a.ldc + col) = w;
                    }
                }
            return;
        }
        f32x4 gb0[2], gb1[2];
#pragma unroll
        for (int bj = 0; bj < 2; ++bj) {
            const int col = col0 + bj * HALF;
            if (MODE == E_GLU) { gb0[bj] = *(const f32x4*)(a.bias + col); gb1[bj] = *(const f32x4*)(a.bias + col + 4); }
            else if (MODE == E_RESID) { gb0[bj] = *(const f32x4*)(gv + col); gb1[bj] = *(const f32x4*)(gv + col + 4); }
            else { gb0[bj] = (f32x4){0.f, 0.f, 0.f, 0.f}; gb1[bj] = gb0[bj]; }
        }
#pragma unroll
        for (int ai = 0; ai < 2; ++ai)
#pragma unroll
            for (int mp = 0; mp < 2; ++mp) {
                u32x4 gw[2][2]; f32x4 xa[2][2], xb[2][2];
#pragma unroll
                for (int mm = 0; mm < 2; ++mm)
#pragma unroll
                    for (int bj = 0; bj < 2; ++bj) {
                        const int row = row0 + ai * HALF + (mp * 2 + mm) * 16, col = col0 + bj * HALF;
                        if (MODE == E_GLU) gw[mm][bj] = *(const u32x4*)(a.G + (size_t)row * a.ldg + col);
                        if (MODE == E_MERGE) { gw[mm][bj] = *(const u32x4*)(a.G + (size_t)row * a.ldg + nbr * 1024 + col);
                            if (nbr != 0) { const u32x4 mw = *(const u32x4*)((const bf16_t*)a.MF + (size_t)row * 1024 + col);
                                xa[mm][bj] = (f32x4){bflo(mw.x), bfhi(mw.x), bflo(mw.y), bfhi(mw.y)}; xb[mm][bj] = (f32x4){bflo(mw.z), bfhi(mw.z), bflo(mw.w), bfhi(mw.w)}; } }
                        if (MODE == E_RESID) { const int lr = row - pm * BM; xa[mm][bj] = *(const f32x4*)(xin + (size_t)lr * DM + col); xb[mm][bj] = *(const f32x4*)(xin + (size_t)lr * DM + col + 4); }
                    }
#pragma unroll
                for (int mm = 0; mm < 2; ++mm)
#pragma unroll
                    for (int bj = 0; bj < 2; ++bj) {
                        const int m = mp * 2 + mm; const int row = row0 + ai * HALF + m * 16, col = col0 + bj * HALF;
                        const f32x4 v0 = acc[ai][bj][m][0], v1 = acc[ai][bj][m][1];
                        if (MODE == E_GLU) {
                            const u32x4 g = gw[mm][bj]; const f32x4 b0 = gb0[bj], b1 = gb1[bj];
                            float o[8];
                            o[0] = bflo(g.x) * sigmoidf_(v0[0] + b0[0]); o[1] = bfhi(g.x) * sigmoidf_(v0[1] + b0[1]);
                            o[2] = bflo(g.y) * sigmoidf_(v0[2] + b0[2]); o[3] = bfhi(g.y) * sigmoidf_(v0[3] + b0[3]);
                            o[4] = bflo(g.z) * sigmoidf_(v1[0] + b1[0]); o[5] = bfhi(g.z) * sigmoidf_(v1[1] + b1[1]);
                            o[6] = bflo(g.w) * sigmoidf_(v1[2] + b1[2]); o[7] = bfhi(g.w) * sigmoidf_(v1[3] + b1[3]);
                            u32x4 w; w.x = cvt_pk_bf16(o[0], o[1]); w.y = cvt_pk_bf16(o[2], o[3]); w.z = cvt_pk_bf16(o[4], o[5]); w.w = cvt_pk_bf16(o[6], o[7]);
                            *(u32x4*)(a.O + (size_t)row * a.ldc + col) = w;
                        } else if (MODE == E_MERGE) {
                            const u32x4 g = gw[mm][bj];
                            f32x4 p0, p1;
                            p0[0] = bflo(g.x) * v0[0]; p0[1] = bfhi(g.x) * v0[1]; p0[2] = bflo(g.y) * v0[2]; p0[3] = bfhi(g.y) * v0[3];
                            p1[0] = bflo(g.z) * v1[0]; p1[1] = bfhi(g.z) * v1[1]; p1[2] = bflo(g.w) * v1[2]; p1[3] = bfhi(g.w) * v1[3];
                            if (nbr != 0) { p0 = p0 + xa[mm][bj]; p1 = p1 + xb[mm][bj]; }
                            u32x4 w; w.x = cvt_pk_bf16(p0[0], p0[1]); w.y = cvt_pk_bf16(p0[2], p0[3]); w.z = cvt_pk_bf16(p1[0], p1[1]); w.w = cvt_pk_bf16(p1[2], p1[3]);
                            if (nbr != 3) *(u32x4*)((bf16_t*)a.MF + (size_t)row * 1024 + col) = w;
                            else *(u32x4*)(a.O + (size_t)row * a.ldc + col) = w;
                        } else if (MODE == E_RESID) {
                            const int lr = row - pm * BM;
                            *(f32x4*)(xout + (size_t)lr * DM + col) = xa[mm][bj] + gb0[bj] * v0;
                            *(f32x4*)(xout + (size_t)lr * DM + col + 4) = xb[mm][bj] + gb1[bj] * v1;
                        }
                    }
            }
    }
};

template <class EpiT, class Sched>
__device__ __forceinline__ void gemm_phase(LAS unsigned char* lds, const Gemm g, const Sched& S, const EpiT& E) {
    int tid_ = threadIdx.x; asm volatile("" : "+v"(tid_));
    const int tid = tid_, wid = __builtin_amdgcn_readfirstlane(tid >> 6), lane = tid & 63, wr = wid >> 2, wc = wid & 3, fr = lane & 15, fq = lane >> 4;
    const int K = g.K, nt = K / BK;
    unsigned voffA[2], voffB[2];
#pragma unroll
    for (int i = 0; i < 2; ++i) { int R, C; stage_rc(tid * 16 + i * 8192, R, C); const int Rb = (R & ~31) + perm32(R & 31);
        voffA[i] = (unsigned)(R * K + C) * 2u; voffB[i] = (unsigned)(Rb * K + C) * 2u; }
    const size_t kstep = (size_t)(BK * 2);
    const size_t hstep = (size_t)HALF * K * 2;
    const size_t tstep = 2 * hstep;
    const unsigned ldsw = (unsigned)wid * 1024u;
    const int aoff = lds_byte(wr * 64 + fr, fq * 8), boff = lds_byte(wc * 32 + fr, fq * 8);
#define PG8_SA(b, h) (((b) * 2 + (h)) * HTB)
#define PG8_SB(b, h) ((4 + (b) * 2 + (h)) * HTB)
#define PG8_STAGE(bufoff, gbase, voff) do { _Pragma("unroll") for (int _i = 0; _i < 2; ++_i) \
        __builtin_amdgcn_global_load_lds((const unsigned*)((const char*)(gbase) + (voff)[_i]), (LAS unsigned*)(lds + (bufoff) + ldsw + _i * 8192), 16, 0, 0); } while (0)
#define PG8_LDA(dst, b, h) do { _Pragma("unroll") for (int m = 0; m < 4; ++m) _Pragma("unroll") for (int k = 0; k < 2; ++k) dst[m][k] = *(const LAS bf16x8*)(lds + PG8_SA(b, h) + aoff + m * 2048 + k * 1024); } while (0)
#define PG8_LDB(dst, b, h) do { _Pragma("unroll") for (int n = 0; n < 2; ++n) _Pragma("unroll") for (int k = 0; k < 2; ++k) dst[n][k] = *(const LAS bf16x8*)(lds + PG8_SB(b, h) + boff + n * 2048 + k * 1024); } while (0)
#define PG8_MMA(ai, bj, At, Bt) do { __builtin_amdgcn_s_setprio(1); _Pragma("unroll") for (int m = 0; m < 4; ++m) _Pragma("unroll") for (int n = 0; n < 2; ++n) _Pragma("unroll") for (int k = 0; k < 2; ++k) \
        acc[ai][bj][m][n] = __builtin_amdgcn_mfma_f32_16x16x32_bf16(Bt[n][k], At[m][k], acc[ai][bj][m][n], 0, 0, 0); __builtin_amdgcn_s_setprio(0); } while (0)
#define PG8_WAIT_V(n) asm volatile("s_waitcnt vmcnt(" #n ")" ::: "memory")
#define PG8_WAIT_L(n) asm volatile("s_waitcnt lgkmcnt(" #n ")" ::: "memory")
#define PG8_BAR __builtin_amdgcn_s_barrier()
#define PG8_SCHED __builtin_amdgcn_sched_barrier(0)
    Unit cur, nxt; int ui = 0;
    if (!S.next(0, cur)) return;
    f32x4 acc[2][2][4][2];
#pragma unroll
    for (int a = 0; a < 2; ++a)
#pragma unroll
        for (int b = 0; b < 2; ++b)
#pragma unroll
            for (int m = 0; m < 4; ++m)
#pragma unroll
                for (int n = 0; n < 2; ++n) acc[a][b][m][n] = (f32x4){0.f, 0.f, 0.f, 0.f};
    bf16x8 At[4][2], B0[2][2], B1[2][2];
    const char* cA = (const char*)g.A + (size_t)cur.pm * tstep; const char* cB = (const char*)g.Bt + (size_t)cur.pn * tstep;
    PG8_STAGE(PG8_SB(0, 0), cB, voffB); PG8_STAGE(PG8_SB(0, 1), cB + hstep, voffB); PG8_STAGE(PG8_SA(0, 0), cA, voffA); PG8_STAGE(PG8_SA(0, 1), cA + hstep, voffA);
    if (wr == 1) PG8_BAR;
    PG8_WAIT_V(2); PG8_BAR;
    PG8_STAGE(PG8_SB(1, 0), cB + kstep, voffB); PG8_STAGE(PG8_SA(1, 0), cA + kstep, voffA); PG8_STAGE(PG8_SB(1, 1), cB + hstep + kstep, voffB);
    PG8_WAIT_V(6); PG8_BAR;
    for (;;) {
        const bool has_next = S.next(ui + 1, nxt);
        const char* nA = has_next ? (const char*)g.A + (size_t)nxt.pm * tstep : cA; const char* nB = has_next ? (const char*)g.Bt + (size_t)nxt.pn * tstep : cB;
        for (int t = 0; t < nt; t += 2) {
            const bool last = (t == nt - 2);
            const char* a1 = cA + (size_t)(t + 1) * kstep;
            const char* a2 = last ? nA : cA + (size_t)(t + 2) * kstep; const char* b2 = last ? nB : cB + (size_t)(t + 2) * kstep;
            const char* a3 = a2 + kstep; const char* b3 = b2 + kstep;
            PG8_LDB(B0, 0, 0); PG8_LDB(B1, 0, 1); PG8_SCHED; PG8_LDA(At, 0, 0); PG8_STAGE(PG8_SA(1, 1), a1 + hstep, voffA);
            PG8_WAIT_V(8); PG8_WAIT_L(0); PG8_BAR; PG8_MMA(0, 0, At, B0); PG8_MMA(0, 1, At, B1); PG8_BAR; PG8_SCHED;
            PG8_LDA(At, 0, 1); PG8_STAGE(PG8_SB(0, 0), b2, voffB); PG8_STAGE(PG8_SB(0, 1), b2 + hstep, voffB); PG8_STAGE(PG8_SA(0, 0), a2, voffA);
            PG8_WAIT_V(8); PG8_WAIT_L(0); PG8_BAR; PG8_MMA(1, 0, At, B0); PG8_MMA(1, 1, At, B1); PG8_BAR; PG8_SCHED;
            PG8_LDB(B0, 1, 0); PG8_LDB(B1, 1, 1); PG8_SCHED; PG8_LDA(At, 1, 0); PG8_STAGE(PG8_SA(0, 1), a2 + hstep, voffA);
            PG8_WAIT_V(8); PG8_WAIT_L(0); PG8_BAR; PG8_MMA(0, 0, At, B0); PG8_MMA(0, 1, At, B1); PG8_BAR; PG8_SCHED;
            PG8_LDA(At, 1, 1); PG8_STAGE(PG8_SB(1, 0), b3, voffB); PG8_STAGE(PG8_SB(1, 1), b3 + hstep, voffB); PG8_STAGE(PG8_SA(1, 0), a3, voffA);
            PG8_WAIT_V(8); PG8_WAIT_L(0); PG8_BAR; PG8_MMA(1, 0, At, B0); PG8_MMA(1, 1, At, B1); PG8_BAR; PG8_SCHED;
        }
        if (wr == 0) PG8_BAR;
        E(acc, cur, wr, wc, fr, fq);
        if (!has_next) break;
#pragma unroll
        for (int a = 0; a < 2; ++a)
#pragma unroll
            for (int b = 0; b < 2; ++b)
#pragma unroll
                for (int m = 0; m < 4; ++m)
#pragma unroll
                    for (int n = 0; n < 2; ++n) acc[a][b][m][n] = (f32x4){0.f, 0.f, 0.f, 0.f};
        cur = nxt; cA = nA; cB = nB; ++ui;
        if (wr == 1) PG8_BAR;
    }
    PG8_WAIT_V(0);
    PG8_BAR;
#undef PG8_SA
#undef PG8_SB
#undef PG8_STAGE
#undef PG8_LDA
#undef PG8_LDB
#undef PG8_MMA
#undef PG8_WAIT_V
#undef PG8_WAIT_L
#undef PG8_BAR
#undef PG8_SCHED
}
}

#ifndef QKT_SB_FROM
#define QKT_SB_FROM 100000
#endif
#ifndef QKT_SB_EVERY
#define QKT_SB_EVERY 4
#endif
#ifndef ATT_SD1_FROM
#define ATT_SD1_FROM 128
#endif
namespace att {
constexpr int NW = 8, QBLK = 32, KVBLK = 64;
constexpr float THR = 8.f;
constexpr int SHM_V = KVBLK * 128 * 2;
#define SBAR() __builtin_amdgcn_sched_barrier(0)
__device__ __forceinline__ int crow(int r, int hi) { return (r & 3) + 8 * (r >> 2) + 4 * hi; }
template <int DQK> __device__ __forceinline__ constexpr float scale_of() { return DQK == 64 ? 0.125f : (DQK == 128 ? 0.088388347648318440f : 0.072168783648703220f); }

template <int DQK>
__device__ __forceinline__ void partialSM(f32x16& p0, f32x16& p1, float& m_reg, float& mn, float& alpha) {
    constexpr float SCALE = scale_of<DQK>();
    constexpr float C = SCALE * 1.4426950408889634f;
    float pmax = p0[0];
#pragma unroll
    for (int r = 1; r < 16; ++r) pmax = fmaxf(pmax, p0[r]);
#pragma unroll
    for (int r = 0; r < 16; ++r) pmax = fmaxf(pmax, p1[r]);
    { auto rr = __builtin_amdgcn_permlane32_swap(__float_as_uint(pmax), __float_as_uint(pmax), false, false);
      pmax = fmaxf(__uint_as_float(rr[0]), __uint_as_float(rr[1])); }
    if (__builtin_expect(__all(pmax - m_reg <= THR / SCALE), 1)) { mn = m_reg; alpha = 1.f; }
    else { mn = fmaxf(m_reg, pmax); alpha = __builtin_amdgcn_exp2f((m_reg - mn) * C); m_reg = mn; }
    float mnC = -mn * C;
#pragma unroll
    for (int r = 0; r < 16; ++r) p0[r] = fmaf(p0[r], C, mnC);
#pragma unroll
    for (int r = 0; r < 16; ++r) p1[r] = fmaf(p1[r], C, mnC);
#pragma unroll
    for (int r = 0; r < 16; ++r) p0[r] = __builtin_amdgcn_exp2f(p0[r]);
}
__device__ __forceinline__ void finishSM(f32x16& p0, f32x16& p1, float alpha, float& l_reg, bf16x8& pa0, bf16x8& pa1, bf16x8& pa2, bf16x8& pa3) {
#pragma unroll
    for (int r = 0; r < 16; ++r) p1[r] = __builtin_amdgcn_exp2f(p1[r]);
    float ps = 0;
#pragma unroll
    for (int r = 0; r < 16; ++r) ps += p0[r];
#pragma unroll
    for (int r = 0; r < 16; ++r) ps += p1[r];
    { auto rr = __builtin_amdgcn_permlane32_swap(__float_as_uint(ps), __float_as_uint(ps), false, false);
      ps = __uint_as_float(rr[0]) + __uint_as_float(rr[1]); }
    l_reg = l_reg * alpha + ps;
#define PK4(P, BASE, OUT) do { unsigned a0 = cvt_pk_bf16(P[BASE + 0], P[BASE + 1]), a1 = cvt_pk_bf16(P[BASE + 2], P[BASE + 3]);   \
    unsigned b0 = cvt_pk_bf16(P[BASE + 4], P[BASE + 5]), b1 = cvt_pk_bf16(P[BASE + 6], P[BASE + 7]);                              \
    auto r0 = __builtin_amdgcn_permlane32_swap(a0, b0, false, false); auto r1 = __builtin_amdgcn_permlane32_swap(a1, b1, false, false); \
    u32x4 w = {r0[0], r1[0], r0[1], r1[1]}; OUT = *reinterpret_cast<bf16x8*>(&w); } while (0)
    PK4(p0, 0, pa0); PK4(p0, 8, pa1); PK4(p1, 0, pa2); PK4(p1, 8, pa3);
#undef PK4
}
template <int DQK, int QL = 0>
__device__ __forceinline__ void qkt(f32x16& p0, f32x16& p1, const char* Ks, const bf16x8* qr, int r32, int hi, const char* Qs = nullptr) {
    p0 = f32x16{}; p1 = f32x16{};
#pragma unroll
    for (int d0 = 0; d0 < DQK / 16; ++d0) { const int cb = (d0 * 16 + hi * 8) * 2;
        bf16x8 b0 = *reinterpret_cast<const bf16x8*>(Ks + r32 * (DQK * 2) + (cb ^ ((r32 & 7) << 4)));
        bf16x8 b1 = *reinterpret_cast<const bf16x8*>(Ks + (32 + r32) * (DQK * 2) + (cb ^ ((r32 & 7) << 4)));
        bf16x8 q;
        if (d0 < DQK / 16 - QL) q = qr[d0]; else q = *reinterpret_cast<const bf16x8*>(Qs + (d0 - (DQK / 16 - QL)) * 1024);
        p0 = __builtin_amdgcn_mfma_f32_32x32x16_bf16(b0, q, p0, 0, 0, 0);
        p1 = __builtin_amdgcn_mfma_f32_32x32x16_bf16(b1, q, p1, 0, 0, 0);
        if (DQK > QKT_SB_FROM && (d0 % QKT_SB_EVERY) == QKT_SB_EVERY - 1) SBAR(); }
}
__device__ __forceinline__ int v_st(int k, int c) { const int kk = (k & ~0xC) | ((k & 4) << 1) | ((k & 8) >> 1); return ((kk >> 3) * 4 + (c >> 5)) * 512 + ((kk & 7) * 32 + (c & 31)) * 2; }
__device__ __forceinline__ int v_rd_base(int lane) { return ((lane & 3) << 3) | (((lane >> 2) & 3) << 6) | (((lane >> 4) & 1) << 5) | (((lane >> 5) & 1) << 8); }
constexpr int v_rd_off(int d0, int ks, int half) { return d0 * 512 + ks * 4096 + half * 2048; }
template <int OFF> __device__ __forceinline__ s16x4 tr_read(int vb) {
    s16x4 r; asm volatile("ds_read_b64_tr_b16 %0, %1 offset:%2" : "=&v"(r) : "v"(vb), "i"(OFF) : "memory"); return r;
}
template <int D0> __device__ __forceinline__ void pv_one(f32x16& od, int vb, bf16x8 pa0, bf16x8 pa1, bf16x8 pa2, bf16x8 pa3) {
    const s16x4 l0 = tr_read<v_rd_off(D0, 0, 0)>(vb), h0 = tr_read<v_rd_off(D0, 0, 1)>(vb), l1 = tr_read<v_rd_off(D0, 1, 0)>(vb), h1 = tr_read<v_rd_off(D0, 1, 1)>(vb);
    const s16x4 l2 = tr_read<v_rd_off(D0, 2, 0)>(vb), h2 = tr_read<v_rd_off(D0, 2, 1)>(vb), l3 = tr_read<v_rd_off(D0, 3, 0)>(vb), h3 = tr_read<v_rd_off(D0, 3, 1)>(vb);
    asm volatile("s_waitcnt lgkmcnt(0)" ::: "memory"); SBAR();
#define PK(L, H) (bf16x8){L[0], L[1], L[2], L[3], H[0], H[1], H[2], H[3]}
    od = __builtin_amdgcn_mfma_f32_32x32x16_bf16(pa0, PK(l0, h0), od, 0, 0, 0);
    od = __builtin_amdgcn_mfma_f32_32x32x16_bf16(pa1, PK(l1, h1), od, 0, 0, 0);
    od = __builtin_amdgcn_mfma_f32_32x32x16_bf16(pa2, PK(l2, h2), od, 0, 0, 0);
    od = __builtin_amdgcn_mfma_f32_32x32x16_bf16(pa3, PK(l3, h3), od, 0, 0, 0);
#undef PK
}
__device__ __forceinline__ void pv_d0(f32x16* o, int vb, bf16x8 pa0, bf16x8 pa1, bf16x8 pa2, bf16x8 pa3) {
    pv_one<0>(o[0], vb, pa0, pa1, pa2, pa3); pv_one<1>(o[1], vb, pa0, pa1, pa2, pa3); pv_one<2>(o[2], vb, pa0, pa1, pa2, pa3); pv_one<3>(o[3], vb, pa0, pa1, pa2, pa3);
}

template <int DQK, int ldq, int ldk, int ldv, int ldo, int QL = 0>
__device__ __forceinline__ void attn_body(const bf16_t* __restrict__ Qb, const bf16_t* __restrict__ Kh, const bf16_t* __restrict__ Vh,
                                          bf16_t* __restrict__ Ob, int seq, char* lds) {
    constexpr int SHM_K = KVBLK * DQK * 2, NKC = DQK / 64, SD = (DQK >= ATT_SD1_FROM) ? 1 : 2, CPR = DQK / 8;
    int tid_ = threadIdx.x; asm volatile("" : "+v"(tid_));
    const int tid = tid_, wid = tid >> 6, lane = tid & 63, r32 = lane & 31, hi = lane >> 5;
    char* V_lds = lds; char* K_lds = lds + 2 * SHM_V;
    float* ws = (float*)(lds + 2 * SHM_V + 2 * SHM_K) + wid * 64; float* li_l = ws; float* al_l = ws + 32;
    constexpr int NQR = DQK / 16 - QL;
    float m_reg = -1e30f, l_reg = 0; f32x16 o[4] = {}; bf16x8 qr[NQR];
    const bf16_t* Qw = Qb + (long)(wid * QBLK + r32) * ldq + hi * 8;
#pragma unroll
    for (int d0 = 0; d0 < NQR; ++d0) qr[d0] = *reinterpret_cast<const bf16x8*>(Qw + d0 * 16);
    char* Qs = lds + 2 * SHM_V + 2 * SHM_K + NW * 256 + wid * (QL * 1024) + lane * 16;
#pragma unroll
    for (int d0 = 0; d0 < QL; ++d0) *reinterpret_cast<bf16x8*>(Qs + d0 * 1024) = *reinterpret_cast<const bf16x8*>(Qw + (NQR + d0) * 16);
    const int sr = tid >> 4, sc = (tid & 15) * 8, vst0 = v_st(sr, sc), vst1 = v_st(32 + sr, sc);
    unsigned koff[NKC]; int kdst[NKC];
    const unsigned voffV0 = (unsigned)(sr * ldv + sc) * 2u, voffV1 = (unsigned)((32 + sr) * ldv + sc) * 2u;
#pragma unroll
    for (int kc = 0; kc < NKC; ++kc) { const int ci = tid + 512 * kc; const int krow = ci / CPR, kcol = (ci % CPR) * 8; koff[kc] = (unsigned)(krow * ldk + kcol) * 2u;
        kdst[kc] = krow * (DQK * 2) + ((kcol * 2) ^ ((krow & 7) << 4)); }
    const int vb0 = (int)(uintptr_t)V_lds + v_rd_base(lane);
    struct { bf16x8 vs0, vs1, ks[NKC]; } sr_[SD];
#define SLOAD(i, k0) do { const char* vb_ = (const char*)Vh + (size_t)(k0) * (ldv * 2); const char* kb_ = (const char*)Kh + (size_t)(k0) * (ldk * 2); \
    sr_[i].vs0 = *reinterpret_cast<const bf16x8*>(vb_ + voffV0); sr_[i].vs1 = *reinterpret_cast<const bf16x8*>(vb_ + voffV1); \
    _Pragma("unroll") for (int kc_ = 0; kc_ < NKC; ++kc_) sr_[i].ks[kc_] = *reinterpret_cast<const bf16x8*>(kb_ + koff[kc_]); } while (0)
#define SWRITE(b, i) do { *(bf16x8*)(V_lds + (b) * SHM_V + vst0) = sr_[i].vs0; *(bf16x8*)(V_lds + (b) * SHM_V + vst1) = sr_[i].vs1; \
    _Pragma("unroll") for (int kc_ = 0; kc_ < NKC; ++kc_) *(bf16x8*)(K_lds + (b) * SHM_K + kdst[kc_]) = sr_[i].ks[kc_]; } while (0)
#define SWAIT() do { if constexpr (SD == 2) asm volatile("s_waitcnt vmcnt(%0)" :: "n"(2 + NKC) : "memory"); else asm volatile("s_waitcnt vmcnt(0)" ::: "memory"); } while (0)
#define RESC(a) do { if (__any((a) < 1.f)) { if (hi == 0) al_l[r32] = (a); asm volatile("s_waitcnt lgkmcnt(0)" ::: "memory"); \
    _Pragma("unroll") for (int d = 0; d < 4; ++d) _Pragma("unroll") for (int r = 0; r < 16; ++r) o[d][r] *= al_l[crow(r, hi)]; } } while (0)
    f32x16 pA0, pA1, pB0, pB1; float mnA, mnB, alA, alB; bf16x8 pa0, pa1, pa2, pa3; const int NT = seq / KVBLK;
    constexpr int SE = 0, SO = SD - 1;
    SLOAD(SE, 0); asm volatile("s_waitcnt vmcnt(0)" ::: "memory"); SWRITE(0, SE); __syncthreads();
    qkt<DQK, QL>(pA0, pA1, K_lds, qr, r32, hi, Qs); partialSM<DQK>(pA0, pA1, m_reg, mnA, alA);
    SLOAD(SO, KVBLK); if constexpr (SD == 2) { if (2 < NT) SLOAD(SE, 2 * KVBLK); }
    SWAIT(); SWRITE(1, SO); __syncthreads();
    for (int j = 1; j + 1 < NT; j += 2) {
        SBAR(); qkt<DQK, QL>(pB0, pB1, K_lds + SHM_K, qr, r32, hi, Qs);
        finishSM(pA0, pA1, alA, l_reg, pa0, pa1, pa2, pa3); SBAR();
        SLOAD(SO, (j + SD) * KVBLK); SBAR();
        pv_d0(o, vb0, pa0, pa1, pa2, pa3); partialSM<DQK>(pB0, pB1, m_reg, mnB, alB);
        __syncthreads(); SWAIT(); SWRITE(0, SE);
        RESC(alB); __syncthreads();
        SBAR(); qkt<DQK, QL>(pA0, pA1, K_lds, qr, r32, hi, Qs);
        finishSM(pB0, pB1, alB, l_reg, pa0, pa1, pa2, pa3); SBAR();
        if (SD == 1 || j + 3 < NT) SLOAD(SE, (j + 1 + SD) * KVBLK); SBAR();
        pv_d0(o, vb0 + (int)SHM_V, pa0, pa1, pa2, pa3); partialSM<DQK>(pA0, pA1, m_reg, mnA, alA);
        __syncthreads(); SWAIT(); SWRITE(1, SO);
        RESC(alA); __syncthreads();
    }
    SBAR(); qkt<DQK, QL>(pB0, pB1, K_lds + SHM_K, qr, r32, hi, Qs);
    finishSM(pA0, pA1, alA, l_reg, pa0, pa1, pa2, pa3); SBAR();
    pv_d0(o, vb0, pa0, pa1, pa2, pa3); partialSM<DQK>(pB0, pB1, m_reg, mnB, alB);
    __syncthreads(); RESC(alB);
    finishSM(pB0, pB1, alB, l_reg, pa0, pa1, pa2, pa3); SBAR();
    pv_d0(o, vb0 + (int)SHM_V, pa0, pa1, pa2, pa3);
    if (hi == 0) li_l[r32] = l_reg; asm volatile("s_waitcnt lgkmcnt(0)" ::: "memory");
    float rli[16];
#pragma unroll
    for (int r = 0; r < 16; ++r) rli[r] = __builtin_amdgcn_rcpf(li_l[crow(r, hi)]);
    bf16_t* Ow = Ob + (long)(wid * QBLK) * ldo;
#pragma unroll
    for (int r = 0; r < 16; ++r) { const int orow = crow(r, hi);
#pragma unroll
        for (int d0 = 0; d0 < 4; ++d0) Ow[(long)orow * ldo + d0 * 32 + r32] = f2bf(o[d0][r] * rli[r]); }
    __syncthreads();
#undef SLOAD
#undef SWRITE
#undef SWAIT
#undef RESC
}

template <int DQK, int ldq, int ldk, int ldv, int ldo>
__device__ __forceinline__ void attn_body_simple(const bf16_t* __restrict__ Qb, const bf16_t* __restrict__ Kh, const bf16_t* __restrict__ Vh,
                                                 bf16_t* __restrict__ Ob, int seq, char* lds) {
    constexpr int SHM_K = KVBLK * DQK * 2, NKC = DQK / 64, CPR = DQK / 8;
    int tid_ = threadIdx.x; asm volatile("" : "+v"(tid_));
    const int tid = tid_, wid = tid >> 6, lane = tid & 63, r32 = lane & 31, hi = lane >> 5;
    char* V_lds = lds; char* K_lds = lds + 2 * SHM_V;
    float* ws = (float*)(lds + 2 * SHM_V + 2 * SHM_K) + wid * 64; float* li_l = ws; float* al_l = ws + 32;
    float m_reg = -1e30f, l_reg = 0; f32x16 o[4] = {}; bf16x8 qr[DQK / 16];
    const bf16_t* Qw = Qb + (long)(wid * QBLK + r32) * ldq + hi * 8;
#pragma unroll
    for (int d0 = 0; d0 < DQK / 16; ++d0) qr[d0] = *reinterpret_cast<const bf16x8*>(Qw + d0 * 16);
    const int sr = tid >> 4, sc = (tid & 15) * 8, vst0 = v_st(sr, sc), vst1 = v_st(32 + sr, sc);
    unsigned koff[NKC]; int kdst[NKC];
    const unsigned voffV0 = (unsigned)(sr * ldv + sc) * 2u, voffV1 = (unsigned)((32 + sr) * ldv + sc) * 2u;
#pragma unroll
    for (int kc = 0; kc < NKC; ++kc) { const int ci = tid + 512 * kc; const int krow = ci / CPR, kcol = (ci % CPR) * 8; koff[kc] = (unsigned)(krow * ldk + kcol) * 2u;
        kdst[kc] = krow * (DQK * 2) + ((kcol * 2) ^ ((krow & 7) << 4)); }
    const int vb0 = (int)(uintptr_t)V_lds + v_rd_base(lane);
    bf16x8 vs0, vs1, ks[NKC];
#define SLOAD1(k0) do { const char* vb_ = (const char*)Vh + (size_t)(k0) * (ldv * 2); const char* kb_ = (const char*)Kh + (size_t)(k0) * (ldk * 2); \
    vs0 = *reinterpret_cast<const bf16x8*>(vb_ + voffV0); vs1 = *reinterpret_cast<const bf16x8*>(vb_ + voffV1); \
    _Pragma("unroll") for (int kc_ = 0; kc_ < NKC; ++kc_) ks[kc_] = *reinterpret_cast<const bf16x8*>(kb_ + koff[kc_]); } while (0)
#define SWRITE1(b) do { *(bf16x8*)(V_lds + (b) * SHM_V + vst0) = vs0; *(bf16x8*)(V_lds + (b) * SHM_V + vst1) = vs1; \
    _Pragma("unroll") for (int kc_ = 0; kc_ < NKC; ++kc_) *(bf16x8*)(K_lds + (b) * SHM_K + kdst[kc_]) = ks[kc_]; } while (0)
    f32x16 pA0, pA1; float mnA, alA; bf16x8 pa0, pa1, pa2, pa3; const int NT = seq / KVBLK;
    SLOAD1(0); asm volatile("s_waitcnt vmcnt(0)" ::: "memory"); SWRITE1(0); __syncthreads();
    for (int j = 0; j < NT; ++j) {
        const int buf = j & 1;
        if (j + 1 < NT) SLOAD1((j + 1) * KVBLK);
        SBAR();
        qkt<DQK>(pA0, pA1, K_lds + buf * SHM_K, qr, r32, hi);
        partialSM<DQK>(pA0, pA1, m_reg, mnA, alA);
        if (__any(alA < 1.f)) { if (hi == 0) al_l[r32] = alA; asm volatile("s_waitcnt lgkmcnt(0)" ::: "memory");
#pragma unroll
            for (int d = 0; d < 4; ++d)
#pragma unroll
                for (int r = 0; r < 16; ++r) o[d][r] *= al_l[crow(r, hi)]; }
        finishSM(pA0, pA1, alA, l_reg, pa0, pa1, pa2, pa3); SBAR();
        pv_d0(o, vb0 + buf * (int)SHM_V, pa0, pa1, pa2, pa3);
        if (j + 1 < NT) { asm volatile("s_waitcnt vmcnt(0)" ::: "memory"); SWRITE1(buf ^ 1); }
        __syncthreads();
    }
    if (hi == 0) li_l[r32] = l_reg; asm volatile("s_waitcnt lgkmcnt(0)" ::: "memory");
    float rli[16];
#pragma unroll
    for (int r = 0; r < 16; ++r) rli[r] = __builtin_amdgcn_rcpf(li_l[crow(r, hi)]);
    bf16_t* Ow = Ob + (long)(wid * QBLK) * ldo;
#pragma unroll
    for (int r = 0; r < 16; ++r) { const int orow = crow(r, hi);
#pragma unroll
        for (int d0 = 0; d0 < 4; ++d0) Ow[(long)orow * ldo + d0 * 32 + r32] = f2bf(o[d0][r] * rli[r]); }
    __syncthreads();
#undef SLOAD1
#undef SWRITE1
}

template <int DQK, int ldq, int ldk, int ldv, int ldo>
__device__ __forceinline__ void attn_body_dma(const bf16_t* __restrict__ Qb, const bf16_t* __restrict__ Kh, const bf16_t* __restrict__ Vh,
                                              bf16_t* __restrict__ Ob, int seq, char* lds) {
    constexpr int SHM_K = KVBLK * DQK * 2, NKC = DQK / 64;
    int tid_ = threadIdx.x; asm volatile("" : "+v"(tid_));
    const int tid = tid_, wid = __builtin_amdgcn_readfirstlane(tid >> 6), lane = tid & 63, r32 = lane & 31, hi = lane >> 5;
    char* V_lds = lds; char* K_lds = lds + 2 * SHM_V;
    float* ws = (float*)(lds + 2 * SHM_V + 2 * SHM_K) + wid * 64; float* li_l = ws; float* al_l = ws + 32;
    float m_reg = -1e30f, l_reg = 0; f32x16 o[4] = {}; bf16x8 qr[DQK / 16];
    const bf16_t* Qw = Qb + (long)(wid * QBLK + r32) * ldq + hi * 8;
#pragma unroll
    for (int d0 = 0; d0 < DQK / 16; ++d0) qr[d0] = *reinterpret_cast<const bf16x8*>(Qw + d0 * 16);
    unsigned vsrc[2], ksrc[NKC];
#pragma unroll
    for (int i = 0; i < 2; ++i) { const int o_ = i * 8192 + tid * 16; const int sub = o_ >> 9, w_ = (o_ & 511) >> 1; const int kk = (sub >> 2) * 8 + (w_ >> 5), c = (sub & 3) * 32 + (w_ & 31);
        const int k = (kk & ~0xC) | ((kk & 4) << 1) | ((kk & 8) >> 1); vsrc[i] = (unsigned)(k * ldv + c) * 2u; }
#pragma unroll
    for (int i = 0; i < NKC; ++i) { const int o_ = i * 8192 + tid * 16; const int row = o_ / (DQK * 2), b = o_ % (DQK * 2); const int cb = b ^ ((row & 7) << 4);
        ksrc[i] = (unsigned)(row * ldk) * 2u + (unsigned)cb; }
    const unsigned vdst = (unsigned)(uintptr_t)V_lds + (unsigned)wid * 1024u, kdst0 = (unsigned)(uintptr_t)K_lds + (unsigned)wid * 1024u;
    const int vb0 = (int)(uintptr_t)V_lds + v_rd_base(lane);
#define DMA_TILE(k0, b) do { const char* vb_ = (const char*)Vh + (size_t)(k0) * (ldv * 2); const char* kb_ = (const char*)Kh + (size_t)(k0) * (ldk * 2); \
    _Pragma("unroll") for (int i_ = 0; i_ < 2; ++i_) __builtin_amdgcn_global_load_lds((const unsigned*)(vb_ + vsrc[i_]), (LAS unsigned*)(vdst + (b) * SHM_V + i_ * 8192), 16, 0, 0); \
    _Pragma("unroll") for (int i_ = 0; i_ < NKC; ++i_) __builtin_amdgcn_global_load_lds((const unsigned*)(kb_ + ksrc[i_]), (LAS unsigned*)(kdst0 + (b) * SHM_K + i_ * 8192), 16, 0, 0); } while (0)
    f32x16 pA0, pA1; float mnA, alA; bf16x8 pa0, pa1, pa2, pa3; const int NT = seq / KVBLK;
    DMA_TILE(0, 0); asm volatile("s_waitcnt vmcnt(0)" ::: "memory"); __syncthreads();
    for (int j = 0; j < NT; ++j) {
        const int buf = j & 1;
        SBAR();
        qkt<DQK>(pA0, pA1, K_lds + buf * SHM_K, qr, r32, hi);
        SBAR();
        if (j + 1 < NT) DMA_TILE((j + 1) * KVBLK, buf ^ 1);
        SBAR();
        partialSM<DQK>(pA0, pA1, m_reg, mnA, alA);
        if (__any(alA < 1.f)) { if (hi == 0) al_l[r32] = alA; asm volatile("s_waitcnt lgkmcnt(0)" ::: "memory");
#pragma unroll
            for (int d = 0; d < 4; ++d)
#pragma unroll
                for (int r = 0; r < 16; ++r) o[d][r] *= al_l[crow(r, hi)]; }
        finishSM(pA0, pA1, alA, l_reg, pa0, pa1, pa2, pa3); SBAR();
        pv_d0(o, vb0 + buf * (int)SHM_V, pa0, pa1, pa2, pa3);
        asm volatile("s_waitcnt vmcnt(0)" ::: "memory");
        __syncthreads();
    }
    if (hi == 0) li_l[r32] = l_reg; asm volatile("s_waitcnt lgkmcnt(0)" ::: "memory");
    float rli[16];
#pragma unroll
    for (int r = 0; r < 16; ++r) rli[r] = __builtin_amdgcn_rcpf(li_l[crow(r, hi)]);
    bf16_t* Ow = Ob + (long)(wid * QBLK) * ldo;
#pragma unroll
    for (int r = 0; r < 16; ++r) { const int orow = crow(r, hi);
#pragma unroll
        for (int d0 = 0; d0 < 4; ++d0) Ow[(long)orow * ldo + d0 * 32 + r32] = f2bf(o[d0][r] * rli[r]); }
    __syncthreads();
#undef DMA_TILE
}
}

__device__ __forceinline__ unsigned pk2(float lo, float hi) { return cvt_pk_bf16(lo, hi); }

__device__ __forceinline__ void transpose_mat(const float* W, int K, int Nsrc, bf16_t* WT, int Ndst, int mode, LAS float* scr, int gw, int NGW, int lane) {
    const int nblk = Ndst / 32, nitems = (K / 64) * nblk;
    for (int item = gw; item < nitems; item += NGW) {
        const int kb = item / nblk, nb = item % nblk, k0 = 64 * kb, n0 = 32 * nb;
        int s0 = n0;
        if (mode == 1) s0 = n0 < 3520 ? n0 : (n0 < 3584 ? -1 : n0 - 64);
        if (mode == 2) { const int pn = n0 >> 8, j = n0 & 255; s0 = j < 128 ? 128 * pn + j : DFF + 128 * pn + (j - 128); }
        float wv[32];
#pragma unroll
        for (int i = 0; i < 32; ++i) { const int kk = 2 * i + (lane >> 5); wv[i] = s0 < 0 ? 0.f : W[(size_t)(k0 + kk) * Nsrc + s0 + (lane & 31)]; }
#pragma unroll
        for (int i = 0; i < 32; ++i) { const int kk = 2 * i + (lane >> 5); scr[kk * 33 + (lane & 31)] = wv[i]; }
        asm volatile("s_waitcnt lgkmcnt(0)" ::: "memory");
        const int c = lane & 7;
#pragma unroll
        for (int j = 0; j < 4; ++j) { const int n = (lane >> 3) + 8 * j; const LAS float* s = scr + (8 * c) * 33 + n;
            u32x4 o; o.x = pk2(s[0 * 33], s[1 * 33]); o.y = pk2(s[2 * 33], s[3 * 33]); o.z = pk2(s[4 * 33], s[5 * 33]); o.w = pk2(s[6 * 33], s[7 * 33]);
            *(u32x4*)(WT + (size_t)(n0 + n) * K + k0 + 8 * c) = o; }
        asm volatile("s_waitcnt lgkmcnt(0)" ::: "memory");
    }
}

__device__ __forceinline__ void ph_prologue(const Params& p, LAS unsigned char* lds) {
    const int tid = otid(), wave = tid >> 6, lane = tid & 63;
    const int gw = obid() * 8 + wave, NGW = gridDim.x * 8;
    LAS float* scr = (LAS float*)(lds + wave * 16384);
    for (int l = 0; l < 2; ++l) {
        bf16_t* Wl = (bf16_t*)(p.ws + WS_W + l * W_LAYER_B);
        transpose_mat(p.in[7] + (size_t)l * 1024 * 7616, 1024, 7616, Wl + W_IN, 7680, 1, scr, gw, NGW, lane);
        transpose_mat(p.in[26] + (size_t)l * 256 * 768, 256, 768, Wl + W_UQ, 768, 0, scr, gw, NGW, lane);
        transpose_mat(p.in[27] + (size_t)l * 128 * 1024, 128, 1024, Wl + W_UKV, 1024, 0, scr, gw, NGW, lane);
        transpose_mat(p.in[16] + (size_t)l * 512 * 512, 512, 512, Wl + W_GLU, 512, 0, scr, gw, NGW, lane);
        for (int n = 0; n < 4; ++n) transpose_mat(p.in[30] + ((size_t)l * 4 + n) * 512 * 1024, 512, 1024, Wl + W_BR + (size_t)n * 1024 * 512, 1024, 0, scr, gw, NGW, lane);
        transpose_mat(p.in[31] + (size_t)l * 1024 * 1024, 1024, 1024, Wl + W_OUT, 1024, 0, scr, gw, NGW, lane);
        transpose_mat(p.in[33] + (size_t)l * 1024 * 5632, 1024, 5632, Wl + W_FI, 5632, 2, scr, gw, NGW, lane);
        transpose_mat(p.in[34] + (size_t)l * 2816 * 1024, 2816, 1024, Wl + W_FO, 1024, 0, scr, gw, NGW, lane);
    }
    {
        typedef float f32x2t __attribute__((ext_vector_type(2)));
        f32x2t* T64 = (f32x2t*)(p.ws + WS_ROPE64); f32x2t* T128 = (f32x2t*)(p.ws + WS_ROPE128);
        for (int idx = obid() * 512 + tid; idx < 128 * 16 + 128 * 32; idx += gridDim.x * 512) {
            if (idx < 128 * 16) { const int pos = idx >> 4, k = idx & 15; const float ang = (float)pos * exp2f(-(float)(4 * k) * (13.287712379549449f / 64)); T64[idx] = (f32x2t){cosf(ang), sinf(ang)}; }
            else { const int i2 = idx - 128 * 16, pos = i2 >> 5, k = i2 & 31; const float ang = (float)pos * exp2f(-(float)(4 * k) * (13.287712379549449f / 128)); T128[i2] = (f32x2t){cosf(ang), sinf(ang)}; }
        }
    }
    __syncthreads();
    LAS float* sc = (LAS float*)lds;
    LAS float* part = (LAS float*)(lds + 32768);
    float* MOD = (float*)(p.ws + WS_MOD);
    for (int it = obid(); it < 2 * 96; it += gridDim.x) {
        const int l = it / 96, cb = it % 96;
        for (int idx = tid; idx < 5 * 1024; idx += 512) { const int mi = idx >> 10, k = idx & 1023; const float v = mi < 4 ? p.in[1][mi * 1024 + k] : p.in[3][k]; sc[idx] = v / (1.f + __expf(-v)); }
        __syncthreads();
        const int j = cb * 64 + lane; const float* wm = p.in[4] + (size_t)l * 1024 * MODW + j;
        float a0 = 0, a1 = 0, a2 = 0, a3 = 0, a4 = 0;
#pragma unroll 32
        for (int kk = 0; kk < 128; ++kk) { const int k = wave * 128 + kk; const float w = wm[(size_t)k * MODW];
            a0 += sc[k] * w; a1 += sc[1024 + k] * w; a2 += sc[2048 + k] * w; a3 += sc[3072 + k] * w; a4 += sc[4096 + k] * w; }
        part[(wave * 5 + 0) * 64 + lane] = a0; part[(wave * 5 + 1) * 64 + lane] = a1; part[(wave * 5 + 2) * 64 + lane] = a2; part[(wave * 5 + 3) * 64 + lane] = a3; part[(wave * 5 + 4) * 64 + lane] = a4;
        __syncthreads();
        if (tid < 320) { const int mi = tid >> 6, jj = tid & 63; float s = 0;
#pragma unroll
            for (int w = 0; w < 8; ++w) s += part[(w * 5 + mi) * 64 + jj];
            MOD[((size_t)l * 5 + mi) * MODW + cb * 64 + jj] = s + p.in[5][l * MODW + cb * 64 + jj]; }
        __syncthreads();
    }
}

__device__ __forceinline__ const float* row_src(int R, const float* xl, const float* xc, int& mi) {
    const int b = R / RB, s = R - b * RB;
    if (s < CTX) { mi = 4; return xc + ((size_t)b * CTX + s) * DM; }
    mi = b; return xl + ((size_t)b * SEQ + (s - CTX)) * DM;
}
__device__ __forceinline__ void nm_finish(const f32x4 (&v)[4], int R, int mi, int lane, const float* gain, const float* modl, int sh_chunk, bf16_t* H) {
    const float* shp = modl + (size_t)mi * MODW + sh_chunk * 1024; const float* scp = shp + 1024;
    float ss = 0.f;
#pragma unroll
    for (int j = 0; j < 4; ++j) ss += (v[j].x * v[j].x + v[j].y * v[j].y) + (v[j].z * v[j].z + v[j].w * v[j].w);
    const float rs = rsqrtf(wave_sum(ss) * (1.f / DM) + EPS);
#pragma unroll
    for (int j = 0; j < 4; ++j) { const int c = j * 256 + lane * 4;
        const f32x4 g = *(const f32x4*)(gain + c), sh = *(const f32x4*)(shp + c), sc = *(const f32x4*)(scp + c);
        const f32x4 y = (v[j] * rs * g) * (sc + 1.0f) + sh;
        u32x2 w; w.x = cvt_pk_bf16(y.x, y.y); w.y = cvt_pk_bf16(y.z, y.w);
        *(u32x2*)(H + (size_t)R * DM + c) = w; }
}
__device__ __forceinline__ void ph_norm_mod(const float* xl, const float* xc, const float* gain, const float* modl, int sh_chunk, bf16_t* H) {
    const int tid = otid(); const int lane = tid & 63, gw = obid() * 8 + (tid >> 6), NGW = gridDim.x * 8;
    for (int R = gw; R < MTOT; R += 2 * NGW) {
        const int R2 = R + NGW; const bool has2 = R2 < MTOT;
        int mi, mi2 = 0; const float* xr = row_src(R, xl, xc, mi); const float* xr2 = has2 ? row_src(R2, xl, xc, mi2) : xr;
        f32x4 v[4], v2[4];
#pragma unroll
        for (int j = 0; j < 4; ++j) v[j] = *(const f32x4*)(xr + j * 256 + lane * 4);
#pragma unroll
        for (int j = 0; j < 4; ++j) v2[j] = *(const f32x4*)(xr2 + j * 256 + lane * 4);
        nm_finish(v, R, mi, lane, gain, modl, sh_chunk, H);
        if (has2) nm_finish(v2, R2, mi2, lane, gain, modl, sh_chunk, H);
    }
}

__device__ __forceinline__ int s5_pos(int i, int dir) { return dir == 0 ? i : (i < CTX ? (CTX - 1 - i) : (RB + CTX - 1 - i)); }
__device__ __forceinline__ void s5_chain(const Params& p, int layer, int unit, LAS unsigned char* lds) {
    const int b = unit >> 6, dir = (unit >> 5) & 1, g = unit & 31;
    const int tid = otid(), wid = tid >> 6, lane = tid & 63, fr = lane & 15, quad = lane >> 4;
    LAS float* BU = (LAS float*)lds;
    LAS bf16_t* Hb = (LAS bf16_t*)(lds + 65536);
    const int ldg = ((layer * 2 + dir) * 32 + g);
    const float* lam_re = p.in[8] + (size_t)ldg * 64; const float* lam_im = p.in[9] + (size_t)ldg * 64;
    const float dt = expf(p.in[10][ldg]);
    const float* bre = p.in[11] + (size_t)ldg * 64 * 16; const float* bim = p.in[12] + (size_t)ldg * 64 * 16;
    const float* cre = p.in[13] + (size_t)ldg * 16 * 64; const float* cim = p.in[14] + (size_t)ldg * 16 * 64;
    const bf16_t* U = (const bf16_t*)(p.ws + WS_G + S_U) + (size_t)b * RB * 512 + g * 16;
    bf16_t* Y = (bf16_t*)(p.ws + WS_G + (dir == 0 ? S_YF : S_YR)) + ((size_t)g * MTOT + (size_t)b * RB) * 16;
    const int cb0 = (wid & 3) * 2;
    bf16x8 bop[2] = {{0, 0, 0, 0, 0, 0, 0, 0}, {0, 0, 0, 0, 0, 0, 0, 0}};
#pragma unroll
    for (int t = 0; t < 2; ++t) {
        const int cb = cb0 + t, pst = (cb & 3) * 16 + fr; const float lr = lam_re[pst], li = lam_im[pst];
        const float mag = expf(lr * dt); const float abr = mag * cosf(li * dt), abi = mag * sinf(li * dt);
        const float den = lr * lr + li * li, nr = abr - 1.f, ni = abi;
        const float cr = (nr * lr + ni * li) / den, ci = (ni * lr - nr * li) / den;
        if (quad < 2) {
#pragma unroll
            for (int j = 0; j < 8; ++j) { const int c = quad * 8 + j; const float br_ = bre[pst * 16 + c], bi_ = bim[pst * 16 + c];
                const float v = (cb < 4) ? cr * br_ - ci * bi_ : cr * bi_ + ci * br_; bop[t][j] = (short)f2bf(v); }
        }
    }
    float ar, ai, hr = 0.f, hi = 0.f;
    { const float lr = lam_re[lane], li = lam_im[lane]; const float mag = expf(lr * dt); ar = mag * cosf(li * dt); ai = mag * sinf(li * dt); }
    bf16x8 cop[4];
#pragma unroll
    for (int ks = 0; ks < 4; ++ks)
#pragma unroll
        for (int j = 0; j < 8; ++j) { const int k = ks * 32 + quad * 8 + j; const float v = (k & 1) ? -cim[fr * 64 + (k >> 1)] : cre[fr * 64 + (k >> 1)]; cop[ks][j] = (short)f2bf(v); }
#define S5_LD(chunk, A_) do { _Pragma("unroll") for (int rb = 0; rb < 4; ++rb) { const int s_ = s5_pos((chunk) * 64 + rb * 16 + fr, dir); \
        A_[rb] = (bf16x8){0, 0, 0, 0, 0, 0, 0, 0}; if (quad < 2) A_[rb] = *(const bf16x8*)(U + (size_t)s_ * 512 + quad * 8); } } while (0)
#define S5_MM(A_, BUb) do { _Pragma("unroll") for (int rb = 0; rb < 4; ++rb) { \
        _Pragma("unroll") for (int t = 0; t < 2; ++t) { f32x4 acc = {0.f, 0.f, 0.f, 0.f}; acc = __builtin_amdgcn_mfma_f32_16x16x32_bf16(A_[rb], bop[t], acc, 0, 0, 0); \
            _Pragma("unroll") for (int j = 0; j < 4; ++j) (BUb)[(rb * 16 + quad * 4 + j) * 128 + (cb0 + t) * 16 + fr] = acc[j]; } } } while (0)
#define S5_C(chunk, Hbb, rb) do { f32x4 acc = {0.f, 0.f, 0.f, 0.f}; \
        _Pragma("unroll") for (int ks = 0; ks < 4; ++ks) { const bf16x8 aop = *(const LAS bf16x8*)((Hbb) + ((rb) * 16 + fr) * 136 + ks * 32 + quad * 8); \
            acc = __builtin_amdgcn_mfma_f32_16x16x32_bf16(aop, cop[ks], acc, 0, 0, 0); } \
        _Pragma("unroll") for (int j = 0; j < 4; ++j) { const int s_ = s5_pos((chunk) * 64 + (rb) * 16 + quad * 4 + j, dir); Y[(size_t)s_ * 16 + fr] = f2bf(acc[j]); } } while (0)
    constexpr int NCH = RB / 64;
    bf16x8 ua[4], ub[4];
    if (wid >= 4) { S5_LD(0, ua); S5_MM(ua, BU); S5_LD(1, ua); }
    __syncthreads();
    for (int k = 0; k < NCH; ++k) {
        LAS float* BUc = BU + (k & 1) * 8192; LAS bf16_t* Hbc = Hb + (k & 1) * (64 * 136);
        if (wid == 0) {
#pragma unroll
            for (int hf = 0; hf < 2; ++hf) {
                float brv[32], biv[32];
#pragma unroll
                for (int i = 0; i < 32; ++i) { brv[i] = BUc[(hf * 32 + i) * 128 + lane]; biv[i] = BUc[(hf * 32 + i) * 128 + 64 + lane]; }
#pragma unroll
                for (int i = 0; i < 32; ++i) {
                    const float nr = fmaf(ar, hr, fmaf(-ai, hi, brv[i])), ni = fmaf(ar, hi, fmaf(ai, hr, biv[i]));
                    hr = nr; hi = ni;
                    *(LAS unsigned*)(Hbc + (hf * 32 + i) * 136 + 2 * lane) = cvt_pk_bf16(hr, hi);
                }
            }
        } else if (wid >= 4) {
            if (k + 1 < NCH) { LAS float* BUn = BU + ((k + 1) & 1) * 8192;
                if (k + 2 < NCH) S5_LD(k + 2, ub);
                S5_MM(ua, BUn);
#pragma unroll
                for (int rb = 0; rb < 4; ++rb) ua[rb] = ub[rb]; }
        } else if (k > 0) {
            LAS bf16_t* Hbp = Hb + ((k - 1) & 1) * (64 * 136);
            S5_C(k - 1, Hbp, wid - 1);
            if (wid == 1) S5_C(k - 1, Hbp, 3);
        }
        __syncthreads();
    }
    if (wid >= 1 && wid < 4) { LAS bf16_t* Hbp = Hb + ((NCH - 1) & 1) * (64 * 136); S5_C(NCH - 1, Hbp, wid - 1); if (wid == 1) S5_C(NCH - 1, Hbp, 3); }
    __syncthreads();
#undef S5_LD
#undef S5_MM
#undef S5_C
}

__device__ __forceinline__ u32x4 gelu8(const u32x4 u, const u32x4 yf, const u32x4 yr, const float* d, int c) {
    float o[8];
#pragma unroll
    for (int e = 0; e < 4; ++e) {
        const float y0 = d[c + 2 * e] * bflo(u[e]) + bflo(yf[e]) + bflo(yr[e]);
        const float y1 = d[c + 2 * e + 1] * bfhi(u[e]) + bfhi(yf[e]) + bfhi(yr[e]);
        o[2 * e] = y0 * sigmoidf_(1.5957691216057308f * (y0 + 0.044715f * y0 * y0 * y0));
        o[2 * e + 1] = y1 * sigmoidf_(1.5957691216057308f * (y1 + 0.044715f * y1 * y1 * y1));
    }
    u32x4 w; w.x = cvt_pk_bf16(o[0], o[1]); w.y = cvt_pk_bf16(o[2], o[3]); w.z = cvt_pk_bf16(o[4], o[5]); w.w = cvt_pk_bf16(o[6], o[7]);
    return w;
}
__device__ __forceinline__ void ph_s5_gelu(const Params& p, int layer) {
    bf16_t* U = (bf16_t*)(p.ws + WS_G + S_U); const bf16_t* YF = (const bf16_t*)(p.ws + WS_G + S_YF); const bf16_t* YR = (const bf16_t*)(p.ws + WS_G + S_YR);
    const float* d = p.in[15] + layer * 512;
    const size_t n8 = (size_t)MTOT * 512 / 8, stride = (size_t)gridDim.x * 512;
    const int tid = otid();
    for (size_t i = (size_t)obid() * 512 + tid; i < n8; i += 2 * stride) {
        const size_t i2 = i + stride; const bool has2 = i2 < n8; const size_t ib = has2 ? i2 : i;
        const int c = (int)(i & 63) * 8, c2 = (int)(ib & 63) * 8;
        const size_t yo = ((size_t)(c >> 4) * MTOT + (i >> 6)) * 16 + (c & 15), yo2 = ((size_t)(c2 >> 4) * MTOT + (ib >> 6)) * 16 + (c2 & 15);
        const u32x4 u = *(const u32x4*)(U + i * 8), yf = *(const u32x4*)(YF + yo), yr = *(const u32x4*)(YR + yo);
        const u32x4 ub = *(const u32x4*)(U + ib * 8), yfb = *(const u32x4*)(YF + yo2), yrb = *(const u32x4*)(YR + yo2);
        *(u32x4*)(U + i * 8) = gelu8(u, yf, yr, d, c);
        if (has2) *(u32x4*)(U + ib * 8) = gelu8(ub, yfb, yrb, d, c2);
    }
}

template <int NP> __device__ __forceinline__ void seg_load(const bf16_t* in, int ncols, int lane, unsigned (&w)[NP]) {
#pragma unroll
    for (int i = 0; i < NP; ++i) w[i] = (128 * i + 2 * lane < ncols) ? *(const unsigned*)(in + 128 * i + 2 * lane) : 0u;
}
template <int CW, int NP>
__device__ __forceinline__ void seg_fin(const unsigned (&w)[NP], bf16_t* out, int ncols, const float* gain, bool rope, int t, int lane, const float* rtab = nullptr) {
#pragma unroll
    for (int i = 0; i < NP; ++i) {
        const bool valid = 128 * i + 2 * lane < ncols;
        const float x0 = bflo(w[i]), x1 = bfhi(w[i]);
        float ss = x0 * x0 + x1 * x1;
        ss = (CW == 64) ? half_sum(ss) : wave_sum(ss);
        const float rs = rsqrtf(ss * (1.f / CW) + EPS);
        const int e = (2 * lane) % CW;
        float y0 = x0 * rs * gain[e], y1 = x1 * rs * gain[e + 1];
        if (rope) {
            const int pi = e >> 1, q = CW / 4; const int k = pi < q ? pi : pi - q; const int pos = pi < q ? (t >> 6) : (t & 63);
            typedef float f32x2t __attribute__((ext_vector_type(2)));
            const f32x2t cssn = ((const f32x2t*)rtab)[pos * q + k]; const float cs = cssn.x, sn = cssn.y;
            const float r0 = y0 * cs - y1 * sn, r1 = y0 * sn + y1 * cs; y0 = r0; y1 = r1;
        }
        if (valid) *(unsigned*)(out + 128 * i + 2 * lane) = cvt_pk_bf16(y0, y1);
    }
}
__device__ __forceinline__ void ph_prep1(const Params& p, int layer) {
    const int tid = otid(); const int lane = tid & 63, gw = obid() * 8 + (tid >> 6), NGW = gridDim.x * 8;
    bf16_t* Z = (bf16_t*)(p.ws + WS_G + G_Z); bf16_t* CQ = (bf16_t*)(p.ws + WS_G + G_CQ); bf16_t* CKV = (bf16_t*)(p.ws + WS_G + G_CKV);
    const float* daq = p.in[18] + layer * 64; const float* dak = p.in[19] + layer * 64; const float* gqq = p.in[22] + layer * 128; const float* gqk = p.in[23] + layer * 128;
    const float* r64 = (const float*)(p.ws + WS_ROPE64); const float* r128 = (const float*)(p.ws + WS_ROPE128);
    const float* cqn = p.in[24] + layer * 256; const float* ckvn = p.in[25] + layer * 128; const float* mlk = p.in[29] + layer * 192;
    for (int r = gw; r < RB; r += NGW) {
        bf16_t* z = Z + (size_t)r * ZW; const bool lat = r >= CTX; const int t = r - CTX;
        unsigned wq[4], wk[4], gq[4], gk[2], kv[1], kr[1];
        seg_load<4>(z + Z_DAQ, 512, lane, wq); seg_load<4>(z + Z_DAK, 512, lane, wk); seg_load<4>(z + Z_GQQ, 512, lane, gq); seg_load<2>(z + Z_GQK, 256, lane, gk);
        seg_load<1>(z + Z_CKV, 128, lane, kv); seg_load<1>(z + Z_KR, 64, lane, kr);
        const u32x2 wc = *(const u32x2*)(z + Z_CQ + 4 * lane);
        seg_fin<64, 4>(wq, z + Z_DAQ, 512, daq, lat, t, lane, r64);
        seg_fin<64, 4>(wk, z + Z_DAK, 512, dak, lat, t, lane, r64);
        seg_fin<128, 4>(gq, z + Z_GQQ, 512, gqq, lat, t, lane, r128);
        seg_fin<128, 2>(gk, z + Z_GQK, 256, gqk, lat, t, lane, r128);
        seg_fin<128, 1>(kv, CKV + (size_t)r * 128, 128, ckvn, false, 0, lane);
        seg_fin<64, 1>(kr, z + Z_KR, 64, mlk + 128, lat, t, lane, r64);
        {
            const float x0 = bflo(wc.x), x1 = bfhi(wc.x), x2 = bflo(wc.y), x3 = bfhi(wc.y);
            const float rs = rsqrtf(wave_sum(x0 * x0 + x1 * x1 + x2 * x2 + x3 * x3) * (1.f / 256) + EPS);
            const f32x4 g = *(const f32x4*)(cqn + 4 * lane);
            u32x2 o; o.x = cvt_pk_bf16(x0 * rs * g.x, x1 * rs * g.y); o.y = cvt_pk_bf16(x2 * rs * g.z, x3 * rs * g.w);
            *(u32x2*)(CQ + (size_t)r * 256 + 4 * lane) = o;
        }
    }
}
__device__ __forceinline__ void ph_prep2(const Params& p, int layer) {
    const int tid = otid(); const int lane = tid & 63, gw = obid() * 8 + (tid >> 6), NGW = gridDim.x * 8;
    const bf16_t* Z = (const bf16_t*)(p.ws + WS_G + G_Z); bf16_t* MLQ = (bf16_t*)(p.ws + WS_G + G_MLQ); const bf16_t* MLKV = (const bf16_t*)(p.ws + WS_G + G_MLKV); bf16_t* KF = (bf16_t*)(p.ws + WS_G + G_KF);
    const float* mlq = p.in[28] + layer * 192; const float* mlk = p.in[29] + layer * 192; const float* r64 = (const float*)(p.ws + WS_ROPE64);
    for (int r = gw; r < RB; r += NGW) {
        const bool lat = r >= CTX; const int t = r - CTX;
        bf16_t* q = MLQ + (size_t)r * 768; const bf16_t* kv = MLKV + (size_t)r * 1024; bf16_t* kf = KF + (size_t)r * 768;
        const unsigned krw = lane < 32 ? *(const unsigned*)(Z + (size_t)r * ZW + Z_KR + 2 * lane) : 0u;
        unsigned qn[4][1], qp[4][1], kn[4][1];
#pragma unroll
        for (int h = 0; h < 4; ++h) { seg_load<1>(q + h * 192, 128, lane, qn[h]); seg_load<1>(q + h * 192 + 128, 64, lane, qp[h]); seg_load<1>(kv + h * 256, 128, lane, kn[h]); }
#pragma unroll
        for (int h = 0; h < 4; ++h) {
            seg_fin<128, 1>(qn[h], q + h * 192, 128, mlq, false, 0, lane);
            seg_fin<64, 1>(qp[h], q + h * 192 + 128, 64, mlq + 128, lat, t, lane, r64);
            seg_fin<128, 1>(kn[h], kf + h * 192, 128, mlk, false, 0, lane);
            if (lane < 32) *(unsigned*)(kf + h * 192 + 128 + 2 * lane) = krw;
        }
    }
}
__device__ __forceinline__ void ph_subln(const Params& p, int layer) {
    const int tid = otid(); const int lane = tid & 63, gw = obid() * 8 + (tid >> 6), NGW = gridDim.x * 8;
    const bf16_t* A1 = (const bf16_t*)(p.ws + WS_G + G_A1); const bf16_t* A2 = (const bf16_t*)(p.ws + WS_G + G_A2); bf16_t* O = (bf16_t*)(p.ws + WS_G + G_BR);
    const float* lam = p.in[20] + layer * 256; const float* sub = p.in[21] + layer * 128;
    int lyr = layer; asm volatile("" : "+s"(lyr));
    const float lam_init = lyr == 0 ? 0.2f : 0.35550907f;
    const float l1 = wave_sum(lam[lane] * lam[64 + lane]), l2 = wave_sum(lam[128 + lane] * lam[192 + lane]);
    const float lam_full = expf(l1) - expf(l2) + lam_init;
    const float g0 = sub[2 * lane] * (1.f - lam_init), g1 = sub[2 * lane + 1] * (1.f - lam_init);
    for (int r = gw; r < RB; r += NGW) {
        unsigned w1[4], w2[4];
#pragma unroll
        for (int h = 0; h < 4; ++h) { const size_t off = (size_t)r * 512 + h * 128 + 2 * lane; w1[h] = *(const unsigned*)(A1 + off); w2[h] = *(const unsigned*)(A2 + off); }
#pragma unroll
        for (int h = 0; h < 4; ++h) {
            const size_t off = (size_t)r * 512 + h * 128 + 2 * lane;
            const float d0 = bflo(w1[h]) - lam_full * bflo(w2[h]), d1 = bfhi(w1[h]) - lam_full * bfhi(w2[h]);
            const float rs = rsqrtf(wave_sum(d0 * d0 + d1 * d1) * (1.f / 128) + EPS);
            *(unsigned*)(O + off) = cvt_pk_bf16(d0 * rs * g0, d1 * rs * g1);
        }
    }
}

__device__ __forceinline__ void attn_unit(const Params& p, int u, char* lds) {
    const bf16_t* Z = (const bf16_t*)(p.ws + WS_G + G_Z);
    int type, hd, qb;
    if (u < 128) { type = 0; hd = u >> 5; qb = 1 + (u & 31); }
    else if (u < 256) { type = 1; hd = (u - 128) >> 5; qb = 1 + (u & 31); }
    else if (u < 512) { type = 2; hd = (u - 256) >> 5; qb = 1 + (u & 31); }
    else { const int k = u - 512; qb = 0; if (k < 4) { type = 0; hd = k; } else if (k < 8) { type = 1; hd = k - 4; } else { type = 2; hd = k - 8; } }
    const int seq = qb == 0 ? CTX : RB; const size_t q0 = (size_t)qb * 256;
#ifndef ATT_TYPES
#define ATT_TYPES 7
#endif
    if (type == 0 && (ATT_TYPES & 1)) {
        const bf16_t* Q = (const bf16_t*)(p.ws + WS_G + G_MLQ) + q0 * 768 + hd * 192;
        const bf16_t* K = (const bf16_t*)(p.ws + WS_G + G_KF) + hd * 192;
        const bf16_t* V = (const bf16_t*)(p.ws + WS_G + G_MLKV) + hd * 256 + 128;
        bf16_t* O = (bf16_t*)(p.ws + WS_G + G_BR) + (size_t)2 * RB * 512 + q0 * 512 + hd * 128;
#ifndef ML_QL
#define ML_QL -1
#endif
#ifndef ATT_DMA
#define ATT_DMA 3
#endif
        if constexpr (ATT_DMA & 1) att::attn_body_dma<192, 768, 768, 1024, 512>(Q, K, V, O, seq, lds);
        else if constexpr (ML_QL < 0) att::attn_body_simple<192, 768, 768, 1024, 512>(Q, K, V, O, seq, lds);
        else att::attn_body<192, 768, 768, 1024, 512, (ML_QL < 0 ? 0 : ML_QL)>(Q, K, V, O, seq, lds);
    } else if (type == 1 && (ATT_TYPES & 2)) {
        const int kvh = hd >> 1;
        const bf16_t* Q = Z + q0 * ZW + Z_GQQ + hd * 128;
        const bf16_t* K = Z + Z_GQK + kvh * 128;
        const bf16_t* V = Z + Z_GQV + kvh * 128;
        bf16_t* O = (bf16_t*)(p.ws + WS_G + G_BR) + (size_t)1 * RB * 512 + q0 * 512 + hd * 128;
#ifndef GQ_SIMPLE
#define GQ_SIMPLE 1
#endif
        if constexpr (ATT_DMA & 2) att::attn_body_dma<128, ZW, ZW, ZW, 512>(Q, K, V, O, seq, lds);
        else if constexpr (GQ_SIMPLE) att::attn_body_simple<128, ZW, ZW, ZW, 512>(Q, K, V, O, seq, lds); else att::attn_body<128, ZW, ZW, ZW, 512>(Q, K, V, O, seq, lds);
    } else if (type == 2 && (ATT_TYPES & 4)) {
        const int h = hd >> 1, m = hd & 1;
        const bf16_t* Q = Z + q0 * ZW + Z_DAQ + h * 128 + m * 64;
        const bf16_t* K = Z + Z_DAK + h * 128 + m * 64;
        const bf16_t* V = Z + Z_DAV + h * 128;
        bf16_t* O = (bf16_t*)(p.ws + WS_G + (m == 0 ? G_A1 : G_A2)) + q0 * 512 + h * 128;
#ifndef DA_SIMPLE
#define DA_SIMPLE 0
#endif
        if constexpr (DA_SIMPLE) att::attn_body_simple<64, ZW, ZW, ZW, 512>(Q, K, V, O, seq, lds); else att::attn_body<64, ZW, ZW, ZW, 512>(Q, K, V, O, seq, lds);
    }
}
#ifndef ATT_REP_TYPES
#define ATT_REP_TYPES 7
#endif
__device__ __forceinline__ void ph_attn(const Params& p, char* lds, int last, int tmask = 7) {
    const int G = gridDim.x, c = obid();
    for (int i = 0; i < 3; ++i) {
        int u;
        const int xcd = c & 7, jq = c >> 3;
        if (G == 256) u = i == 0 ? (xcd < 4 ? xcd * 32 + jq : 128 + (xcd - 4) * 32 + jq) : (i == 1 ? 256 + xcd * 32 + jq : ((c >= 128 && c < 144 && !last) ? 512 + (c - 128) : -1));
        else u = -1;
        if (u >= 0) { const int ty = u < 128 ? 1 : (u < 256 ? 2 : (u < 512 ? 4 : 7)); if (ty & tmask) attn_unit(p, u, lds); }
    }
    if (G != 256) for (int u = c; u < (last ? 512 : 528); u += G) attn_unit(p, u, lds);
}


#define XB_TMO      128
#define XB_XCNT(j)  (256  + 64 * (j))
#define XB_XSUB(j)  (1280 + 64 * (j))
#define XB_XGEN(j)  (2304 + 64 * (j))
#define XB_TOP      3328
#define XB_TOPGEN   3392
#define XCD_BAR_WORDS 3456
#define XB_SPIN_CAP (1u << 23)
__device__ __forceinline__ unsigned xb_ld(unsigned* p)              { return __hip_atomic_load(p, __ATOMIC_RELAXED, __HIP_MEMORY_SCOPE_AGENT); }
__device__ __forceinline__ unsigned xb_add(unsigned* p, unsigned v) { return __hip_atomic_fetch_add(p, v, __ATOMIC_RELAXED, __HIP_MEMORY_SCOPE_AGENT); }
__device__ __forceinline__ unsigned xb_xcc_id() { return (unsigned)__builtin_amdgcn_s_getreg((3 << 11) | 20) & 0xFu; }
#define XB_SPIN(cond, bar) do { unsigned _sp = 0; while (cond) { __builtin_amdgcn_s_sleep(1); \
    if ((++_sp & 255u) == 0u) { if (xb_ld(&(bar)[XB_TMO])) break; if (_sp > XB_SPIN_CAP) { atomicAdd(&(bar)[XB_TMO], 1u); break; } } } } while (0)
struct XcdBarrier { unsigned* bar; unsigned x; volatile LAS unsigned* st; };
__device__ __forceinline__ void xcd_barrier_complete(unsigned* bar, unsigned x, unsigned& nloc, unsigned& nx) {
    const unsigned G = gridDim.x * gridDim.y * gridDim.z;
    unsigned sum, cnt, mine, sp = 0u;
    for (;;) {
        sum = 0u; cnt = 0u; mine = 0u;
#pragma unroll
        for (unsigned j = 0; j < 16; ++j) { const unsigned c = xb_ld(&bar[XB_XCNT(j)]); sum += c; cnt += (c > 0u) ? 1u : 0u; mine = (j == x) ? c : mine; }
        if (sum == G) break;
        __builtin_amdgcn_s_sleep(1);
        if ((++sp & 255u) == 0u) { if (xb_ld(&bar[XB_TMO])) break; if (sp > XB_SPIN_CAP) { atomicAdd(&bar[XB_TMO], 1u); break; } }
    }
    nloc = mine > 0u ? mine : 1u; nx = cnt > 0u ? cnt : 1u;
}
__device__ __forceinline__ void xcd_barrier(const XcdBarrier& b) {
    asm volatile("s_waitcnt vmcnt(0)" ::: "memory");
    __syncthreads();
    if (otid() == 0) {
        unsigned* bar = b.bar;
        __builtin_amdgcn_s_waitcnt(0);
        unsigned nloc = b.st[0], nx = b.st[1];
        if (nloc == 0u) { xcd_barrier_complete(bar, b.x, nloc, nx); b.st[0] = nloc; b.st[1] = nx; }
        const unsigned old = xb_add(&bar[XB_XSUB(b.x)], 1u);
        const unsigned gen = old / nloc;
        if (old + 1u == (gen + 1u) * nloc) {
            __builtin_amdgcn_fence(__ATOMIC_RELEASE, "agent");
            asm volatile("s_waitcnt vmcnt(0)" ::: "memory");
            const unsigned og = xb_add(&bar[XB_TOP], 1u);
            const unsigned tg = og / nx;
            if (og + 1u == (tg + 1u) * nx) xb_add(&bar[XB_TOPGEN], 1u);
            else XB_SPIN(xb_ld(&bar[XB_TOPGEN]) == tg, bar);
            __builtin_amdgcn_fence(__ATOMIC_ACQUIRE, "agent");
            xb_add(&bar[XB_XGEN(b.x)], 1u);
            asm volatile("s_waitcnt vmcnt(0)" ::: "memory");
        } else {
            XB_SPIN(xb_ld(&bar[XB_XGEN(b.x)]) == gen, bar);
            __builtin_amdgcn_fence(__ATOMIC_ACQUIRE, "agent");
            asm volatile("s_waitcnt vmcnt(0)" ::: "memory");
        }
    }
    __syncthreads();
}

__global__ void __launch_bounds__(512, 2) mk_fwd(Params p0) {
    extern __shared__ __attribute__((aligned(16))) unsigned char lds_raw[];
    LAS unsigned char* lds = (LAS unsigned char*)lds_raw;
    cg::grid_group grid = cg::this_grid();
#define GSYNC() do { if (hi < 0) { asm volatile("s_waitcnt vmcnt(0) lgkmcnt(0)" ::: "memory"); grid.sync(); }     \
    else { XcdBarrier xb_; xb_.bar = (unsigned*)(load_params().ws + WS_BAR); xb_.x = xb_xcc_id(); xb_.st = (volatile LAS unsigned*)(lds + 131072 + 64); xcd_barrier(xb_); } } while (0)
    if (threadIdx.x == 0) { volatile LAS unsigned* st_ = (volatile LAS unsigned*)(lds + 131072 + 64); st_[0] = 0u; st_[1] = 0u;
        (void)xb_add(&((unsigned*)(p0.ws + WS_BAR))[XB_XCNT(xb_xcc_id())], 1u); }
    __syncthreads();
    const int lo = p0.lo, hi = p0.hi; int ph = 0; int layer = 0;
#ifndef PHASE_MASK
#define PHASE_MASK 0xFFFF
#endif
#ifndef REPEAT_MASK
#define REPEAT_MASK 0
#endif
#define PH_BEGIN(cat) if (ph >= lo && ph < hi) { constexpr int cat_ = (cat); (void)cat_; DIAG_T0(cat) if constexpr ((PHASE_MASK >> (cat)) & 1) for (int rep_ = 0; rep_ < (((REPEAT_MASK >> (cat)) & 1) ? 2 : 1); ++rep_) { if (rep_) GSYNC(); const Params p = load_params(); \
    unsigned char* ws = p.ws; float* MOD = (float*)(ws + WS_MOD); float* ctxb = (float*)(ws + WS_CTXB); bf16_t* H = (bf16_t*)(ws + WS_H); bf16_t* ABR = (bf16_t*)(ws + WS_ABR); \
    const bf16_t* Wl = (const bf16_t*)(ws + WS_W + layer * W_LAYER_B); const float* modl = MOD + (size_t)layer * 5 * MODW; \
    const float* xl_in = layer == 0 ? p.in[0] : p.out; const float* xc_in = layer == 0 ? p.in[2] : ctxb; \
    int lastl = layer; asm volatile("" : "+s"(lastl)); lastl = (lastl == 1) ? 1 : 0; \
    (void)MOD; (void)ctxb; (void)H; (void)ABR; (void)Wl; (void)modl; (void)xl_in; (void)xc_in; (void)lastl;
#if defined(DIAG_A_MASK)
#define DIAG_T0(cat) if (blockIdx.x == 0 && threadIdx.x == 0) { ((LAS unsigned long long*)(lds + LDS_BYTES - 64))[2] = __builtin_amdgcn_s_memrealtime(); }
#define DIAG_T1(cat) if (blockIdx.x == 0 && threadIdx.x == 0) { LAS unsigned long long* ta_ = (LAS unsigned long long*)(lds + LDS_BYTES - 64); const unsigned long long dt_ = __builtin_amdgcn_s_memrealtime() - ta_[2]; \
    if ((DIAG_A_MASK >> (cat)) & 1) ta_[0] += dt_; if ((DIAG_B_MASK >> (cat)) & 1) ta_[1] += dt_; }
#else
#define DIAG_T0(cat)
#define DIAG_T1(cat)
#endif
#define PH_END   } if (ph + 1 < hi) GSYNC(); DIAG_T1(cat_) } ++ph;
    const int G = gridDim.x, c = blockIdx.x;
#if defined(DIAG_A_MASK)
    if (threadIdx.x == 0) { LAS unsigned long long* ta_ = (LAS unsigned long long*)(lds + LDS_BYTES - 64); ta_[0] = 0; ta_[1] = 0; }
#endif

#if defined(EXTRA_SYNCS)
    for (int es = 0; es < EXTRA_SYNCS; ++es) GSYNC();
#endif
    PH_BEGIN(0) ph_prologue(p, lds); PH_END

    for (layer = 0; layer < 2; ++layer) {

        PH_BEGIN(1) ph_norm_mod(xl_in, xc_in, p.in[6] + layer * DM, modl, 0, H); PH_END

        PH_BEGIN(2) {
            pg8::Gemm g{H, Wl + W_IN, MTOT, 512, 1024}; pg8::StaticOrder S; S.init(MTOT, 512, G, c);
            pg8::Epi<pg8::E_STORE> E{}; E.a.O = (bf16_t*)(ws + WS_G + S_U); E.a.ldc = 512;
            pg8::gemm_phase(lds, g, S, E);
            { pg8::Gemm g2{H, Wl + W_IN + (size_t)512 * 1024, RB, ZW, 1024}; pg8::StaticOrder S2; S2.init(RB, ZW, G, (c + 160) % G);
              pg8::Epi<pg8::E_INPROJ> E2{}; E2.a.O = (bf16_t*)(ws + WS_G + G_Z); E2.a.ldc = ZW;
              pg8::gemm_phase(lds, g2, S2, E2); }
        } PH_END

        PH_BEGIN(3) { for (int u = c; u < 256; u += G) s5_chain(p, layer, u, lds); } PH_END

        PH_BEGIN(4) ph_s5_gelu(p, layer); PH_END

        PH_BEGIN(9) {
            pg8::Gemm g{(const bf16_t*)(ws + WS_G + S_U), Wl + W_GLU, MTOT, 512, 512}; pg8::StaticOrder S; S.init(MTOT, 512, G, c);
            pg8::Epi<pg8::E_GLU> E{}; E.a.O = ABR; E.a.ldc = 512; E.a.G = (const bf16_t*)(ws + WS_G + S_U); E.a.ldg = 512; E.a.bias = p.in[17] + layer * 512;
            pg8::gemm_phase(lds, g, S, E);
            ph_prep1(p, layer);
        } PH_END

        for (int gb = 0; gb < NB; ++gb) {
            const size_t grow0 = (size_t)gb * RB;
            if (gb > 0) {
            PH_BEGIN(10) {
                pg8::Gemm g{H + grow0 * DM, Wl + W_IN + (size_t)512 * 1024, RB, ZW, 1024}; pg8::StaticOrder S; S.init(RB, ZW, G, c);
                pg8::Epi<pg8::E_INPROJ> E{}; E.a.O = (bf16_t*)(ws + WS_G + G_Z); E.a.ldc = ZW;
                pg8::gemm_phase(lds, g, S, E);
            } PH_END

            PH_BEGIN(5) ph_prep1(p, layer); PH_END
            }

            PH_BEGIN(11) {
                { pg8::Gemm g{(const bf16_t*)(ws + WS_G + G_CQ), Wl + W_UQ, RB, 768, 256}; pg8::StaticOrder S; S.init(RB, 768, G, c);
                  pg8::Epi<pg8::E_STORE> E{}; E.a.O = (bf16_t*)(ws + WS_G + G_MLQ); E.a.ldc = 768;
                  pg8::gemm_phase(lds, g, S, E); }
                { pg8::Gemm g{(const bf16_t*)(ws + WS_G + G_CKV), Wl + W_UKV, RB, 1024, 128}; pg8::StaticOrder S; S.init(RB, 1024, G, (c + 128) % G);
                  pg8::Epi<pg8::E_STORE> E{}; E.a.O = (bf16_t*)(ws + WS_G + G_MLKV); E.a.ldc = 1024;
                  pg8::gemm_phase(lds, g, S, E); }
            } PH_END

            PH_BEGIN(6) ph_prep2(p, layer); PH_END

            PH_BEGIN(7) ph_attn(p, (char*)lds_raw, lastl, rep_ ? ATT_REP_TYPES : 7); PH_END

            PH_BEGIN(8) ph_subln(p, layer); PH_END

            PH_BEGIN(12) {
                const int vpm0 = gb * TPB, vpm1 = (int)((WS_G + G_BR - WS_ABR) / 262144);
                pg8::Gemm g{ABR, Wl + W_BR, RB, 1024, 512}; pg8::MergeOrder S{G, c, vpm0, vpm1, lastl};
                pg8::Epi<pg8::E_MERGE> E{}; E.a.O = H + grow0 * DM; E.a.ldc = DM; E.a.G = (const bf16_t*)(ws + WS_G + G_Z) + Z_GATE; E.a.ldg = ZW;
                E.a.MF = (float*)(ws + WS_G + G_MF); E.a.vpm0 = vpm0; E.a.vpm1 = vpm1;
                pg8::gemm_phase(lds, g, S, E);
            } PH_END
        }

        PH_BEGIN(13) {
            pg8::Gemm g{H, Wl + W_OUT, MTOT, 1024, 1024}; pg8::StaticOrder S; S.init(MTOT, 1024, G, c, lastl);
            pg8::Epi<pg8::E_RESID> E{}; E.a.xin_l = xl_in; E.a.xin_c = xc_in; E.a.xout_l = p.out; E.a.xout_c = ctxb; E.a.gate = modl + 2 * 1024;
            pg8::gemm_phase(lds, g, S, E);
        } PH_END

        PH_BEGIN(1) ph_norm_mod(p.out, ctxb, p.in[32] + layer * DM, modl, 3, H); PH_END

        PH_BEGIN(14) {
            pg8::Gemm g{H, Wl + W_FI, MTOT, 2 * DFF, 1024}; pg8::StaticOrder S; S.init(MTOT, 2 * DFF, G, c, lastl);
            pg8::Epi<pg8::E_SWIGLU> E{}; E.a.O = (bf16_t*)(ws + WS_G); E.a.ldc = DFF;
            pg8::gemm_phase(lds, g, S, E);
        } PH_END

        PH_BEGIN(15) {
            pg8::Gemm g{(const bf16_t*)(ws + WS_G), Wl + W_FO, MTOT, 1024, DFF}; pg8::StaticOrder S; S.init(MTOT, 1024, G, c, lastl);
            pg8::Epi<pg8::E_RESID> E{}; E.a.xin_l = p.out; E.a.xin_c = ctxb; E.a.xout_l = p.out; E.a.xout_c = ctxb; E.a.gate = modl + 5 * 1024;
            pg8::gemm_phase(lds, g, S, E);
        } PH_END
    }
#if defined(DIAG_A_MASK)
    GSYNC();
    if (blockIdx.x == 0) { LAS unsigned long long* ta_ = (LAS unsigned long long*)(lds + LDS_BYTES - 64);
        const float A = (float)ta_[0] * 0.01f, B = (float)ta_[1] * 0.01f;
        if (threadIdx.x == 0) p0.out[0] = A; else p0.out[threadIdx.x] = B; if (threadIdx.x > 0) p0.out[threadIdx.x + 511] = B; }
#endif
#undef PH_BEGIN
#undef PH_END
}
constexpr int N_PHASES = 1 + 2 * (5 + 4 * 7 + 4 - 2);

extern "C" void kernel_launch(void* const* d_in, const int* in_sizes, int n_in, void* d_out, int out_size, void* d_ws, size_t ws_size, hipStream_t stream) {
    static int grid = 0;
    if (grid == 0) {
        if (n_in != 35 || out_size != NB * SEQ * DM || ws_size < WS_END) { fprintf(stderr, "kernel_launch: bad shapes: n_in %d out %d ws %zu (need %zu)\n", n_in, out_size, ws_size, (size_t)WS_END); grid = -1; return; }
        int dev = 0, cus = 0, per_cu = 0;
        (void)hipGetDevice(&dev); (void)hipDeviceGetAttribute(&cus, hipDeviceAttributeMultiprocessorCount, dev);
        if (hipFuncSetAttribute((const void*)mk_fwd, hipFuncAttributeMaxDynamicSharedMemorySize, LDS_BYTES) != hipSuccess) { fprintf(stderr, "kernel_launch: hipFuncSetAttribute failed\n"); grid = -1; return; }
        (void)hipOccupancyMaxActiveBlocksPerMultiprocessor(&per_cu, (const void*)mk_fwd, 512, LDS_BYTES);
        (void)hipGetLastError();
        if (per_cu < 1) per_cu = 1;
        grid = cus;
    }
    if (grid < 0) return;
    if (hipMemsetAsync((char*)d_ws + WS_BAR, 0, 16384, stream) != hipSuccess) { fprintf(stderr, "kernel_launch: memset failed\n"); return; }
    Params p{};
    for (int i = 0; i < 35; ++i) p.in[i] = (const float*)d_in[i];
    p.out = (float*)d_out; p.ws = (unsigned char*)d_ws;
#if MK_MODE == 0
    p.lo = 0; p.hi = N_PHASES;
    void* args[] = {&p};
    hipError_t e = hipLaunchCooperativeKernel((const void*)mk_fwd, dim3(grid), dim3(512), args, LDS_BYTES, stream);
    if (e != hipSuccess) fprintf(stderr, "cooperative launch failed: %s (grid %d)\n", hipGetErrorString(e), grid);
#else
    for (int ph = 0; ph < N_PHASES; ++ph) {
        p.lo = ph; p.hi = ph + 1;
        hipLaunchKernelGGL(mk_fwd, dim3(grid), dim3(512), LDS_BYTES, stream, p);
    }
#endif
}
```

```cpp
#include <hip/hip_runtime.h>
#include <hip/hip_cooperative_groups.h>
#include <cstdio>
#include <cstdint>
namespace cg = cooperative_groups;

#ifndef MK_MODE
#define MK_MODE 0
#endif

#define LAS __attribute__((address_space(3)))
typedef unsigned short bf16_t;
typedef short bf16x8 __attribute__((ext_vector_type(8)));
typedef short s16x4 __attribute__((ext_vector_type(4)));
typedef float f32x4 __attribute__((ext_vector_type(4)));
typedef float f32x16 __attribute__((ext_vector_type(16)));
typedef unsigned u32x4 __attribute__((ext_vector_type(4)));
typedef unsigned u32x2 __attribute__((ext_vector_type(2)));

constexpr int DM = 1024, NB = 4, SEQ = 8192, CTX = 256, RB = SEQ + CTX  , MTOT = NB * RB  ;
constexpr int TPB = RB / 256;
constexpr int ZW = 7168;
constexpr int Z_DAQ = 0, Z_DAK = 512, Z_DAV = 1024, Z_GQQ = 1536, Z_GQK = 2048, Z_GQV = 2304, Z_CQ = 2560, Z_CKV = 2816, Z_KR = 2944, Z_GATE = 3072;
constexpr int DFF = 2816, MODW = 6144;
constexpr float EPS = 1e-6f;

constexpr size_t MiB = 1u << 20;
constexpr size_t al(size_t x) { return (x + MiB - 1) / MiB * MiB; }
constexpr size_t WS_MOD = 0;
constexpr size_t WS_ROPE64 = 256 * 1024, WS_ROPE128 = WS_ROPE64 + 128 * 16 * 8;
constexpr size_t WS_BAR = 512 * 1024;
constexpr size_t WS_CTXB = al(WS_MOD + 2 * 5 * MODW * 4);
constexpr size_t WS_W = WS_CTXB + 4 * MiB;
constexpr size_t W_IN = 0, W_UQ = W_IN + (size_t)7680 * 1024, W_UKV = W_UQ + 768 * 256, W_GLU = W_UKV + 1024 * 128, W_BR = W_GLU + 512 * 512,
                 W_OUT = W_BR + (size_t)4 * 1024 * 512, W_FI = W_OUT + (size_t)1024 * 1024, W_FO = W_FI + (size_t)5632 * 1024, W_LAYER = W_FO + (size_t)1024 * 2816;
constexpr size_t W_LAYER_B = al(W_LAYER * 2);
constexpr size_t WS_H = WS_W + 2 * W_LAYER_B;
constexpr size_t WS_ABR = WS_H + al((size_t)MTOT * 1024 * 2);
constexpr size_t WS_G = WS_ABR + al((size_t)MTOT * 512 * 2);
constexpr size_t G_Z = 0;
constexpr size_t G_CQ = al(G_Z + (size_t)RB * ZW * 2);
constexpr size_t G_CKV = al(G_CQ + (size_t)RB * 256 * 2);
constexpr size_t G_MLQ = al(G_CKV + (size_t)RB * 128 * 2);
constexpr size_t G_MLKV = al(G_MLQ + (size_t)RB * 768 * 2);
constexpr size_t G_KF = al(G_MLKV + (size_t)RB * 1024 * 2);
constexpr size_t G_A1 = al(G_KF + (size_t)RB * 768 * 2);
constexpr size_t G_A2 = al(G_A1 + (size_t)RB * 512 * 2);
constexpr size_t G_BR = al(G_A2 + (size_t)RB * 512 * 2);
constexpr size_t G_MF = al(G_BR + (size_t)3 * RB * 512 * 2);
constexpr size_t G_END = al(G_MF + (size_t)RB * 1024 * 4);
constexpr size_t S_SZ = al((size_t)MTOT * 512 * 2), S_U = G_MLQ  , S_YF = S_U + S_SZ, S_YR = S_YF + S_SZ, S_END = S_YR + S_SZ;
constexpr size_t HID_B = (size_t)MTOT * DFF * 2;
static_assert(S_END <= G_END && HID_B <= G_END, "aliases fit");
constexpr size_t WS_END = WS_G + G_END;
static_assert(WS_END <= (size_t)512 * MiB, "workspace budget");
static_assert((WS_G + G_BR - WS_ABR) % 262144 == 0, "merge virtual tiles");

constexpr int LDS_BYTES = 147456;

typedef __bf16 bf16x2n __attribute__((ext_vector_type(2)));
typedef float f32x2n __attribute__((ext_vector_type(2)));
__device__ __forceinline__ unsigned cvt_pk_bf16(float lo, float hi) { f32x2n v = {lo, hi}; bf16x2n b = __builtin_convertvector(v, bf16x2n); return __builtin_bit_cast(unsigned, b); }
__device__ __forceinline__ float bf2f(unsigned v) { return __uint_as_float(v << 16); }
__device__ __forceinline__ float bflo(unsigned w) { return __uint_as_float(w << 16); }
__device__ __forceinline__ float bfhi(unsigned w) { return __uint_as_float(w & 0xffff0000u); }
__device__ __forceinline__ bf16_t f2bf(float f) { return (bf16_t)(cvt_pk_bf16(f, 0.f) & 0xffffu); }
template <int O> __device__ __forceinline__ float swz_xor(float v) { return __int_as_float(__builtin_amdgcn_ds_swizzle(__float_as_int(v), 0x1f | (O << 10))); }
__device__ __forceinline__ float half_sum(float v) {
    v += swz_xor<1>(v); v += swz_xor<2>(v); v += swz_xor<4>(v); v += swz_xor<8>(v); v += swz_xor<16>(v); return v;
}
__device__ __forceinline__ float wave_sum(float v) {
    v = half_sum(v);
    auto rr = __builtin_amdgcn_permlane32_swap(__float_as_uint(v), __float_as_uint(v), false, false);
    return __uint_as_float(rr[0]) + __uint_as_float(rr[1]);
}
__device__ __forceinline__ int otid() { int t = threadIdx.x; asm volatile("" : "+v"(t)); return t; }
__device__ __forceinline__ float sigmoidf_(float x) { return __builtin_amdgcn_rcpf(1.f + __expf(-x)); }

__device__ __forceinline__ int obid() { int b = blockIdx.x; asm volatile("" : "+s"(b)); return b; }
struct Params { const float* in[35]; float* out; unsigned char* ws; int lo, hi; };
__device__ __forceinline__ Params load_params() {
#if defined(__HIP_DEVICE_COMPILE__)
    typedef const __attribute__((address_space(4))) Params* CP;
    CP q = (CP)__builtin_amdgcn_kernarg_segment_ptr(); asm volatile("" : "+s"(q));
    Params r;
#pragma unroll
    for (int i = 0; i < 35; ++i) r.in[i] = q->in[i];
    r.out = q->out; r.ws = q->ws; r.lo = q->lo; r.hi = q->hi; return r;
#else
    return Params{};
#endif
}

namespace pg8 {
constexpr int BM = 256, BK = 64, HALF = 128, HTB = HALF * BK * 2, STAGE_BYTES = 8 * HTB, NXCD = 8, WGM = 8;
__host__ __device__ __forceinline__ int lds_byte(int r, int c) { const int st = (r >> 4) * 2 + (c >> 5), rr = r & 15, cc = c & 31, ob = rr * 64 + cc * 2; return st * 1024 + (ob ^ (((ob >> 9) & 1) << 5)); }
__host__ __device__ __forceinline__ void stage_rc(int b, int& R, int& C) { const int st = b / 1024, sb = b % 1024, swz = sb ^ (((sb >> 9) & 1) << 5); R = (st >> 1) * 16 + swz / 64; C = (st & 1) * 32 + (swz % 64) / 2; }
__host__ __device__ __forceinline__ int perm32(int rho) { const int n = rho >> 4, i = rho & 15; return 8 * (i >> 2) + 4 * n + (i & 3); }
struct Unit { int pm, pn; };
struct Gemm { const bf16_t* A; const bf16_t* Bt; int M, N, K; };
struct StaticOrder {
    int nM, nN, nwg, G, c;
    int skip;
    __device__ void init(int M, int N, int G_, int c_, int skip_ = 0) { skip = skip_; nM = skip_ ? NB * (TPB - 1) : M / BM; nN = N / BM; nwg = nM * nN; G = G_; c = c_; }
    __device__ bool next(int i, Unit& u) const {
        const long L = (long)i * G + c; if (L >= nwg) return false;
        int wgid = (int)L; { const int q = nwg / NXCD, r = nwg % NXCD, xcd = wgid % NXCD, off = wgid / NXCD; wgid = (xcd < r ? xcd * (q + 1) : r * (q + 1) + (xcd - r) * q) + off; }
        const int nig = WGM * nN, gid = wgid / nig, fm = gid * WGM, gsz = (nM - fm) < WGM ? (nM - fm) : WGM;
        u.pm = fm + ((wgid % nig) % gsz); u.pn = (wgid % nig) / gsz; if (skip) u.pm += u.pm / (TPB - 1) + 1; return true;
    }
};
struct MergeOrder {
    int G, c, vpm0, vpm1, skip;
    __device__ bool next(int i, Unit& u) const {
        const int j = i >> 2, n = i & 3; const int L = j * G + c; if (L >= (TPB - skip) * 4) return false;
        const int pm = (L >> 2) + skip, pn = L & 3; u.pm = (n == 0 ? vpm0 : vpm1 + (n - 1) * TPB) + pm; u.pn = n * 4 + pn; return true;
    }
};

enum { E_STORE = 0, E_INPROJ = 1, E_GLU = 2, E_MERGE = 3, E_RESID = 4, E_SWIGLU = 5 };
struct EpiArgs {
    bf16_t* O; int ldc;
    const bf16_t* G; int ldg;
    const float* bias;
    float* MF;
    int vpm0, vpm1;
    const float* xin_l; const float* xin_c; float* xout_l; float* xout_c; const float* gate;
};
template <int MODE> struct Epi {
    EpiArgs a;
    __device__ __forceinline__ void operator()(const f32x4 (&acc)[2][2][4][2], const Unit& u, int, int, int, int) const {
        const int t_ = otid(), wid_ = __builtin_amdgcn_readfirstlane(t_ >> 6), wr = wid_ >> 2, wc = wid_ & 3, fr = t_ & 15, fq = (t_ & 63) >> 4;
        int pm = u.pm, pn = u.pn, nbr = 0;
        if (MODE == E_MERGE) { nbr = u.pn >> 2; pn = u.pn & 3; pm = u.pm - (nbr == 0 ? a.vpm0 : a.vpm1 + (nbr - 1) * TPB); }
        const int row0 = pm * BM + wr * 64 + fr;
        const int col0 = (MODE == E_SWIGLU ? pn * 128 : pn * BM) + wc * 32 + 8 * fq;
        const float* xin = nullptr; float* xout = nullptr; const float* gv = nullptr;
        if (MODE == E_RESID) {
            const int b = pm / TPB, t = pm - b * TPB;
            if (t == 0) { xin = a.xin_c + (size_t)b * CTX * DM; xout = a.xout_c + (size_t)b * CTX * DM; gv = a.gate + 4 * MODW; }
            else { xin = a.xin_l + ((size_t)b * SEQ + (size_t)(t - 1) * 256) * DM; xout = a.xout_l + ((size_t)b * SEQ + (size_t)(t - 1) * 256) * DM; gv = a.gate + b * MODW; }
        }
        if (MODE == E_SWIGLU || MODE == E_STORE || MODE == E_INPROJ) {
#pragma unroll
            for (int ai = 0; ai < 2; ++ai)
#pragma unroll
                for (int m = 0; m < 4; ++m) {
                    const int row = row0 + ai * HALF + m * 16;
                    if (MODE == E_SWIGLU) {
                        const f32x4 g0 = acc[ai][0][m][0], g1 = acc[ai][0][m][1], u0 = acc[ai][1][m][0], u1 = acc[ai][1][m][1];
                        float h[8];
#pragma unroll
                        for (int e = 0; e < 4; ++e) { h[e] = g0[e] * sigmoidf_(g0[e]) * u0[e]; h[4 + e] = g1[e] * sigmoidf_(g1[e]) * u1[e]; }
                        u32x4 w; w.x = cvt_pk_bf16(h[0], h[1]); w.y = cvt_pk_bf16(h[2], h[3]); w.z = cvt_pk_bf16(h[4], h[5]); w.w = cvt_pk_bf16(h[6], h[7]);
                        *(u32x4*)(a.O + (size_t)row * a.ldc + col0) = w;
                        continue;
                    }
#pragma unroll
                    for (int bj = 0; bj < 2; ++bj) {
                        const int col = col0 + bj * HALF;
                        f32x4 v0 = acc[ai][bj][m][0], v1 = acc[ai][bj][m][1];
                        if (MODE == E_INPROJ && pn >= 12) {
#pragma unroll
                            for (int e = 0; e < 4; ++e) { v0[e] = sigmoidf_(v0[e]); v1[e] = sigmoidf_(v1[e]); }
                        }
                        u32x4 w; w.x = cvt_pk_bf16(v0[0], v0[1]); w.y = cvt_pk_bf16(v0[2], v0[3]); w.z = cvt_pk_bf16(v1[0], v1[1]); w.w = cvt_pk_bf16(v1[2], v1[3]);
                        *(u32x4*)(a.O + (size_t)row * a.ldc + col) = w;
                    }
                }
            return;
        }
        f32x4 gb0[2], gb1[2];
#pragma unroll
        for (int bj = 0; bj < 2; ++bj) {
            const int col = col0 + bj * HALF;
            if (MODE == E_GLU) { gb0[bj] = *(const f32x4*)(a.bias + col); gb1[bj] = *(const f32x4*)(a.bias + col + 4); }
            else if (MODE == E_RESID) { gb0[bj] = *(const f32x4*)(gv + col); gb1[bj] = *(const f32x4*)(gv + col + 4); }
            else { gb0[bj] = (f32x4){0.f, 0.f, 0.f, 0.f}; gb1[bj] = gb0[bj]; }
        }
#pragma unroll
        for (int ai = 0; ai < 2; ++ai)
#pragma unroll
            for (int mp = 0; mp < 2; ++mp) {
                u32x4 gw[2][2]; f32x4 xa[2][2], xb[2][2];
#pragma unroll
                for (int mm = 0; mm < 2; ++mm)
#pragma unroll
                    for (int bj = 0; bj < 2; ++bj) {
                        const int row = row0 + ai * HALF + (mp * 2 + mm) * 16, col = col0 + bj * HALF;
                        if (MODE == E_GLU) gw[mm][bj] = *(const u32x4*)(a.G + (size_t)row * a.ldg + col);
                        if (MODE == E_MERGE) { gw[mm][bj] = *(const u32x4*)(a.G + (size_t)row * a.ldg + nbr * 1024 + col);
                            if (nbr != 0) { const u32x4 mw = *(const u32x4*)((const bf16_t*)a.MF + (size_t)row * 1024 + col);
                                xa[mm][bj] = (f32x4){bflo(mw.x), bfhi(mw.x), bflo(mw.y), bfhi(mw.y)}; xb[mm][bj] = (f32x4){bflo(mw.z), bfhi(mw.z), bflo(mw.w), bfhi(mw.w)}; } }
                        if (MODE == E_RESID) { const int lr = row - pm * BM; xa[mm][bj] = *(const f32x4*)(xin + (size_t)lr * DM + col); xb[mm][bj] = *(const f32x4*)(xin + (size_t)lr * DM + col + 4); }
                    }
#pragma unroll
                for (int mm = 0; mm < 2; ++mm)
#pragma unroll
                    for (int bj = 0; bj < 2; ++bj) {
                        const int m = mp * 2 + mm; const int row = row0 + ai * HALF + m * 16, col = col0 + bj * HALF;
                        const f32x4 v0 = acc[ai][bj][m][0], v1 = acc[ai][bj][m][1];
                        if (MODE == E_GLU) {
                            const u32x4 g = gw[mm][bj]; const f32x4 b0 = gb0[bj], b1 = gb1[bj];
                            float o[8];
                            o[0] = bflo(g.x) * sigmoidf_(v0[0] + b0[0]); o[1] = bfhi(g.x) * sigmoidf_(v0[1] + b0[1]);
                            o[2] = bflo(g.y) * sigmoidf_(v0[2] + b0[2]); o[3] = bfhi(g.y) * sigmoidf_(v0[3] + b0[3]);
                            o[4] = bflo(g.z) * sigmoidf_(v1[0] + b1[0]); o[5] = bfhi(g.z) * sigmoidf_(v1[1] + b1[1]);
                            o[6] = bflo(g.w) * sigmoidf_(v1[2] + b1[2]); o[7] = bfhi(g.w) * sigmoidf_(v1[3] + b1[3]);
                            u32x4 w; w.x = cvt_pk_bf16(o[0], o[1]); w.y = cvt_pk_bf16(o[2], o[3]); w.z = cvt_pk_bf16(o[4], o[5]); w.w = cvt_pk_bf16(o[6], o[7]);
                            *(u32x4*)(a.O + (size_t)row * a.ldc + col) = w;
                        } else if (MODE == E_MERGE) {
                            const u32x4 g = gw[mm][bj];
                            f32x4 p0, p1;
                            p0[0] = bflo(g.x) * v0[0]; p0[1] = bfhi(g.x) * v0[1]; p0[2] = bflo(g.y) * v0[2]; p0[3] = bfhi(g.y) * v0[3];
                            p1[0] = bflo(g.z) * v1[0]; p1[1] = bfhi(g.z) * v1[1]; p1[2] = bflo(g.w) * v1[2]; p1[3] = bfhi(g.w) * v1[3];
                            if (nbr != 0) { p0 = p0 + xa[mm][bj]; p1 = p1 + xb[mm][bj]; }
                            u32x4 w; w.x = cvt_pk_bf16(p0[0], p0[1]); w.y = cvt_pk_bf16(p0[2], p0[3]); w.z = cvt_pk_bf16(p1[0], p1[1]); w.w = cvt_pk_bf16(p1[2], p1[3]);
                            if (nbr != 3) *(u32x4*)((bf16_t*)a.MF + (size_t)row * 1024 + col) = w;
                            else *(u32x4*)(a.O + (size_t)row * a.ldc + col) = w;
                        } else if (MODE == E_RESID) {
                            const int lr = row - pm * BM;
                            *(f32x4*)(xout + (size_t)lr * DM + col) = xa[mm][bj] + gb0[bj] * v0;
                            *(f32x4*)(xout + (size_t)lr * DM + col + 4) = xb[mm][bj] + gb1[bj] * v1;
                        }
                    }
            }
    }
};

template <class EpiT, class Sched>
__device__ __forceinline__ void gemm_phase(LAS unsigned char* lds, const Gemm g, const Sched& S, const EpiT& E) {
    int tid_ = threadIdx.x; asm volatile("" : "+v"(tid_));
    const int tid = tid_, wid = __builtin_amdgcn_readfirstlane(tid >> 6), lane = tid & 63, wr = wid >> 2, wc = wid & 3, fr = lane & 15, fq = lane >> 4;
    const int K = g.K, nt = K / BK;
    unsigned voffA[2], voffB[2];
#pragma unroll
    for (int i = 0; i < 2; ++i) { int R, C; stage_rc(tid * 16 + i * 8192, R, C); const int Rb = (R & ~31) + perm32(R & 31);
        voffA[i] = (unsigned)(R * K + C) * 2u; voffB[i] = (unsigned)(Rb * K + C) * 2u; }
    const size_t kstep = (size_t)(BK * 2);
    const size_t hstep = (size_t)HALF * K * 2;
    const size_t tstep = 2 * hstep;
    const unsigned ldsw = (unsigned)wid * 1024u;
    const int aoff = lds_byte(wr * 64 + fr, fq * 8), boff = lds_byte(wc * 32 + fr, fq * 8);
#define PG8_SA(b, h) (((b) * 2 + (h)) * HTB)
#define PG8_SB(b, h) ((4 + (b) * 2 + (h)) * HTB)
#define PG8_STAGE(bufoff, gbase, voff) do { _Pragma("unroll") for (int _i = 0; _i < 2; ++_i) \
        __builtin_amdgcn_global_load_lds((const unsigned*)((const char*)(gbase) + (voff)[_i]), (LAS unsigned*)(lds + (bufoff) + ldsw + _i * 8192), 16, 0, 0); } while (0)
#define PG8_LDA(dst, b, h) do { _Pragma("unroll") for (int m = 0; m < 4; ++m) _Pragma("unroll") for (int k = 0; k < 2; ++k) dst[m][k] = *(const LAS bf16x8*)(lds + PG8_SA(b, h) + aoff + m * 2048 + k * 1024); } while (0)
#define PG8_LDB(dst, b, h) do { _Pragma("unroll") for (int n = 0; n < 2; ++n) _Pragma("unroll") for (int k = 0; k < 2; ++k) dst[n][k] = *(const LAS bf16x8*)(lds + PG8_SB(b, h) + boff + n * 2048 + k * 1024); } while (0)
#define PG8_MMA(ai, bj, At, Bt) do { __builtin_amdgcn_s_setprio(1); _Pragma("unroll") for (int m = 0; m < 4; ++m) _Pragma("unroll") for (int n = 0; n < 2; ++n) _Pragma("unroll") for (int k = 0; k < 2; ++k) \
        acc[ai][bj][m][n] = __builtin_amdgcn_mfma_f32_16x16x32_bf16(Bt[n][k], At[m][k], acc[ai][bj][m][n], 0, 0, 0); __builtin_amdgcn_s_setprio(0); } while (0)
#define PG8_WAIT_V(n) asm volatile("s_waitcnt vmcnt(" #n ")" ::: "memory")
#define PG8_WAIT_L(n) asm volatile("s_waitcnt lgkmcnt(" #n ")" ::: "memory")
#define PG8_BAR __builtin_amdgcn_s_barrier()
#define PG8_SCHED __builtin_amdgcn_sched_barrier(0)
    Unit cur, nxt; int ui = 0;
    if (!S.next(0, cur)) return;
    f32x4 acc[2][2][4][2];
#pragma unroll
    for (int a = 0; a < 2; ++a)
#pragma unroll
        for (int b = 0; b < 2; ++b)
#pragma unroll
            for (int m = 0; m < 4; ++m)
#pragma unroll
                for (int n = 0; n < 2; ++n) acc[a][b][m][n] = (f32x4){0.f, 0.f, 0.f, 0.f};
    bf16x8 At[4][2], B0[2][2], B1[2][2];
    const char* cA = (const char*)g.A + (size_t)cur.pm * tstep; const char* cB = (const char*)g.Bt + (size_t)cur.pn * tstep;
    PG8_STAGE(PG8_SB(0, 0), cB, voffB); PG8_STAGE(PG8_SB(0, 1), cB + hstep, voffB); PG8_STAGE(PG8_SA(0, 0), cA, voffA); PG8_STAGE(PG8_SA(0, 1), cA + hstep, voffA);
    if (wr == 1) PG8_BAR;
    PG8_WAIT_V(2); PG8_BAR;
    PG8_STAGE(PG8_SB(1, 0), cB + kstep, voffB); PG8_STAGE(PG8_SA(1, 0), cA + kstep, voffA); PG8_STAGE(PG8_SB(1, 1), cB + hstep + kstep, voffB);
    PG8_WAIT_V(6); PG8_BAR;
    for (;;) {
        const bool has_next = S.next(ui + 1, nxt);
        const char* nA = has_next ? (const char*)g.A + (size_t)nxt.pm * tstep : cA; const char* nB = has_next ? (const char*)g.Bt + (size_t)nxt.pn * tstep : cB;
        for (int t = 0; t < nt; t += 2) {
            const bool last = (t == nt - 2);
            const char* a1 = cA + (size_t)(t + 1) * kstep;
            const char* a2 = last ? nA : cA + (size_t)(t + 2) * kstep; const char* b2 = last ? nB : cB + (size_t)(t + 2) * kstep;
            const char* a3 = a2 + kstep; const char* b3 = b2 + kstep;
            PG8_LDB(B0, 0, 0); PG8_LDB(B1, 0, 1); PG8_SCHED; PG8_LDA(At, 0, 0); PG8_STAGE(PG8_SA(1, 1), a1 + hstep, voffA);
            PG8_WAIT_V(8); PG8_WAIT_L(0); PG8_BAR; PG8_MMA(0, 0, At, B0); PG8_MMA(0, 1, At, B1); PG8_BAR; PG8_SCHED;
            PG8_LDA(At, 0, 1); PG8_STAGE(PG8_SB(0, 0), b2, voffB); PG8_STAGE(PG8_SB(0, 1), b2 + hstep, voffB); PG8_STAGE(PG8_SA(0, 0), a2, voffA);
            PG8_WAIT_V(8); PG8_WAIT_L(0); PG8_BAR; PG8_MMA(1, 0, At, B0); PG8_MMA(1, 1, At, B1); PG8_BAR; PG8_SCHED;
            PG8_LDB(B0, 1, 0); PG8_LDB(B1, 1, 1); PG8_SCHED; PG8_LDA(At, 1, 0); PG8_STAGE(PG8_SA(0, 1), a2 + hstep, voffA);
            PG8_WAIT_V(8); PG8_WAIT_L(0); PG8_BAR; PG8_MMA(0, 0, At, B0); PG8_MMA(0, 1, At, B1); PG8_BAR; PG8_SCHED;
            PG8_LDA(At, 1, 1); PG8_STAGE(PG8_SB(1, 0), b3, voffB); PG8_STAGE(PG8_SB(1, 1), b3 + hstep, voffB); PG8_STAGE(PG8_SA(1, 0), a3, voffA);
            PG8_WAIT_V(8); PG8_WAIT_L(0); PG8_BAR; PG8_MMA(1, 0, At, B0); PG8_MMA(1, 1, At, B1); PG8_BAR; PG8_SCHED;
        }
        if (wr == 0) PG8_BAR;
        E(acc, cur, wr, wc, fr, fq);
        if (!has_next) break;
#pragma unroll
        for (int a = 0; a < 2; ++a)
#pragma unroll
            for (int b = 0; b < 2; ++b)
#pragma unroll
                for (int m = 0; m < 4; ++m)
#pragma unroll
                    for (int n = 0; n < 2; ++n) acc[a][b][m][n] = (f32x4){0.f, 0.f, 0.f, 0.f};
        cur = nxt; cA = nA; cB = nB; ++ui;
        if (wr == 1) PG8_BAR;
    }
    PG8_WAIT_V(0);
    PG8_BAR;
#undef PG8_SA
#undef PG8_SB
#undef PG8_STAGE
#undef PG8_LDA
#undef PG8_LDB
#undef PG8_MMA
#undef PG8_WAIT_V
#undef PG8_WAIT_L
#undef PG8_BAR
#undef PG8_SCHED
}
}

#ifndef QKT_SB_FROM
#define QKT_SB_FROM 100000
#endif
#ifndef QKT_SB_EVERY
#define QKT_SB_EVERY 4
#endif
#ifndef ATT_SD1_FROM
#define ATT_SD1_FROM 128
#endif
namespace att {
constexpr int NW = 8, QBLK = 32, KVBLK = 64;
constexpr float THR = 8.f;
constexpr int SHM_V = KVBLK * 128 * 2;
#define SBAR() __builtin_amdgcn_sched_barrier(0)
__device__ __forceinline__ int crow(int r, int hi) { return (r & 3) + 8 * (r >> 2) + 4 * hi; }
template <int DQK> __device__ __forceinline__ constexpr float scale_of() { return DQK == 64 ? 0.125f : (DQK == 128 ? 0.088388347648318440f : 0.072168783648703220f); }

template <int DQK>
__device__ __forceinline__ void partialSM(f32x16& p0, f32x16& p1, float& m_reg, float& mn, float& alpha) {
    constexpr float SCALE = scale_of<DQK>();
    constexpr float C = SCALE * 1.4426950408889634f;
    float pmax = p0[0];
#pragma unroll
    for (int r = 1; r < 16; ++r) pmax = fmaxf(pmax, p0[r]);
#pragma unroll
    for (int r = 0; r < 16; ++r) pmax = fmaxf(pmax, p1[r]);
    { auto rr = __builtin_amdgcn_permlane32_swap(__float_as_uint(pmax), __float_as_uint(pmax), false, false);
      pmax = fmaxf(__uint_as_float(rr[0]), __uint_as_float(rr[1])); }
    if (__builtin_expect(__all(pmax - m_reg <= THR / SCALE), 1)) { mn = m_reg; alpha = 1.f; }
    else { mn = fmaxf(m_reg, pmax); alpha = __builtin_amdgcn_exp2f((m_reg - mn) * C); m_reg = mn; }
    float mnC = -mn * C;
#pragma unroll
    for (int r = 0; r < 16; ++r) p0[r] = fmaf(p0[r], C, mnC);
#pragma unroll
    for (int r = 0; r < 16; ++r) p1[r] = fmaf(p1[r], C, mnC);
#pragma unroll
    for (int r = 0; r < 16; ++r) p0[r] = __builtin_amdgcn_exp2f(p0[r]);
}
__device__ __forceinline__ void finishSM(f32x16& p0, f32x16& p1, float alpha, float& l_reg, bf16x8& pa0, bf16x8& pa1, bf16x8& pa2, bf16x8& pa3) {
#pragma unroll
    for (int r = 0; r < 16; ++r) p1[r] = __builtin_amdgcn_exp2f(p1[r]);
    float ps = 0;
#pragma unroll
    for (int r = 0; r < 16; ++r) ps += p0[r];
#pragma unroll
    for (int r = 0; r < 16; ++r) ps += p1[r];
    { auto rr = __builtin_amdgcn_permlane32_swap(__float_as_uint(ps), __float_as_uint(ps), false, false);
      ps = __uint_as_float(rr[0]) + __uint_as_float(rr[1]); }
    l_reg = l_reg * alpha + ps;
#define PK4(P, BASE, OUT) do { unsigned a0 = cvt_pk_bf16(P[BASE + 0], P[BASE + 1]), a1 = cvt_pk_bf16(P[BASE + 2], P[BASE + 3]);   \
    unsigned b0 = cvt_pk_bf16(P[BASE + 4], P[BASE + 5]), b1 = cvt_pk_bf16(P[BASE + 6], P[BASE + 7]);                              \
    auto r0 = __builtin_amdgcn_permlane32_swap(a0, b0, false, false); auto r1 = __builtin_amdgcn_permlane32_swap(a1, b1, false, false); \
    u32x4 w = {r0[0], r1[0], r0[1], r1[1]}; OUT = *reinterpret_cast<bf16x8*>(&w); } while (0)
    PK4(p0, 0, pa0); PK4(p0, 8, pa1); PK4(p1, 0, pa2); PK4(p1, 8, pa3);
#undef PK4
}
template <int DQK, int QL = 0>
__device__ __forceinline__ void qkt(f32x16& p0, f32x16& p1, const char* Ks, const bf16x8* qr, int r32, int hi, const char* Qs = nullptr) {
    p0 = f32x16{}; p1 = f32x16{};
#pragma unroll
    for (int d0 = 0; d0 < DQK / 16; ++d0) { const int cb = (d0 * 16 + hi * 8) * 2;
        bf16x8 b0 = *reinterpret_cast<const bf16x8*>(Ks + r32 * (DQK * 2) + (cb ^ ((r32 & 7) << 4)));
        bf16x8 b1 = *reinterpret_cast<const bf16x8*>(Ks + (32 + r32) * (DQK * 2) + (cb ^ ((r32 & 7) << 4)));
        bf16x8 q;
        if (d0 < DQK / 16 - QL) q = qr[d0]; else q = *reinterpret_cast<const bf16x8*>(Qs + (d0 - (DQK / 16 - QL)) * 1024);
        p0 = __builtin_amdgcn_mfma_f32_32x32x16_bf16(b0, q, p0, 0, 0, 0);
        p1 = __builtin_amdgcn_mfma_f32_32x32x16_bf16(b1, q, p1, 0, 0, 0);
        if (DQK > QKT_SB_FROM && (d0 % QKT_SB_EVERY) == QKT_SB_EVERY - 1) SBAR(); }
}
__device__ __forceinline__ int v_st(int k, int c) { const int kk = (k & ~0xC) | ((k & 4) << 1) | ((k & 8) >> 1); return ((kk >> 3) * 4 + (c >> 5)) * 512 + ((kk & 7) * 32 + (c & 31)) * 2; }
__device__ __forceinline__ int v_rd_base(int lane) { return ((lane & 3) << 3) | (((lane >> 2) & 3) << 6) | (((lane >> 4) & 1) << 5) | (((lane >> 5) & 1) << 8); }
constexpr int v_rd_off(int d0, int ks, int half) { return d0 * 512 + ks * 4096 + half * 2048; }
template <int OFF> __device__ __forceinline__ s16x4 tr_read(int vb) {
    s16x4 r; asm volatile("ds_read_b64_tr_b16 %0, %1 offset:%2" : "=&v"(r) : "v"(vb), "i"(OFF) : "memory"); return r;
}
template <int D0> __device__ __forceinline__ void pv_one(f32x16& od, int vb, bf16x8 pa0, bf16x8 pa1, bf16x8 pa2, bf16x8 pa3) {
    const s16x4 l0 = tr_read<v_rd_off(D0, 0, 0)>(vb), h0 = tr_read<v_rd_off(D0, 0, 1)>(vb), l1 = tr_read<v_rd_off(D0, 1, 0)>(vb), h1 = tr_read<v_rd_off(D0, 1, 1)>(vb);
    const s16x4 l2 = tr_read<v_rd_off(D0, 2, 0)>(vb), h2 = tr_read<v_rd_off(D0, 2, 1)>(vb), l3 = tr_read<v_rd_off(D0, 3, 0)>(vb), h3 = tr_read<v_rd_off(D0, 3, 1)>(vb);
    asm volatile("s_waitcnt lgkmcnt(0)" ::: "memory"); SBAR();
#define PK(L, H) (bf16x8){L[0], L[1], L[2], L[3], H[0], H[1], H[2], H[3]}
    od = __builtin_amdgcn_mfma_f32_32x32x16_bf16(pa0, PK(l0, h0), od, 0, 0, 0);
    od = __builtin_amdgcn_mfma_f32_32x32x16_bf16(pa1, PK(l1, h1), od, 0, 0, 0);
    od = __builtin_amdgcn_mfma_f32_32x32x16_bf16(pa2, PK(l2, h2), od, 0, 0, 0);
    od = __builtin_amdgcn_mfma_f32_32x32x16_bf16(pa3, PK(l3, h3), od, 0, 0, 0);
#undef PK
}
__device__ __forceinline__ void pv_d0(f32x16* o, int vb, bf16x8 pa0, bf16x8 pa1, bf16x8 pa2, bf16x8 pa3) {
    pv_one<0>(o[0], vb, pa0, pa1, pa2, pa3); pv_one<1>(o[1], vb, pa0, pa1, pa2, pa3); pv_one<2>(o[2], vb, pa0, pa1, pa2, pa3); pv_one<3>(o[3], vb, pa0, pa1, pa2, pa3);
}

template <int DQK, int ldq, int ldk, int ldv, int ldo, int QL = 0>
__device__ __forceinline__ void attn_body(const bf16_t* __restrict__ Qb, const bf16_t* __restrict__ Kh, const bf16_t* __restrict__ Vh,
                                          bf16_t* __restrict__ Ob, int seq, char* lds) {
    constexpr int SHM_K = KVBLK * DQK * 2, NKC = DQK / 64, SD = (DQK >= ATT_SD1_FROM) ? 1 : 2, CPR = DQK / 8;
    int tid_ = threadIdx.x; asm volatile("" : "+v"(tid_));
    const int tid = tid_, wid = tid >> 6, lane = tid & 63, r32 = lane & 31, hi = lane >> 5;
    char* V_lds = lds; char* K_lds = lds + 2 * SHM_V;
    float* ws = (float*)(lds + 2 * SHM_V + 2 * SHM_K) + wid * 64; float* li_l = ws; float* al_l = ws + 32;
    constexpr int NQR = DQK / 16 - QL;
    float m_reg = -1e30f, l_reg = 0; f32x16 o[4] = {}; bf16x8 qr[NQR];
    const bf16_t* Qw = Qb + (long)(wid * QBLK + r32) * ldq + hi * 8;
#pragma unroll
    for (int d0 = 0; d0 < NQR; ++d0) qr[d0] = *reinterpret_cast<const bf16x8*>(Qw + d0 * 16);
    char* Qs = lds + 2 * SHM_V + 2 * SHM_K + NW * 256 + wid * (QL * 1024) + lane * 16;
#pragma unroll
    for (int d0 = 0; d0 < QL; ++d0) *reinterpret_cast<bf16x8*>(Qs + d0 * 1024) = *reinterpret_cast<const bf16x8*>(Qw + (NQR + d0) * 16);
    const int sr = tid >> 4, sc = (tid & 15) * 8, vst0 = v_st(sr, sc), vst1 = v_st(32 + sr, sc);
    unsigned koff[NKC]; int kdst[NKC];
    const unsigned voffV0 = (unsigned)(sr * ldv + sc) * 2u, voffV1 = (unsigned)((32 + sr) * ldv + sc) * 2u;
#pragma unroll
    for (int kc = 0; kc < NKC; ++kc) { const int ci = tid + 512 * kc; const int krow = ci / CPR, kcol = (ci % CPR) * 8; koff[kc] = (unsigned)(krow * ldk + kcol) * 2u;
        kdst[kc] = krow * (DQK * 2) + ((kcol * 2) ^ ((krow & 7) << 4)); }
    const int vb0 = (int)(uintptr_t)V_lds + v_rd_base(lane);
    struct { bf16x8 vs0, vs1, ks[NKC]; } sr_[SD];
#define SLOAD(i, k0) do { const char* vb_ = (const char*)Vh + (size_t)(k0) * (ldv * 2); const char* kb_ = (const char*)Kh + (size_t)(k0) * (ldk * 2); \
    sr_[i].vs0 = *reinterpret_cast<const bf16x8*>(vb_ + voffV0); sr_[i].vs1 = *reinterpret_cast<const bf16x8*>(vb_ + voffV1); \
    _Pragma("unroll") for (int kc_ = 0; kc_ < NKC; ++kc_) sr_[i].ks[kc_] = *reinterpret_cast<const bf16x8*>(kb_ + koff[kc_]); } while (0)
#define SWRITE(b, i) do { *(bf16x8*)(V_lds + (b) * SHM_V + vst0) = sr_[i].vs0; *(bf16x8*)(V_lds + (b) * SHM_V + vst1) = sr_[i].vs1; \
    _Pragma("unroll") for (int kc_ = 0; kc_ < NKC; ++kc_) *(bf16x8*)(K_lds + (b) * SHM_K + kdst[kc_]) = sr_[i].ks[kc_]; } while (0)
#define SWAIT() do { if constexpr (SD == 2) asm volatile("s_waitcnt vmcnt(%0)" :: "n"(2 + NKC) : "memory"); else asm volatile("s_waitcnt vmcnt(0)" ::: "memory"); } while (0)
#define RESC(a) do { if (__any((a) < 1.f)) { if (hi == 0) al_l[r32] = (a); asm volatile("s_waitcnt lgkmcnt(0)" ::: "memory"); \
    _Pragma("unroll") for (int d = 0; d < 4; ++d) _Pragma("unroll") for (int r = 0; r < 16; ++r) o[d][r] *= al_l[crow(r, hi)]; } } while (0)
    f32x16 pA0, pA1, pB0, pB1; float mnA, mnB, alA, alB; bf16x8 pa0, pa1, pa2, pa3; const int NT = seq / KVBLK;
    constexpr int SE = 0, SO = SD - 1;
    SLOAD(SE, 0); asm volatile("s_waitcnt vmcnt(0)" ::: "memory"); SWRITE(0, SE); __syncthreads();
    qkt<DQK, QL>(pA0, pA1, K_lds, qr, r32, hi, Qs); partialSM<DQK>(pA0, pA1, m_reg, mnA, alA);
    SLOAD(SO, KVBLK); if constexpr (SD == 2) { if (2 < NT) SLOAD(SE, 2 * KVBLK); }
    SWAIT(); SWRITE(1, SO); __syncthreads();
    for (int j = 1; j + 1 < NT; j += 2) {
        SBAR(); qkt<DQK, QL>(pB0, pB1, K_lds + SHM_K, qr, r32, hi, Qs);
        finishSM(pA0, pA1, alA, l_reg, pa0, pa1, pa2, pa3); SBAR();
        SLOAD(SO, (j + SD) * KVBLK); SBAR();
        pv_d0(o, vb0, pa0, pa1, pa2, pa3); partialSM<DQK>(pB0, pB1, m_reg, mnB, alB);
        __syncthreads(); SWAIT(); SWRITE(0, SE);
        RESC(alB); __syncthreads();
        SBAR(); qkt<DQK, QL>(pA0, pA1, K_lds, qr, r32, hi, Qs);
        finishSM(pB0, pB1, alB, l_reg, pa0, pa1, pa2, pa3); SBAR();
        if (SD == 1 || j + 3 < NT) SLOAD(SE, (j + 1 + SD) * KVBLK); SBAR();
        pv_d0(o, vb0 + (int)SHM_V, pa0, pa1, pa2, pa3); partialSM<DQK>(pA0, pA1, m_reg, mnA, alA);
        __syncthreads(); SWAIT(); SWRITE(1, SO);
        RESC(alA); __syncthreads();
    }
    SBAR(); qkt<DQK, QL>(pB0, pB1, K_lds + SHM_K, qr, r32, hi, Qs);
    finishSM(pA0, pA1, alA, l_reg, pa0, pa1, pa2, pa3); SBAR();
    pv_d0(o, vb0, pa0, pa1, pa2, pa3); partialSM<DQK>(pB0, pB1, m_reg, mnB, alB);
    __syncthreads(); RESC(alB);
    finishSM(pB0, pB1, alB, l_reg, pa0, pa1, pa2, pa3); SBAR();
    pv_d0(o, vb0 + (int)SHM_V, pa0, pa1, pa2, pa3);
    if (hi == 0) li_l[r32] = l_reg; asm volatile("s_waitcnt lgkmcnt(0)" ::: "memory");
    float rli[16];
#pragma unroll
    for (int r = 0; r < 16; ++r) rli[r] = __builtin_amdgcn_rcpf(li_l[crow(r, hi)]);
    bf16_t* Ow = Ob + (long)(wid * QBLK) * ldo;
#pragma unroll
    for (int r = 0; r < 16; ++r) { const int orow = crow(r, hi);
#pragma unroll
        for (int d0 = 0; d0 < 4; ++d0) Ow[(long)orow * ldo + d0 * 32 + r32] = f2bf(o[d0][r] * rli[r]); }
    __syncthreads();
#undef SLOAD
#undef SWRITE
#undef SWAIT
#undef RESC
}

template <int DQK, int ldq, int ldk, int ldv, int ldo>
__device__ __forceinline__ void attn_body_simple(const bf16_t* __restrict__ Qb, const bf16_t* __restrict__ Kh, const bf16_t* __restrict__ Vh,
                                                 bf16_t* __restrict__ Ob, int seq, char* lds) {
    constexpr int SHM_K = KVBLK * DQK * 2, NKC = DQK / 64, CPR = DQK / 8;
    int tid_ = threadIdx.x; asm volatile("" : "+v"(tid_));
    const int tid = tid_, wid = tid >> 6, lane = tid & 63, r32 = lane & 31, hi = lane >> 5;
    char* V_lds = lds; char* K_lds = lds + 2 * SHM_V;
    float* ws = (float*)(lds + 2 * SHM_V + 2 * SHM_K) + wid * 64; float* li_l = ws; float* al_l = ws + 32;
    float m_reg = -1e30f, l_reg = 0; f32x16 o[4] = {}; bf16x8 qr[DQK / 16];
    const bf16_t* Qw = Qb + (long)(wid * QBLK + r32) * ldq + hi * 8;
#pragma unroll
    for (int d0 = 0; d0 < DQK / 16; ++d0) qr[d0] = *reinterpret_cast<const bf16x8*>(Qw + d0 * 16);
    const int sr = tid >> 4, sc = (tid & 15) * 8, vst0 = v_st(sr, sc), vst1 = v_st(32 + sr, sc);
    unsigned koff[NKC]; int kdst[NKC];
    const unsigned voffV0 = (unsigned)(sr * ldv + sc) * 2u, voffV1 = (unsigned)((32 + sr) * ldv + sc) * 2u;
#pragma unroll
    for (int kc = 0; kc < NKC; ++kc) { const int ci = tid + 512 * kc; const int krow = ci / CPR, kcol = (ci % CPR) * 8; koff[kc] = (unsigned)(krow * ldk + kcol) * 2u;
        kdst[kc] = krow * (DQK * 2) + ((kcol * 2) ^ ((krow & 7) << 4)); }
    const int vb0 = (int)(uintptr_t)V_lds + v_rd_base(lane);
    bf16x8 vs0, vs1, ks[NKC];
#define SLOAD1(k0) do { const char* vb_ = (const char*)Vh + (size_t)(k0) * (ldv * 2); const char* kb_ = (const char*)Kh + (size_t)(k0) * (ldk * 2); \
    vs0 = *reinterpret_cast<const bf16x8*>(vb_ + voffV0); vs1 = *reinterpret_cast<const bf16x8*>(vb_ + voffV1); \
    _Pragma("unroll") for (int kc_ = 0; kc_ < NKC; ++kc_) ks[kc_] = *reinterpret_cast<const bf16x8*>(kb_ + koff[kc_]); } while (0)
#define SWRITE1(b) do { *(bf16x8*)(V_lds + (b) * SHM_V + vst0) = vs0; *(bf16x8*)(V_lds + (b) * SHM_V + vst1) = vs1; \
    _Pragma("unroll") for (int kc_ = 0; kc_ < NKC; ++kc_) *(bf16x8*)(K_lds + (b) * SHM_K + kdst[kc_]) = ks[kc_]; } while (0)
    f32x16 pA0, pA1; float mnA, alA; bf16x8 pa0, pa1, pa2, pa3; const int NT = seq / KVBLK;
    SLOAD1(0); asm volatile("s_waitcnt vmcnt(0)" ::: "memory"); SWRITE1(0); __syncthreads();
    for (int j = 0; j < NT; ++j) {
        const int buf = j & 1;
        if (j + 1 < NT) SLOAD1((j + 1) * KVBLK);
        SBAR();
        qkt<DQK>(pA0, pA1, K_lds + buf * SHM_K, qr, r32, hi);
        partialSM<DQK>(pA0, pA1, m_reg, mnA, alA);
        if (__any(alA < 1.f)) { if (hi == 0) al_l[r32] = alA; asm volatile("s_waitcnt lgkmcnt(0)" ::: "memory");
#pragma unroll
            for (int d = 0; d < 4; ++d)
#pragma unroll
                for (int r = 0; r < 16; ++r) o[d][r] *= al_l[crow(r, hi)]; }
        finishSM(pA0, pA1, alA, l_reg, pa0, pa1, pa2, pa3); SBAR();
        pv_d0(o, vb0 + buf * (int)SHM_V, pa0, pa1, pa2, pa3);
        if (j + 1 < NT) { asm volatile("s_waitcnt vmcnt(0)" ::: "memory"); SWRITE1(buf ^ 1); }
        __syncthreads();
    }
    if (hi == 0) li_l[r32] = l_reg; asm volatile("s_waitcnt lgkmcnt(0)" ::: "memory");
    float rli[16];
#pragma unroll
    for (int r = 0; r < 16; ++r) rli[r] = __builtin_amdgcn_rcpf(li_l[crow(r, hi)]);
    bf16_t* Ow = Ob + (long)(wid * QBLK) * ldo;
#pragma unroll
    for (int r = 0; r < 16; ++r) { const int orow = crow(r, hi);
#pragma unroll
        for (int d0 = 0; d0 < 4; ++d0) Ow[(long)orow * ldo + d0 * 32 + r32] = f2bf(o[d0][r] * rli[r]); }
    __syncthreads();
#undef SLOAD1
#undef SWRITE1
}

template <int DQK, int ldq, int ldk, int ldv, int ldo>
__device__ __forceinline__ void attn_body_dma(const bf16_t* __restrict__ Qb, const bf16_t* __restrict__ Kh, const bf16_t* __restrict__ Vh,
                                              bf16_t* __restrict__ Ob, int seq, char* lds) {
    constexpr int SHM_K = KVBLK * DQK * 2, NKC = DQK / 64;
    int tid_ = threadIdx.x; asm volatile("" : "+v"(tid_));
    const int tid = tid_, wid = __builtin_amdgcn_readfirstlane(tid >> 6), lane = tid & 63, r32 = lane & 31, hi = lane >> 5;
    char* V_lds = lds; char* K_lds = lds + 2 * SHM_V;
    float* ws = (float*)(lds + 2 * SHM_V + 2 * SHM_K) + wid * 64; float* li_l = ws; float* al_l = ws + 32;
    float m_reg = -1e30f, l_reg = 0; f32x16 o[4] = {}; bf16x8 qr[DQK / 16];
    const bf16_t* Qw = Qb + (long)(wid * QBLK + r32) * ldq + hi * 8;
#pragma unroll
    for (int d0 = 0; d0 < DQK / 16; ++d0) qr[d0] = *reinterpret_cast<const bf16x8*>(Qw + d0 * 16);
    unsigned vsrc[2], ksrc[NKC];
#pragma unroll
    for (int i = 0; i < 2; ++i) { const int o_ = i * 8192 + tid * 16; const int sub = o_ >> 9, w_ = (o_ & 511) >> 1; const int kk = (sub >> 2) * 8 + (w_ >> 5), c = (sub & 3) * 32 + (w_ & 31);
        const int k = (kk & ~0xC) | ((kk & 4) << 1) | ((kk & 8) >> 1); vsrc[i] = (unsigned)(k * ldv + c) * 2u; }
#pragma unroll
    for (int i = 0; i < NKC; ++i) { const int o_ = i * 8192 + tid * 16; const int row = o_ / (DQK * 2), b = o_ % (DQK * 2); const int cb = b ^ ((row & 7) << 4);
        ksrc[i] = (unsigned)(row * ldk) * 2u + (unsigned)cb; }
    const unsigned vdst = (unsigned)(uintptr_t)V_lds + (unsigned)wid * 1024u, kdst0 = (unsigned)(uintptr_t)K_lds + (unsigned)wid * 1024u;
    const int vb0 = (int)(uintptr_t)V_lds + v_rd_base(lane);
#define DMA_TILE(k0, b) do { const char* vb_ = (const char*)Vh + (size_t)(k0) * (ldv * 2); const char* kb_ = (const char*)Kh + (size_t)(k0) * (ldk * 2); \
    _Pragma("unroll") for (int i_ = 0; i_ < 2; ++i_) __builtin_amdgcn_global_load_lds((const unsigned*)(vb_ + vsrc[i_]), (LAS unsigned*)(vdst + (b) * SHM_V + i_ * 8192), 16, 0, 0); \
    _Pragma("unroll") for (int i_ = 0; i_ < NKC; ++i_) __builtin_amdgcn_global_load_lds((const unsigned*)(kb_ + ksrc[i_]), (LAS unsigned*)(kdst0 + (b) * SHM_K + i_ * 8192), 16, 0, 0); } while (0)
    f32x16 pA0, pA1; float mnA, alA; bf16x8 pa0, pa1, pa2, pa3; const int NT = seq / KVBLK;
    DMA_TILE(0, 0); asm volatile("s_waitcnt vmcnt(0)" ::: "memory"); __syncthreads();
    for (int j = 0; j < NT; ++j) {
        const int buf = j & 1;
        SBAR();
        qkt<DQK>(pA0, pA1, K_lds + buf * SHM_K, qr, r32, hi);
        SBAR();
        if (j + 1 < NT) DMA_TILE((j + 1) * KVBLK, buf ^ 1);
        SBAR();
        partialSM<DQK>(pA0, pA1, m_reg, mnA, alA);
        if (__any(alA < 1.f)) { if (hi == 0) al_l[r32] = alA; asm volatile("s_waitcnt lgkmcnt(0)" ::: "memory");
#pragma unroll
            for (int d = 0; d < 4; ++d)
#pragma unroll
                for (int r = 0; r < 16; ++r) o[d][r] *= al_l[crow(r, hi)]; }
        finishSM(pA0, pA1, alA, l_reg, pa0, pa1, pa2, pa3); SBAR();
        pv_d0(o, vb0 + buf * (int)SHM_V, pa0, pa1, pa2, pa3);
        asm volatile("s_waitcnt vmcnt(0)" ::: "memory");
        __syncthreads();
    }
    if (hi == 0) li_l[r32] = l_reg; asm volatile("s_waitcnt lgkmcnt(0)" ::: "memory");
    float rli[16];
#pragma unroll
    for (int r = 0; r < 16; ++r) rli[r] = __builtin_amdgcn_rcpf(li_l[crow(r, hi)]);
    bf16_t* Ow = Ob + (long)(wid * QBLK) * ldo;
#pragma unroll
    for (int r = 0; r < 16; ++r) { const int orow = crow(r, hi);
#pragma unroll
        for (int d0 = 0; d0 < 4; ++d0) Ow[(long)orow * ldo + d0 * 32 + r32] = f2bf(o[d0][r] * rli[r]); }
    __syncthreads();
#undef DMA_TILE
}
}

__device__ __forceinline__ unsigned pk2(float lo, float hi) { return cvt_pk_bf16(lo, hi); }

__device__ __forceinline__ void transpose_mat(const float* W, int K, int Nsrc, bf16_t* WT, int Ndst, int mode, LAS float* scr, int gw, int NGW, int lane) {
    const int nblk = Ndst / 32, nitems = (K / 64) * nblk;
    for (int item = gw; item < nitems; item += NGW) {
        const int kb = item / nblk, nb = item % nblk, k0 = 64 * kb, n0 = 32 * nb;
        int s0 = n0;
        if (mode == 1) s0 = n0 < 3520 ? n0 : (n0 < 3584 ? -1 : n0 - 64);
        if (mode == 2) { const int pn = n0 >> 8, j = n0 & 255; s0 = j < 128 ? 128 * pn + j : DFF + 128 * pn + (j - 128); }
        float wv[32];
#pragma unroll
        for (int i = 0; i < 32; ++i) { const int kk = 2 * i + (lane >> 5); wv[i] = s0 < 0 ? 0.f : W[(size_t)(k0 + kk) * Nsrc + s0 + (lane & 31)]; }
#pragma unroll
        for (int i = 0; i < 32; ++i) { const int kk = 2 * i + (lane >> 5); scr[kk * 33 + (lane & 31)] = wv[i]; }
        asm volatile("s_waitcnt lgkmcnt(0)" ::: "memory");
        const int c = lane & 7;
#pragma unroll
        for (int j = 0; j < 4; ++j) { const int n = (lane >> 3) + 8 * j; const LAS float* s = scr + (8 * c) * 33 + n;
            u32x4 o; o.x = pk2(s[0 * 33], s[1 * 33]); o.y = pk2(s[2 * 33], s[3 * 33]); o.z = pk2(s[4 * 33], s[5 * 33]); o.w = pk2(s[6 * 33], s[7 * 33]);
            *(u32x4*)(WT + (size_t)(n0 + n) * K + k0 + 8 * c) = o; }
        asm volatile("s_waitcnt lgkmcnt(0)" ::: "memory");
    }
}

__device__ __forceinline__ void ph_prologue(const Params& p, LAS unsigned char* lds) {
    const int tid = otid(), wave = tid >> 6, lane = tid & 63;
    const int gw = obid() * 8 + wave, NGW = gridDim.x * 8;
    LAS float* scr = (LAS float*)(lds + wave * 16384);
    for (int l = 0; l < 2; ++l) {
        bf16_t* Wl = (bf16_t*)(p.ws + WS_W + l * W_LAYER_B);
        transpose_mat(p.in[7] + (size_t)l * 1024 * 7616, 1024, 7616, Wl + W_IN, 7680, 1, scr, gw, NGW, lane);
        transpose_mat(p.in[26] + (size_t)l * 256 * 768, 256, 768, Wl + W_UQ, 768, 0, scr, gw, NGW, lane);
        transpose_mat(p.in[27] + (size_t)l * 128 * 1024, 128, 1024, Wl + W_UKV, 1024, 0, scr, gw, NGW, lane);
        transpose_mat(p.in[16] + (size_t)l * 512 * 512, 512, 512, Wl + W_GLU, 512, 0, scr, gw, NGW, lane);
        for (int n = 0; n < 4; ++n) transpose_mat(p.in[30] + ((size_t)l * 4 + n) * 512 * 1024, 512, 1024, Wl + W_BR + (size_t)n * 1024 * 512, 1024, 0, scr, gw, NGW, lane);
        transpose_mat(p.in[31] + (size_t)l * 1024 * 1024, 1024, 1024, Wl + W_OUT, 1024, 0, scr, gw, NGW, lane);
        transpose_mat(p.in[33] + (size_t)l * 1024 * 5632, 1024, 5632, Wl + W_FI, 5632, 2, scr, gw, NGW, lane);
        transpose_mat(p.in[34] + (size_t)l * 2816 * 1024, 2816, 1024, Wl + W_FO, 1024, 0, scr, gw, NGW, lane);
    }
    {
        typedef float f32x2t __attribute__((ext_vector_type(2)));
        f32x2t* T64 = (f32x2t*)(p.ws + WS_ROPE64); f32x2t* T128 = (f32x2t*)(p.ws + WS_ROPE128);
        for (int idx = obid() * 512 + tid; idx < 128 * 16 + 128 * 32; idx += gridDim.x * 512) {
            if (idx < 128 * 16) { const int pos = idx >> 4, k = idx & 15; const float ang = (float)pos * exp2f(-(float)(4 * k) * (13.287712379549449f / 64)); T64[idx] = (f32x2t){cosf(ang), sinf(ang)}; }
            else { const int i2 = idx - 128 * 16, pos = i2 >> 5, k = i2 & 31; const float ang = (float)pos * exp2f(-(float)(4 * k) * (13.287712379549449f / 128)); T128[i2] = (f32x2t){cosf(ang), sinf(ang)}; }
        }
    }
    __syncthreads();
    LAS float* sc = (LAS float*)lds;
    LAS float* part = (LAS float*)(lds + 32768);
    float* MOD = (float*)(p.ws + WS_MOD);
    for (int it = obid(); it < 2 * 96; it += gridDim.x) {
        const int l = it / 96, cb = it % 96;
        for (int idx = tid; idx < 5 * 1024; idx += 512) { const int mi = idx >> 10, k = idx & 1023; const float v = mi < 4 ? p.in[1][mi * 1024 + k] : p.in[3][k]; sc[idx] = v / (1.f + __expf(-v)); }
        __syncthreads();
        const int j = cb * 64 + lane; const float* wm = p.in[4] + (size_t)l * 1024 * MODW + j;
        float a0 = 0, a1 = 0, a2 = 0, a3 = 0, a4 = 0;
#pragma unroll 32
        for (int kk = 0; kk < 128; ++kk) { const int k = wave * 128 + kk; const float w = wm[(size_t)k * MODW];
            a0 += sc[k] * w; a1 += sc[1024 + k] * w; a2 += sc[2048 + k] * w; a3 += sc[3072 + k] * w; a4 += sc[4096 + k] * w; }
        part[(wave * 5 + 0) * 64 + lane] = a0; part[(wave * 5 + 1) * 64 + lane] = a1; part[(wave * 5 + 2) * 64 + lane] = a2; part[(wave * 5 + 3) * 64 + lane] = a3; part[(wave * 5 + 4) * 64 + lane] = a4;
        __syncthreads();
        if (tid < 320) { const int mi = tid >> 6, jj = tid & 63; float s = 0;
#pragma unroll
            for (int w = 0; w < 8; ++w) s += part[(w * 5 + mi) * 64 + jj];
            MOD[((size_t)l * 5 + mi) * MODW + cb * 64 + jj] = s + p.in[5][l * MODW + cb * 64 + jj]; }
        __syncthreads();
    }
}

__device__ __forceinline__ const float* row_src(int R, const float* xl, const float* xc, int& mi) {
    const int b = R / RB, s = R - b * RB;
    if (s < CTX) { mi = 4; return xc + ((size_t)b * CTX + s) * DM; }
    mi = b; return xl + ((size_t)b * SEQ + (s - CTX)) * DM;
}
__device__ __forceinline__ void nm_finish(const f32x4 (&v)[4], int R, int mi, int lane, const float* gain, const float* modl, int sh_chunk, bf16_t* H) {
    const float* shp = modl + (size_t)mi * MODW + sh_chunk * 1024; const float* scp = shp + 1024;
    float ss = 0.f;
#pragma unroll
    for (int j = 0; j < 4; ++j) ss += (v[j].x * v[j].x + v[j].y * v[j].y) + (v[j].z * v[j].z + v[j].w * v[j].w);
    const float rs = rsqrtf(wave_sum(ss) * (1.f / DM) + EPS);
#pragma unroll
    for (int j = 0; j < 4; ++j) { const int c = j * 256 + lane * 4;
        const f32x4 g = *(const f32x4*)(gain + c), sh = *(const f32x4*)(shp + c), sc = *(const f32x4*)(scp + c);
        const f32x4 y = (v[j] * rs * g) * (sc + 1.0f) + sh;
        u32x2 w; w.x = cvt_pk_bf16(y.x, y.y); w.y = cvt_pk_bf16(y.z, y.w);
        *(u32x2*)(H + (size_t)R * DM + c) = w; }
}
__device__ __forceinline__ void ph_norm_mod(const float* xl, const float* xc, const float* gain, const float* modl, int sh_chunk, bf16_t* H) {
    const int tid = otid(); const int lane = tid & 63, gw = obid() * 8 + (tid >> 6), NGW = gridDim.x * 8;
    for (int R = gw; R < MTOT; R += 2 * NGW) {
        const int R2 = R + NGW; const bool has2 = R2 < MTOT;
        int mi, mi2 = 0; const float* xr = row_src(R, xl, xc, mi); const float* xr2 = has2 ? row_src(R2, xl, xc, mi2) : xr;
        f32x4 v[4], v2[4];
#pragma unroll
        for (int j = 0; j < 4; ++j) v[j] = *(const f32x4*)(xr + j * 256 + lane * 4);
#pragma unroll
        for (int j = 0; j < 4; ++j) v2[j] = *(const f32x4*)(xr2 + j * 256 + lane * 4);
        nm_finish(v, R, mi, lane, gain, modl, sh_chunk, H);
        if (has2) nm_finish(v2, R2, mi2, lane, gain, modl, sh_chunk, H);
    }
}

__device__ __forceinline__ int s5_pos(int i, int dir) { return dir == 0 ? i : (i < CTX ? (CTX - 1 - i) : (RB + CTX - 1 - i)); }
__device__ __forceinline__ void s5_chain(const Params& p, int layer, int unit, LAS unsigned char* lds) {
    const int b = unit >> 6, dir = (unit >> 5) & 1, g = unit & 31;
    const int tid = otid(), wid = tid >> 6, lane = tid & 63, fr = lane & 15, quad = lane >> 4;
    LAS float* BU = (LAS float*)lds;
    LAS bf16_t* Hb = (LAS bf16_t*)(lds + 65536);
    const int ldg = ((layer * 2 + dir) * 32 + g);
    const float* lam_re = p.in[8] + (size_t)ldg * 64; const float* lam_im = p.in[9] + (size_t)ldg * 64;
    const float dt = expf(p.in[10][ldg]);
    const float* bre = p.in[11] + (size_t)ldg * 64 * 16; const float* bim = p.in[12] + (size_t)ldg * 64 * 16;
    const float* cre = p.in[13] + (size_t)ldg * 16 * 64; const float* cim = p.in[14] + (size_t)ldg * 16 * 64;
    const bf16_t* U = (const bf16_t*)(p.ws + WS_G + S_U) + (size_t)b * RB * 512 + g * 16;
    bf16_t* Y = (bf16_t*)(p.ws + WS_G + (dir == 0 ? S_YF : S_YR)) + ((size_t)g * MTOT + (size_t)b * RB) * 16;
    const int cb0 = (wid & 3) * 2;
    bf16x8 bop[2] = {{0, 0, 0, 0, 0, 0, 0, 0}, {0, 0, 0, 0, 0, 0, 0, 0}};
#pragma unroll
    for (int t = 0; t < 2; ++t) {
        const int cb = cb0 + t, pst = (cb & 3) * 16 + fr; const float lr = lam_re[pst], li = lam_im[pst];
        const float mag = expf(lr * dt); const float abr = mag * cosf(li * dt), abi = mag * sinf(li * dt);
        const float den = lr * lr + li * li, nr = abr - 1.f, ni = abi;
        const float cr = (nr * lr + ni * li) / den, ci = (ni * lr - nr * li) / den;
        if (quad < 2) {
#pragma unroll
            for (int j = 0; j < 8; ++j) { const int c = quad * 8 + j; const float br_ = bre[pst * 16 + c], bi_ = bim[pst * 16 + c];
                const float v = (cb < 4) ? cr * br_ - ci * bi_ : cr * bi_ + ci * br_; bop[t][j] = (short)f2bf(v); }
        }
    }
    float ar, ai, hr = 0.f, hi = 0.f;
    { const float lr = lam_re[lane], li = lam_im[lane]; const float mag = expf(lr * dt); ar = mag * cosf(li * dt); ai = mag * sinf(li * dt); }
    bf16x8 cop[4];
#pragma unroll
    for (int ks = 0; ks < 4; ++ks)
#pragma unroll
        for (int j = 0; j < 8; ++j) { const int k = ks * 32 + quad * 8 + j; const float v = (k & 1) ? -cim[fr * 64 + (k >> 1)] : cre[fr * 64 + (k >> 1)]; cop[ks][j] = (short)f2bf(v); }
#define S5_LD(chunk, A_) do { _Pragma("unroll") for (int rb = 0; rb < 4; ++rb) { const int s_ = s5_pos((chunk) * 64 + rb * 16 + fr, dir); \
        A_[rb] = (bf16x8){0, 0, 0, 0, 0, 0, 0, 0}; if (quad < 2) A_[rb] = *(const bf16x8*)(U + (size_t)s_ * 512 + quad * 8); } } while (0)
#define S5_MM(A_, BUb) do { _Pragma("unroll") for (int rb = 0; rb < 4; ++rb) { \
        _Pragma("unroll") for (int t = 0; t < 2; ++t) { f32x4 acc = {0.f, 0.f, 0.f, 0.f}; acc = __builtin_amdgcn_mfma_f32_16x16x32_bf16(A_[rb], bop[t], acc, 0, 0, 0); \
            _Pragma("unroll") for (int j = 0; j < 4; ++j) (BUb)[(rb * 16 + quad * 4 + j) * 128 + (cb0 + t) * 16 + fr] = acc[j]; } } } while (0)
#define S5_C(chunk, Hbb, rb) do { f32x4 acc = {0.f, 0.f, 0.f, 0.f}; \
        _Pragma("unroll") for (int ks = 0; ks < 4; ++ks) { const bf16x8 aop = *(const LAS bf16x8*)((Hbb) + ((rb) * 16 + fr) * 136 + ks * 32 + quad * 8); \
            acc = __builtin_amdgcn_mfma_f32_16x16x32_bf16(aop, cop[ks], acc, 0, 0, 0); } \
        _Pragma("unroll") for (int j = 0; j < 4; ++j) { const int s_ = s5_pos((chunk) * 64 + (rb) * 16 + quad * 4 + j, dir); Y[(size_t)s_ * 16 + fr] = f2bf(acc[j]); } } while (0)
    constexpr int NCH = RB / 64;
    bf16x8 ua[4], ub[4];
    if (wid >= 4) { S5_LD(0, ua); S5_MM(ua, BU); S5_LD(1, ua); }
    __syncthreads();
    for (int k = 0; k < NCH; ++k) {
        LAS float* BUc = BU + (k & 1) * 8192; LAS bf16_t* Hbc = Hb + (k & 1) * (64 * 136);
        if (wid == 0) {
#pragma unroll
            for (int hf = 0; hf < 2; ++hf) {
                float brv[32], biv[32];
#pragma unroll
                for (int i = 0; i < 32; ++i) { brv[i] = BUc[(hf * 32 + i) * 128 + lane]; biv[i] = BUc[(hf * 32 + i) * 128 + 64 + lane]; }
#pragma unroll
                for (int i = 0; i < 32; ++i) {
                    const float nr = fmaf(ar, hr, fmaf(-ai, hi, brv[i])), ni = fmaf(ar, hi, fmaf(ai, hr, biv[i]));
                    hr = nr; hi = ni;
                    *(LAS unsigned*)(Hbc + (hf * 32 + i) * 136 + 2 * lane) = cvt_pk_bf16(hr, hi);
                }
            }
        } else if (wid >= 4) {
            if (k + 1 < NCH) { LAS float* BUn = BU + ((k + 1) & 1) * 8192;
                if (k + 2 < NCH) S5_LD(k + 2, ub);
                S5_MM(ua, BUn);
#pragma unroll
                for (int rb = 0; rb < 4; ++rb) ua[rb] = ub[rb]; }
        } else if (k > 0) {
            LAS bf16_t* Hbp = Hb + ((k - 1) & 1) * (64 * 136);
            S5_C(k - 1, Hbp, wid - 1);
            if (wid == 1) S5_C(k - 1, Hbp, 3);
        }
        __syncthreads();
    }
    if (wid >= 1 && wid < 4) { LAS bf16_t* Hbp = Hb + ((NCH - 1) & 1) * (64 * 136); S5_C(NCH - 1, Hbp, wid - 1); if (wid == 1) S5_C(NCH - 1, Hbp, 3); }
    __syncthreads();
#undef S5_LD
#undef S5_MM
#undef S5_C
}

__device__ __forceinline__ u32x4 gelu8(const u32x4 u, const u32x4 yf, const u32x4 yr, const float* d, int c) {
    float o[8];
#pragma unroll
    for (int e = 0; e < 4; ++e) {
        const float y0 = d[c + 2 * e] * bflo(u[e]) + bflo(yf[e]) + bflo(yr[e]);
        const float y1 = d[c + 2 * e + 1] * bfhi(u[e]) + bfhi(yf[e]) + bfhi(yr[e]);
        o[2 * e] = y0 * sigmoidf_(1.5957691216057308f * (y0 + 0.044715f * y0 * y0 * y0));
        o[2 * e + 1] = y1 * sigmoidf_(1.5957691216057308f * (y1 + 0.044715f * y1 * y1 * y1));
    }
    u32x4 w; w.x = cvt_pk_bf16(o[0], o[1]); w.y = cvt_pk_bf16(o[2], o[3]); w.z = cvt_pk_bf16(o[4], o[5]); w.w = cvt_pk_bf16(o[6], o[7]);
    return w;
}
__device__ __forceinline__ void ph_s5_gelu(const Params& p, int layer) {
    bf16_t* U = (bf16_t*)(p.ws + WS_G + S_U); const bf16_t* YF = (const bf16_t*)(p.ws + WS_G + S_YF); const bf16_t* YR = (const bf16_t*)(p.ws + WS_G + S_YR);
    const float* d = p.in[15] + layer * 512;
    const size_t n8 = (size_t)MTOT * 512 / 8, stride = (size_t)gridDim.x * 512;
    const int tid = otid();
    for (size_t i = (size_t)obid() * 512 + tid; i < n8; i += 2 * stride) {
        const size_t i2 = i + stride; const bool has2 = i2 < n8; const size_t ib = has2 ? i2 : i;
        const int c = (int)(i & 63) * 8, c2 = (int)(ib & 63) * 8;
        const size_t yo = ((size_t)(c >> 4) * MTOT + (i >> 6)) * 16 + (c & 15), yo2 = ((size_t)(c2 >> 4) * MTOT + (ib >> 6)) * 16 + (c2 & 15);
        const u32x4 u = *(const u32x4*)(U + i * 8), yf = *(const u32x4*)(YF + yo), yr = *(const u32x4*)(YR + yo);
        const u32x4 ub = *(const u32x4*)(U + ib * 8), yfb = *(const u32x4*)(YF + yo2), yrb = *(const u32x4*)(YR + yo2);
        *(u32x4*)(U + i * 8) = gelu8(u, yf, yr, d, c);
        if (has2) *(u32x4*)(U + ib * 8) = gelu8(ub, yfb, yrb, d, c2);
    }
}

template <int NP> __device__ __forceinline__ void seg_load(const bf16_t* in, int ncols, int lane, unsigned (&w)[NP]) {
#pragma unroll
    for (int i = 0; i < NP; ++i) w[i] = (128 * i + 2 * lane < ncols) ? *(const unsigned*)(in + 128 * i + 2 * lane) : 0u;
}
template <int CW, int NP>
__device__ __forceinline__ void seg_fin(const unsigned (&w)[NP], bf16_t* out, int ncols, const float* gain, bool rope, int t, int lane, const float* rtab = nullptr) {
#pragma unroll
    for (int i = 0; i < NP; ++i) {
        const bool valid = 128 * i + 2 * lane < ncols;
        const float x0 = bflo(w[i]), x1 = bfhi(w[i]);
        float ss = x0 * x0 + x1 * x1;
        ss = (CW == 64) ? half_sum(ss) : wave_sum(ss);
        const float rs = rsqrtf(ss * (1.f / CW) + EPS);
        const int e = (2 * lane) % CW;
        float y0 = x0 * rs * gain[e], y1 = x1 * rs * gain[e + 1];
        if (rope) {
            const int pi = e >> 1, q = CW / 4; const int k = pi < q ? pi : pi - q; const int pos = pi < q ? (t >> 6) : (t & 63);
            typedef float f32x2t __attribute__((ext_vector_type(2)));
            const f32x2t cssn = ((const f32x2t*)rtab)[pos * q + k]; const float cs = cssn.x, sn = cssn.y;
            const float r0 = y0 * cs - y1 * sn, r1 = y0 * sn + y1 * cs; y0 = r0; y1 = r1;
        }
        if (valid) *(unsigned*)(out + 128 * i + 2 * lane) = cvt_pk_bf16(y0, y1);
    }
}
__device__ __forceinline__ void ph_prep1(const Params& p, int layer) {
    const int tid = otid(); const int lane = tid & 63, gw = obid() * 8 + (tid >> 6), NGW = gridDim.x * 8;
    bf16_t* Z = (bf16_t*)(p.ws + WS_G + G_Z); bf16_t* CQ = (bf16_t*)(p.ws + WS_G + G_CQ); bf16_t* CKV = (bf16_t*)(p.ws + WS_G + G_CKV);
    const float* daq = p.in[18] + layer * 64; const float* dak = p.in[19] + layer * 64; const float* gqq = p.in[22] + layer * 128; const float* gqk = p.in[23] + layer * 128;
    const float* r64 = (const float*)(p.ws + WS_ROPE64); const float* r128 = (const float*)(p.ws + WS_ROPE128);
    const float* cqn = p.in[24] + layer * 256; const float* ckvn = p.in[25] + layer * 128; const float* mlk = p.in[29] + layer * 192;
    for (int r = gw; r < RB; r += NGW) {
        bf16_t* z = Z + (size_t)r * ZW; const bool lat = r >= CTX; const int t = r - CTX;
        unsigned wq[4], wk[4], gq[4], gk[2], kv[1], kr[1];
        seg_load<4>(z + Z_DAQ, 512, lane, wq); seg_load<4>(z + Z_DAK, 512, lane, wk); seg_load<4>(z + Z_GQQ, 512, lane, gq); seg_load<2>(z + Z_GQK, 256, lane, gk);
        seg_load<1>(z + Z_CKV, 128, lane, kv); seg_load<1>(z + Z_KR, 64, lane, kr);
        const u32x2 wc = *(const u32x2*)(z + Z_CQ + 4 * lane);
        seg_fin<64, 4>(wq, z + Z_DAQ, 512, daq, lat, t, lane, r64);
        seg_fin<64, 4>(wk, z + Z_DAK, 512, dak, lat, t, lane, r64);
        seg_fin<128, 4>(gq, z + Z_GQQ, 512, gqq, lat, t, lane, r128);
        seg_fin<128, 2>(gk, z + Z_GQK, 256, gqk, lat, t, lane, r128);
        seg_fin<128, 1>(kv, CKV + (size_t)r * 128, 128, ckvn, false, 0, lane);
        seg_fin<64, 1>(kr, z + Z_KR, 64, mlk + 128, lat, t, lane, r64);
        {
            const float x0 = bflo(wc.x), x1 = bfhi(wc.x), x2 = bflo(wc.y), x3 = bfhi(wc.y);
            const float rs = rsqrtf(wave_sum(x0 * x0 + x1 * x1 + x2 * x2 + x3 * x3) * (1.f / 256) + EPS);
            const f32x4 g = *(const f32x4*)(cqn + 4 * lane);
            u32x2 o; o.x = cvt_pk_bf16(x0 * rs * g.x, x1 * rs * g.y); o.y = cvt_pk_bf16(x2 * rs * g.z, x3 * rs * g.w);
            *(u32x2*)(CQ + (size_t)r * 256 + 4 * lane) = o;
        }
    }
}
__device__ __forceinline__ void ph_prep2(const Params& p, int layer) {
    const int tid = otid(); const int lane = tid & 63, gw = obid() * 8 + (tid >> 6), NGW = gridDim.x * 8;
    const bf16_t* Z = (const bf16_t*)(p.ws + WS_G + G_Z); bf16_t* MLQ = (bf16_t*)(p.ws + WS_G + G_MLQ); const bf16_t* MLKV = (const bf16_t*)(p.ws + WS_G + G_MLKV); bf16_t* KF = (bf16_t*)(p.ws + WS_G + G_KF);
    const float* mlq = p.in[28] + layer * 192; const float* mlk = p.in[29] + layer * 192; const float* r64 = (const float*)(p.ws + WS_ROPE64);
    for (int r = gw; r < RB; r += NGW) {
        const bool lat = r >= CTX; const int t = r - CTX;
        bf16_t* q = MLQ + (size_t)r * 768; const bf16_t* kv = MLKV + (size_t)r * 1024; bf16_t* kf = KF + (size_t)r * 768;
        const unsigned krw = lane < 32 ? *(const unsigned*)(Z + (size_t)r * ZW + Z_KR + 2 * lane) : 0u;
        unsigned qn[4][1], qp[4][1], kn[4][1];
#pragma unroll
        for (int h = 0; h < 4; ++h) { seg_load<1>(q + h * 192, 128, lane, qn[h]); seg_load<1>(q + h * 192 + 128, 64, lane, qp[h]); seg_load<1>(kv + h * 256, 128, lane, kn[h]); }
#pragma unroll
        for (int h = 0; h < 4; ++h) {
            seg_fin<128, 1>(qn[h], q + h * 192, 128, mlq, false, 0, lane);
            seg_fin<64, 1>(qp[h], q + h * 192 + 128, 64, mlq + 128, lat, t, lane, r64);
            seg_fin<128, 1>(kn[h], kf + h * 192, 128, mlk, false, 0, lane);
            if (lane < 32) *(unsigned*)(kf + h * 192 + 128 + 2 * lane) = krw;
        }
    }
}
__device__ __forceinline__ void ph_subln(const Params& p, int layer) {
    const int tid = otid(); const int lane = tid & 63, gw = obid() * 8 + (tid >> 6), NGW = gridDim.x * 8;
    const bf16_t* A1 = (const bf16_t*)(p.ws + WS_G + G_A1); const bf16_t* A2 = (const bf16_t*)(p.ws + WS_G + G_A2); bf16_t* O = (bf16_t*)(p.ws + WS_G + G_BR);
    const float* lam = p.in[20] + layer * 256; const float* sub = p.in[21] + layer * 128;
    int lyr = layer; asm volatile("" : "+s"(lyr));
    const float lam_init = lyr == 0 ? 0.2f : 0.35550907f;
    const float l1 = wave_sum(lam[lane] * lam[64 + lane]), l2 = wave_sum(lam[128 + lane] * lam[192 + lane]);
    const float lam_full = expf(l1) - expf(l2) + lam_init;
    const float g0 = sub[2 * lane] * (1.f - lam_init), g1 = sub[2 * lane + 1] * (1.f - lam_init);
    for (int r = gw; r < RB; r += NGW) {
        unsigned w1[4], w2[4];
#pragma unroll
        for (int h = 0; h < 4; ++h) { const size_t off = (size_t)r * 512 + h * 128 + 2 * lane; w1[h] = *(const unsigned*)(A1 + off); w2[h] = *(const unsigned*)(A2 + off); }
#pragma unroll
        for (int h = 0; h < 4; ++h) {
            const size_t off = (size_t)r * 512 + h * 128 + 2 * lane;
            const float d0 = bflo(w1[h]) - lam_full * bflo(w2[h]), d1 = bfhi(w1[h]) - lam_full * bfhi(w2[h]);
            const float rs = rsqrtf(wave_sum(d0 * d0 + d1 * d1) * (1.f / 128) + EPS);
            *(unsigned*)(O + off) = cvt_pk_bf16(d0 * rs * g0, d1 * rs * g1);
        }
    }
}

__device__ __forceinline__ void attn_unit(const Params& p, int u, char* lds) {
    const bf16_t* Z = (const bf16_t*)(p.ws + WS_G + G_Z);
    int type, hd, qb;
    if (u < 128) { type = 0; hd = u >> 5; qb = 1 + (u & 31); }
    else if (u < 256) { type = 1; hd = (u - 128) >> 5; qb = 1 + (u & 31); }
    else if (u < 512) { type = 2; hd = (u - 256) >> 5; qb = 1 + (u & 31); }
    else { const int k = u - 512; qb = 0; if (k < 4) { type = 0; hd = k; } else if (k < 8) { type = 1; hd = k - 4; } else { type = 2; hd = k - 8; } }
    const int seq = qb == 0 ? CTX : RB; const size_t q0 = (size_t)qb * 256;
#ifndef ATT_TYPES
#define ATT_TYPES 7
#endif
    if (type == 0 && (ATT_TYPES & 1)) {
        const bf16_t* Q = (const bf16_t*)(p.ws + WS_G + G_MLQ) + q0 * 768 + hd * 192;
        const bf16_t* K = (const bf16_t*)(p.ws + WS_G + G_KF) + hd * 192;
        const bf16_t* V = (const bf16_t*)(p.ws + WS_G + G_MLKV) + hd * 256 + 128;
        bf16_t* O = (bf16_t*)(p.ws + WS_G + G_BR) + (size_t)2 * RB * 512 + q0 * 512 + hd * 128;
#ifndef ML_QL
#define ML_QL -1
#endif
#ifndef ATT_DMA
#define ATT_DMA 7
#endif
        if constexpr (ATT_DMA & 1) att::attn_body_dma<192, 768, 768, 1024, 512>(Q, K, V, O, seq, lds);
        else if constexpr (ML_QL < 0) att::attn_body_simple<192, 768, 768, 1024, 512>(Q, K, V, O, seq, lds);
        else att::attn_body<192, 768, 768, 1024, 512, (ML_QL < 0 ? 0 : ML_QL)>(Q, K, V, O, seq, lds);
    } else if (type == 1 && (ATT_TYPES & 2)) {
        const int kvh = hd >> 1;
        const bf16_t* Q = Z + q0 * ZW + Z_GQQ + hd * 128;
        const bf16_t* K = Z + Z_GQK + kvh * 128;
        const bf16_t* V = Z + Z_GQV + kvh * 128;
        bf16_t* O = (bf16_t*)(p.ws + WS_G + G_BR) + (size_t)1 * RB * 512 + q0 * 512 + hd * 128;
#ifndef GQ_SIMPLE
#define GQ_SIMPLE 1
#endif
        if constexpr (ATT_DMA & 2) att::attn_body_dma<128, ZW, ZW, ZW, 512>(Q, K, V, O, seq, lds);
        else if constexpr (GQ_SIMPLE) att::attn_body_simple<128, ZW, ZW, ZW, 512>(Q, K, V, O, seq, lds); else att::attn_body<128, ZW, ZW, ZW, 512>(Q, K, V, O, seq, lds);
    } else if (type == 2 && (ATT_TYPES & 4)) {
        const int h = hd >> 1, m = hd & 1;
        const bf16_t* Q = Z + q0 * ZW + Z_DAQ + h * 128 + m * 64;
        const bf16_t* K = Z + Z_DAK + h * 128 + m * 64;
        const bf16_t* V = Z + Z_DAV + h * 128;
        bf16_t* O = (bf16_t*)(p.ws + WS_G + (m == 0 ? G_A1 : G_A2)) + q0 * 512 + h * 128;
#ifndef DA_SIMPLE
#define DA_SIMPLE 0
#endif
        if constexpr (ATT_DMA & 4) att::attn_body_dma<64, ZW, ZW, ZW, 512>(Q, K, V, O, seq, lds);
        else if constexpr (DA_SIMPLE) att::attn_body_simple<64, ZW, ZW, ZW, 512>(Q, K, V, O, seq, lds); else att::attn_body<64, ZW, ZW, ZW, 512>(Q, K, V, O, seq, lds);
    }
}
#ifndef ATT_REP_TYPES
#define ATT_REP_TYPES 7
#endif
__device__ __forceinline__ void ph_attn(const Params& p, char* lds, int last, int tmask = 7) {
    const int G = gridDim.x, c = obid();
    for (int i = 0; i < 3; ++i) {
        int u;
        const int xcd = c & 7, jq = c >> 3;
        if (G == 256) u = i == 0 ? (xcd < 4 ? xcd * 32 + jq : 128 + (xcd - 4) * 32 + jq) : (i == 1 ? 256 + xcd * 32 + jq : ((c >= 128 && c < 144 && !last) ? 512 + (c - 128) : -1));
        else u = -1;
        if (u >= 0) { const int ty = u < 128 ? 1 : (u < 256 ? 2 : (u < 512 ? 4 : 7)); if (ty & tmask) attn_unit(p, u, lds); }
    }
    if (G != 256) for (int u = c; u < (last ? 512 : 528); u += G) attn_unit(p, u, lds);
}


#define XB_TMO      128
#define XB_XCNT(j)  (256  + 64 * (j))
#define XB_XSUB(j)  (1280 + 64 * (j))
#define XB_XGEN(j)  (2304 + 64 * (j))
#define XB_TOP      3328
#define XB_TOPGEN   3392
#define XCD_BAR_WORDS 3456
#define XB_SPIN_CAP (1u << 23)
__device__ __forceinline__ unsigned xb_ld(unsigned* p)              { return __hip_atomic_load(p, __ATOMIC_RELAXED, __HIP_MEMORY_SCOPE_AGENT); }
__device__ __forceinline__ unsigned xb_add(unsigned* p, unsigned v) { return __hip_atomic_fetch_add(p, v, __ATOMIC_RELAXED, __HIP_MEMORY_SCOPE_AGENT); }
__device__ __forceinline__ unsigned xb_xcc_id() { return (unsigned)__builtin_amdgcn_s_getreg((3 << 11) | 20) & 0xFu; }
#define XB_SPIN(cond, bar) do { unsigned _sp = 0; while (cond) { __builtin_amdgcn_s_sleep(1); \
    if ((++_sp & 255u) == 0u) { if (xb_ld(&(bar)[XB_TMO])) break; if (_sp > XB_SPIN_CAP) { atomicAdd(&(bar)[XB_TMO], 1u); break; } } } } while (0)
struct XcdBarrier { unsigned* bar; unsigned x; volatile LAS unsigned* st; };
__device__ __forceinline__ void xcd_barrier_complete(unsigned* bar, unsigned x, unsigned& nloc, unsigned& nx) {
    const unsigned G = gridDim.x * gridDim.y * gridDim.z;
    unsigned sum, cnt, mine, sp = 0u;
    for (;;) {
        sum = 0u; cnt = 0u; mine = 0u;
#pragma unroll
        for (unsigned j = 0; j < 16; ++j) { const unsigned c = xb_ld(&bar[XB_XCNT(j)]); sum += c; cnt += (c > 0u) ? 1u : 0u; mine = (j == x) ? c : mine; }
        if (sum == G) break;
        __builtin_amdgcn_s_sleep(1);
        if ((++sp & 255u) == 0u) { if (xb_ld(&bar[XB_TMO])) break; if (sp > XB_SPIN_CAP) { atomicAdd(&bar[XB_TMO], 1u); break; } }
    }
    nloc = mine > 0u ? mine : 1u; nx = cnt > 0u ? cnt : 1u;
}
__device__ __forceinline__ void xcd_barrier(const XcdBarrier& b) {
    asm volatile("s_waitcnt vmcnt(0)" ::: "memory");
    __syncthreads();
    if (otid() == 0) {
        unsigned* bar = b.bar;
        __builtin_amdgcn_s_waitcnt(0);
        unsigned nloc = b.st[0], nx = b.st[1];
        if (nloc == 0u) { xcd_barrier_complete(bar, b.x, nloc, nx); b.st[0] = nloc; b.st[1] = nx; }
        const unsigned old = xb_add(&bar[XB_XSUB(b.x)], 1u);
        const unsigned gen = old / nloc;
        if (old + 1u == (gen + 1u) * nloc) {
            __builtin_amdgcn_fence(__ATOMIC_RELEASE, "agent");
            asm volatile("s_waitcnt vmcnt(0)" ::: "memory");
            const unsigned og = xb_add(&bar[XB_TOP], 1u);
            const unsigned tg = og / nx;
            if (og + 1u == (tg + 1u) * nx) xb_add(&bar[XB_TOPGEN], 1u);
            else XB_SPIN(xb_ld(&bar[XB_TOPGEN]) == tg, bar);
            __builtin_amdgcn_fence(__ATOMIC_ACQUIRE, "agent");
            xb_add(&bar[XB_XGEN(b.x)], 1u);
            asm volatile("s_waitcnt vmcnt(0)" ::: "memory");
        } else {
            XB_SPIN(xb_ld(&bar[XB_XGEN(b.x)]) == gen, bar);
            __builtin_amdgcn_fence(__ATOMIC_ACQUIRE, "agent");
            asm volatile("s_waitcnt vmcnt(0)" ::: "memory");
        }
    }
    __syncthreads();
}

__global__ void __launch_bounds__(512, 2) mk_fwd(Params p0) {
    extern __shared__ __attribute__((aligned(16))) unsigned char lds_raw[];
    LAS unsigned char* lds = (LAS unsigned char*)lds_raw;
    cg::grid_group grid = cg::this_grid();
#define GSYNC() do { if (hi < 0) { asm volatile("s_waitcnt vmcnt(0) lgkmcnt(0)" ::: "memory"); grid.sync(); }     \
    else { XcdBarrier xb_; xb_.bar = (unsigned*)(load_params().ws + WS_BAR); xb_.x = xb_xcc_id(); xb_.st = (volatile LAS unsigned*)(lds + 131072 + 64); xcd_barrier(xb_); } } while (0)
    if (threadIdx.x == 0) { volatile LAS unsigned* st_ = (volatile LAS unsigned*)(lds + 131072 + 64); st_[0] = 0u; st_[1] = 0u;
        (void)xb_add(&((unsigned*)(p0.ws + WS_BAR))[XB_XCNT(xb_xcc_id())], 1u); }
    __syncthreads();
    const int lo = p0.lo, hi = p0.hi; int ph = 0; int layer = 0;
#ifndef PHASE_MASK
#define PHASE_MASK 0xFFFF
#endif
#ifndef REPEAT_MASK
#define REPEAT_MASK 0
#endif
#define PH_BEGIN(cat) if (ph >= lo && ph < hi) { constexpr int cat_ = (cat); (void)cat_; DIAG_T0(cat) if constexpr ((PHASE_MASK >> (cat)) & 1) for (int rep_ = 0; rep_ < (((REPEAT_MASK >> (cat)) & 1) ? 2 : 1); ++rep_) { if (rep_) GSYNC(); const Params p = load_params(); \
    unsigned char* ws = p.ws; float* MOD = (float*)(ws + WS_MOD); float* ctxb = (float*)(ws + WS_CTXB); bf16_t* H = (bf16_t*)(ws + WS_H); bf16_t* ABR = (bf16_t*)(ws + WS_ABR); \
    const bf16_t* Wl = (const bf16_t*)(ws + WS_W + layer * W_LAYER_B); const float* modl = MOD + (size_t)layer * 5 * MODW; \
    const float* xl_in = layer == 0 ? p.in[0] : p.out; const float* xc_in = layer == 0 ? p.in[2] : ctxb; \
    int lastl = layer; asm volatile("" : "+s"(lastl)); lastl = (lastl == 1) ? 1 : 0; \
    (void)MOD; (void)ctxb; (void)H; (void)ABR; (void)Wl; (void)modl; (void)xl_in; (void)xc_in; (void)lastl;
#if defined(DIAG_A_MASK)
#define DIAG_T0(cat) if (blockIdx.x == 0 && threadIdx.x == 0) { ((LAS unsigned long long*)(lds + LDS_BYTES - 64))[2] = __builtin_amdgcn_s_memrealtime(); }
#define DIAG_T1(cat) if (blockIdx.x == 0 && threadIdx.x == 0) { LAS unsigned long long* ta_ = (LAS unsigned long long*)(lds + LDS_BYTES - 64); const unsigned long long dt_ = __builtin_amdgcn_s_memrealtime() - ta_[2]; \
    if ((DIAG_A_MASK >> (cat)) & 1) ta_[0] += dt_; if ((DIAG_B_MASK >> (cat)) & 1) ta_[1] += dt_; }
#else
#define DIAG_T0(cat)
#define DIAG_T1(cat)
#endif
#define PH_END   } if (ph + 1 < hi) GSYNC(); DIAG_T1(cat_) } ++ph;
    const int G = gridDim.x, c = blockIdx.x;
#if defined(DIAG_A_MASK)
    if (threadIdx.x == 0) { LAS unsigned long long* ta_ = (LAS unsigned long long*)(lds + LDS_BYTES - 64); ta_[0] = 0; ta_[1] = 0; }
#endif

#if defined(EXTRA_SYNCS)
    for (int es = 0; es < EXTRA_SYNCS; ++es) GSYNC();
#endif
    PH_BEGIN(0) ph_prologue(p, lds); PH_END

    for (layer = 0; layer < 2; ++layer) {

        PH_BEGIN(1) ph_norm_mod(xl_in, xc_in, p.in[6] + layer * DM, modl, 0, H); PH_END

        PH_BEGIN(2) {
            pg8::Gemm g{H, Wl + W_IN, MTOT, 512, 1024}; pg8::StaticOrder S; S.init(MTOT, 512, G, c);
            pg8::Epi<pg8::E_STORE> E{}; E.a.O = (bf16_t*)(ws + WS_G + S_U); E.a.ldc = 512;
            pg8::gemm_phase(lds, g, S, E);
            { pg8::Gemm g2{H, Wl + W_IN + (size_t)512 * 1024, RB, ZW, 1024}; pg8::StaticOrder S2; S2.init(RB, ZW, G, (c + 160) % G);
              pg8::Epi<pg8::E_INPROJ> E2{}; E2.a.O = (bf16_t*)(ws + WS_G + G_Z); E2.a.ldc = ZW;
              pg8::gemm_phase(lds, g2, S2, E2); }
        } PH_END

        PH_BEGIN(3) { for (int u = c; u < 256; u += G) s5_chain(p, layer, u, lds); } PH_END

        PH_BEGIN(4) ph_s5_gelu(p, layer); PH_END

        PH_BEGIN(9) {
            pg8::Gemm g{(const bf16_t*)(ws + WS_G + S_U), Wl + W_GLU, MTOT, 512, 512}; pg8::StaticOrder S; S.init(MTOT, 512, G, c);
            pg8::Epi<pg8::E_GLU> E{}; E.a.O = ABR; E.a.ldc = 512; E.a.G = (const bf16_t*)(ws + WS_G + S_U); E.a.ldg = 512; E.a.bias = p.in[17] + layer * 512;
            pg8::gemm_phase(lds, g, S, E);
            ph_prep1(p, layer);
        } PH_END

        for (int gb = 0; gb < NB; ++gb) {
            const size_t grow0 = (size_t)gb * RB;
            if (gb > 0) {
            PH_BEGIN(10) {
                pg8::Gemm g{H + grow0 * DM, Wl + W_IN + (size_t)512 * 1024, RB, ZW, 1024}; pg8::StaticOrder S; S.init(RB, ZW, G, c);
                pg8::Epi<pg8::E_INPROJ> E{}; E.a.O = (bf16_t*)(ws + WS_G + G_Z); E.a.ldc = ZW;
                pg8::gemm_phase(lds, g, S, E);
            } PH_END

            PH_BEGIN(5) ph_prep1(p, layer); PH_END
            }

            PH_BEGIN(11) {
                { pg8::Gemm g{(const bf16_t*)(ws + WS_G + G_CQ), Wl + W_UQ, RB, 768, 256}; pg8::StaticOrder S; S.init(RB, 768, G, c);
                  pg8::Epi<pg8::E_STORE> E{}; E.a.O = (bf16_t*)(ws + WS_G + G_MLQ); E.a.ldc = 768;
                  pg8::gemm_phase(lds, g, S, E); }
                { pg8::Gemm g{(const bf16_t*)(ws + WS_G + G_CKV), Wl + W_UKV, RB, 1024, 128}; pg8::StaticOrder S; S.init(RB, 1024, G, (c + 128) % G);
                  pg8::Epi<pg8::E_STORE> E{}; E.a.O = (bf16_t*)(ws + WS_G + G_MLKV); E.a.ldc = 1024;
                  pg8::gemm_phase(lds, g, S, E); }
            } PH_END

            PH_BEGIN(6) ph_prep2(p, layer); PH_END

            PH_BEGIN(7) ph_attn(p, (char*)lds_raw, lastl, rep_ ? ATT_REP_TYPES : 7); PH_END

            PH_BEGIN(8) ph_subln(p, layer); PH_END

            PH_BEGIN(12) {
                const int vpm0 = gb * TPB, vpm1 = (int)((WS_G + G_BR - WS_ABR) / 262144);
                pg8::Gemm g{ABR, Wl + W_BR, RB, 1024, 512}; pg8::MergeOrder S{G, c, vpm0, vpm1, lastl};
                pg8::Epi<pg8::E_MERGE> E{}; E.a.O = H + grow0 * DM; E.a.ldc = DM; E.a.G = (const bf16_t*)(ws + WS_G + G_Z) + Z_GATE; E.a.ldg = ZW;
                E.a.MF = (float*)(ws + WS_G + G_MF); E.a.vpm0 = vpm0; E.a.vpm1 = vpm1;
                pg8::gemm_phase(lds, g, S, E);
            } PH_END
        }

        PH_BEGIN(13) {
            pg8::Gemm g{H, Wl + W_OUT, MTOT, 1024, 1024}; pg8::StaticOrder S; S.init(MTOT, 1024, G, c, lastl);
            pg8::Epi<pg8::E_RESID> E{}; E.a.xin_l = xl_in; E.a.xin_c = xc_in; E.a.xout_l = p.out; E.a.xout_c = ctxb; E.a.gate = modl + 2 * 1024;
            pg8::gemm_phase(lds, g, S, E);
        } PH_END

        PH_BEGIN(1) ph_norm_mod(p.out, ctxb, p.in[32] + layer * DM, modl, 3, H); PH_END

        PH_BEGIN(14) {
            pg8::Gemm g{H, Wl + W_FI, MTOT, 2 * DFF, 1024}; pg8::StaticOrder S; S.init(MTOT, 2 * DFF, G, c, lastl);
            pg8::Epi<pg8::E_SWIGLU> E{}; E.a.O = (bf16_t*)(ws + WS_G); E.a.ldc = DFF;
            pg8::gemm_phase(lds, g, S, E);
        } PH_END

        PH_BEGIN(15) {
            pg8::Gemm g{(const bf16_t*)(ws + WS_G), Wl + W_FO, MTOT, 1024, DFF}; pg8::StaticOrder S; S.init(MTOT, 1024, G, c, lastl);
            pg8::Epi<pg8::E_RESID> E{}; E.a.xin_l = p.out; E.a.xin_c = ctxb; E.a.xout_l = p.out; E.a.xout_c = ctxb; E.a.gate = modl + 5 * 1024;
            pg8::gemm_phase(lds, g, S, E);
        } PH_END
    }
#if defined(DIAG_A_MASK)
    GSYNC();
    if (blockIdx.x == 0) { LAS unsigned long long* ta_ = (LAS unsigned long long*)(lds + LDS_BYTES - 64);
        const float A = (float)ta_[0] * 0.01f, B = (float)ta_[1] * 0.01f;
        if (threadIdx.x == 0) p0.out[0] = A; else p0.out[threadIdx.x] = B; if (threadIdx.x > 0) p0.out[threadIdx.x + 511] = B; }
#endif
#undef PH_BEGIN
#undef PH_END
}
constexpr int N_PHASES = 1 + 2 * (5 + 4 * 7 + 4 - 2);

extern "C" void kernel_launch(void* const* d_in, const int* in_sizes, int n_in, void* d_out, int out_size, void* d_ws, size_t ws_size, hipStream_t stream) {
    static int grid = 0;
    if (grid == 0) {
        if (n_in != 35 || out_size != NB * SEQ * DM || ws_size < WS_END) { fprintf(stderr, "kernel_launch: bad shapes: n_in %d out %d ws %zu (need %zu)\n", n_in, out_size, ws_size, (size_t)WS_END); grid = -1; return; }
        int dev = 0, cus = 0, per_cu = 0;
        (void)hipGetDevice(&dev); (void)hipDeviceGetAttribute(&cus, hipDeviceAttributeMultiprocessorCount, dev);
        if (hipFuncSetAttribute((const void*)mk_fwd, hipFuncAttributeMaxDynamicSharedMemorySize, LDS_BYTES) != hipSuccess) { fprintf(stderr, "kernel_launch: hipFuncSetAttribute failed\n"); grid = -1; return; }
        (void)hipOccupancyMaxActiveBlocksPerMultiprocessor(&per_cu, (const void*)mk_fwd, 512, LDS_BYTES);
        (void)hipGetLastError();
        if (per_cu < 1) per_cu = 1;
        grid = cus;
    }
    if (grid < 0) return;
    if (hipMemsetAsync((char*)d_ws + WS_BAR, 0, 16384, stream) != hipSuccess) { fprintf(stderr, "kernel_launch: memset failed\n"); return; }
    Params p{};
    for (int i = 0; i < 35; ++i) p.in[i] = (const float*)d_in[i];
    p.out = (float*)d_out; p.ws = (unsigned char*)d_ws;
#if MK_MODE == 0
    p.lo = 0; p.hi = N_PHASES;
    void* args[] = {&p};
    hipError_t e = hipLaunchCooperativeKernel((const void*)mk_fwd, dim3(grid), dim3(512), args, LDS_BYTES, stream);
    if (e != hipSuccess) fprintf(stderr, "cooperative launch failed: %s (grid %d)\n", hipGetErrorString(e), grid);
#else
    for (int ph = 0; ph < N_PHASES; ++ph) {
        p.lo = ph; p.hi = ph + 1;
        hipLaunchKernelGGL(mk_fwd, dim3(grid), dim3(512), LDS_BYTES, stream, p);
    }
#endif
}
```

```cpp
#include <hip/hip_runtime.h>
#include <hip/hip_cooperative_groups.h>
#include <cstdio>
#include <cstdint>
namespace cg = cooperative_groups;

#ifndef MK_MODE
#define MK_MODE 0
#endif

#define LAS __attribute__((address_space(3)))
typedef unsigned short bf16_t;
typedef short bf16x8 __attribute__((ext_vector_type(8)));
typedef short s16x4 __attribute__((ext_vector_type(4)));
typedef float f32x4 __attribute__((ext_vector_type(4)));
typedef float f32x16 __attribute__((ext_vector_type(16)));
typedef unsigned u32x4 __attribute__((ext_vector_type(4)));
typedef unsigned u32x2 __attribute__((ext_vector_type(2)));

constexpr int DM = 1024, NB = 4, SEQ = 8192, CTX = 256, RB = SEQ + CTX  , MTOT = NB * RB  ;
constexpr int TPB = RB / 256;
constexpr int ZW = 7168;
constexpr int Z_DAQ = 0, Z_DAK = 512, Z_DAV = 1024, Z_GQQ = 1536, Z_GQK = 2048, Z_GQV = 2304, Z_CQ = 2560, Z_CKV = 2816, Z_KR = 2944, Z_GATE = 3072;
constexpr int DFF = 2816, MODW = 6144;
constexpr float EPS = 1e-6f;

constexpr size_t MiB = 1u << 20;
constexpr size_t al(size_t x) { return (x + MiB - 1) / MiB * MiB; }
constexpr size_t WS_MOD = 0;
constexpr size_t WS_ROPE64 = 256 * 1024, WS_ROPE128 = WS_ROPE64 + 128 * 16 * 8;
constexpr size_t WS_BAR = 512 * 1024;
constexpr size_t WS_CTXB = al(WS_MOD + 2 * 5 * MODW * 4);
constexpr size_t WS_W = WS_CTXB + 4 * MiB;
constexpr size_t W_IN = 0, W_UQ = W_IN + (size_t)7680 * 1024, W_UKV = W_UQ + 768 * 256, W_GLU = W_UKV + 1024 * 128, W_BR = W_GLU + 512 * 512,
                 W_OUT = W_BR + (size_t)4 * 1024 * 512, W_FI = W_OUT + (size_t)1024 * 1024, W_FO = W_FI + (size_t)5632 * 1024, W_LAYER = W_FO + (size_t)1024 * 2816;
constexpr size_t W_LAYER_B = al(W_LAYER * 2);
constexpr size_t WS_H = WS_W + 2 * W_LAYER_B;
constexpr size_t WS_ABR = WS_H + al((size_t)MTOT * 1024 * 2);
constexpr size_t WS_G = WS_ABR + al((size_t)MTOT * 512 * 2);
constexpr size_t G_Z = 0;
constexpr size_t G_CQ = al(G_Z + (size_t)RB * ZW * 2);
constexpr size_t G_CKV = al(G_CQ + (size_t)RB * 256 * 2);
constexpr size_t G_MLQ = al(G_CKV + (size_t)RB * 128 * 2);
constexpr size_t G_MLKV = al(G_MLQ + (size_t)RB * 768 * 2);
constexpr size_t G_KF = al(G_MLKV + (size_t)RB * 1024 * 2);
constexpr size_t G_A1 = al(G_KF + (size_t)RB * 768 * 2);
constexpr size_t G_A2 = al(G_A1 + (size_t)RB * 512 * 2);
constexpr size_t G_BR = al(G_A2 + (size_t)RB * 512 * 2);
constexpr size_t G_MF = al(G_BR + (size_t)3 * RB * 512 * 2);
constexpr size_t G_END = al(G_MF + (size_t)RB * 1024 * 4);
constexpr size_t S_SZ = al((size_t)MTOT * 512 * 2), S_U = G_MLQ  , S_YF = S_U + S_SZ, S_YR = S_YF + S_SZ, S_END = S_YR + S_SZ;
constexpr size_t HID_B = (size_t)MTOT * DFF * 2;
static_assert(S_END <= G_END && HID_B <= G_END, "aliases fit");
constexpr size_t WS_END = WS_G + G_END;
static_assert(WS_END <= (size_t)512 * MiB, "workspace budget");
static_assert((WS_G + G_BR - WS_ABR) % 262144 == 0, "merge virtual tiles");

constexpr int LDS_BYTES = 147456;

typedef __bf16 bf16x2n __attribute__((ext_vector_type(2)));
typedef float f32x2n __attribute__((ext_vector_type(2)));
__device__ __forceinline__ unsigned cvt_pk_bf16(float lo, float hi) { f32x2n v = {lo, hi}; bf16x2n b = __builtin_convertvector(v, bf16x2n); return __builtin_bit_cast(unsigned, b); }
__device__ __forceinline__ float bf2f(unsigned v) { return __uint_as_float(v << 16); }
__device__ __forceinline__ float bflo(unsigned w) { return __uint_as_float(w << 16); }
__device__ __forceinline__ float bfhi(unsigned w) { return __uint_as_float(w & 0xffff0000u); }
__device__ __forceinline__ bf16_t f2bf(float f) { return (bf16_t)(cvt_pk_bf16(f, 0.f) & 0xffffu); }
template <int O> __device__ __forceinline__ float swz_xor(float v) { return __int_as_float(__builtin_amdgcn_ds_swizzle(__float_as_int(v), 0x1f | (O << 10))); }
__device__ __forceinline__ float half_sum(float v) {
    v += swz_xor<1>(v); v += swz_xor<2>(v); v += swz_xor<4>(v); v += swz_xor<8>(v); v += swz_xor<16>(v); return v;
}
__device__ __forceinline__ float wave_sum(float v) {
    v = half_sum(v);
    auto rr = __builtin_amdgcn_permlane32_swap(__float_as_uint(v), __float_as_uint(v), false, false);
    return __uint_as_float(rr[0]) + __uint_as_float(rr[1]);
}
__device__ __forceinline__ int otid() { int t = threadIdx.x; asm volatile("" : "+v"(t)); return t; }
__device__ __forceinline__ float sigmoidf_(float x) { return __builtin_amdgcn_rcpf(1.f + __expf(-x)); }

__device__ __forceinline__ int obid() { int b = blockIdx.x; asm volatile("" : "+s"(b)); return b; }
struct Params { const float* in[35]; float* out; unsigned char* ws; int lo, hi; };
__device__ __forceinline__ Params load_params() {
#if defined(__HIP_DEVICE_COMPILE__)
    typedef const __attribute__((address_space(4))) Params* CP;
    CP q = (CP)__builtin_amdgcn_kernarg_segment_ptr(); asm volatile("" : "+s"(q));
    Params r;
#pragma unroll
    for (int i = 0; i < 35; ++i) r.in[i] = q->in[i];
    r.out = q->out; r.ws = q->ws; r.lo = q->lo; r.hi = q->hi; return r;
#else
    return Params{};
#endif
}

namespace pg8 {
constexpr int BM = 256, BK = 64, HALF = 128, HTB = HALF * BK * 2, STAGE_BYTES = 8 * HTB, NXCD = 8, WGM = 8;
__host__ __device__ __forceinline__ int lds_byte(int r, int c) { const int st = (r >> 4) * 2 + (c >> 5), rr = r & 15, cc = c & 31, ob = rr * 64 + cc * 2; return st * 1024 + (ob ^ (((ob >> 9) & 1) << 5)); }
__host__ __device__ __forceinline__ void stage_rc(int b, int& R, int& C) { const int st = b / 1024, sb = b % 1024, swz = sb ^ (((sb >> 9) & 1) << 5); R = (st >> 1) * 16 + swz / 64; C = (st & 1) * 32 + (swz % 64) / 2; }
__host__ __device__ __forceinline__ int perm32(int rho) { const int n = rho >> 4, i = rho & 15; return 8 * (i >> 2) + 4 * n + (i & 3); }
struct Unit { int pm, pn; };
struct Gemm { const bf16_t* A; const bf16_t* Bt; int M, N, K; };
struct StaticOrder {
    int nM, nN, nwg, G, c;
    int skip;
    __device__ void init(int M, int N, int G_, int c_, int skip_ = 0) { skip = skip_; nM = skip_ ? NB * (TPB - 1) : M / BM; nN = N / BM; nwg = nM * nN; G = G_; c = c_; }
    __device__ bool next(int i, Unit& u) const {
        const long L = (long)i * G + c; if (L >= nwg) return false;
        int wgid = (int)L; { const int q = nwg / NXCD, r = nwg % NXCD, xcd = wgid % NXCD, off = wgid / NXCD; wgid = (xcd < r ? xcd * (q + 1) : r * (q + 1) + (xcd - r) * q) + off; }
        const int nig = WGM * nN, gid = wgid / nig, fm = gid * WGM, gsz = (nM - fm) < WGM ? (nM - fm) : WGM;
        u.pm = fm + ((wgid % nig) % gsz); u.pn = (wgid % nig) / gsz; if (skip) u.pm += u.pm / (TPB - 1) + 1; return true;
    }
};
struct MergeOrder {
    int G, c, vpm0, vpm1, skip;
    __device__ bool next(int i, Unit& u) const {
        const int j = i >> 2, n = i & 3; const int L = j * G + c; if (L >= (TPB - skip) * 4) return false;
        const int pm = (L >> 2) + skip, pn = L & 3; u.pm = (n == 0 ? vpm0 : vpm1 + (n - 1) * TPB) + pm; u.pn = n * 4 + pn; return true;
    }
};

enum { E_STORE = 0, E_INPROJ = 1, E_GLU = 2, E_MERGE = 3, E_RESID = 4, E_SWIGLU = 5 };
struct EpiArgs {
    bf16_t* O; int ldc;
    const bf16_t* G; int ldg;
    const float* bias;
    float* MF;
    int vpm0, vpm1;
    const float* xin_l; const float* xin_c; float* xout_l; float* xout_c; const float* gate;
};
template <int MODE> struct Epi {
    EpiArgs a;
    __device__ __forceinline__ void operator()(const f32x4 (&acc)[2][2][4][2], const Unit& u, int, int, int, int) const {
        const int t_ = otid(), wid_ = __builtin_amdgcn_readfirstlane(t_ >> 6), wr = wid_ >> 2, wc = wid_ & 3, fr = t_ & 15, fq = (t_ & 63) >> 4;
        int pm = u.pm, pn = u.pn, nbr = 0;
        if (MODE == E_MERGE) { nbr = u.pn >> 2; pn = u.pn & 3; pm = u.pm - (nbr == 0 ? a.vpm0 : a.vpm1 + (nbr - 1) * TPB); }
        const int row0 = pm * BM + wr * 64 + fr;
        const int col0 = (MODE == E_SWIGLU ? pn * 128 : pn * BM) + wc * 32 + 8 * fq;
        const float* xin = nullptr; float* xout = nullptr; const float* gv = nullptr;
        if (MODE == E_RESID) {
            const int b = pm / TPB, t = pm - b * TPB;
            if (t == 0) { xin = a.xin_c + (size_t)b * CTX * DM; xout = a.xout_c + (size_t)b * CTX * DM; gv = a.gate + 4 * MODW; }
            else { xin = a.xin_l + ((size_t)b * SEQ + (size_t)(t - 1) * 256) * DM; xout = a.xout_l + ((size_t)b * SEQ + (size_t)(t - 1) * 256) * DM; gv = a.gate + b * MODW; }
        }
        if (MODE == E_SWIGLU || MODE == E_STORE || MODE == E_INPROJ) {
#pragma unroll
            for (int ai = 0; ai < 2; ++ai)
#pragma unroll
                for (int m = 0; m < 4; ++m) {
                    const int row = row0 + ai * HALF + m * 16;
                    if (MODE == E_SWIGLU) {
                        const f32x4 g0 = acc[ai][0][m][0], g1 = acc[ai][0][m][1], u0 = acc[ai][1][m][0], u1 = acc[ai][1][m][1];
                        float h[8];
#pragma unroll
                        for (int e = 0; e < 4; ++e) { h[e] = g0[e] * sigmoidf_(g0[e]) * u0[e]; h[4 + e] = g1[e] * sigmoidf_(g1[e]) * u1[e]; }
                        u32x4 w; w.x = cvt_pk_bf16(h[0], h[1]); w.y = cvt_pk_bf16(h[2], h[3]); w.z = cvt_pk_bf16(h[4], h[5]); w.w = cvt_pk_bf16(h[6], h[7]);
                        *(u32x4*)(a.O + (size_t)row * a.ldc + col0) = w;
                        continue;
                    }
#pragma unroll
                    for (int bj = 0; bj < 2; ++bj) {
                        const int col = col0 + bj * HALF;
                        f32x4 v0 = acc[ai][bj][m][0], v1 = acc[ai][bj][m][1];
                        if (MODE == E_INPROJ && pn >= 12) {
#pragma unroll
                            for (int e = 0; e < 4; ++e) { v0[e] = sigmoidf_(v0[e]); v1[e] = sigmoidf_(v1[e]); }
                        }
                        u32x4 w; w.x = cvt_pk_bf16(v0[0], v0[1]); w.y = cvt_pk_bf16(v0[2], v0[3]); w.z = cvt_pk_bf16(v1[0], v1[1]); w.w = cvt_pk_bf16(v1[2], v1[3]);
                        *(u32x4*)(a.O + (size_t)row * a.ldc + col) = w;
                    }
                }
            return;
        }
        f32x4 gb0[2], gb1[2];
#pragma unroll
        for (int bj = 0; bj < 2; ++bj) {
            const int col = col0 + bj * HALF;
            if (MODE == E_GLU) { gb0[bj] = *(const f32x4*)(a.bias + col); gb1[bj] = *(const f32x4*)(a.bias + col + 4); }
            else if (MODE == E_RESID) { gb0[bj] = *(const f32x4*)(gv + col); gb1[bj] = *(const f32x4*)(gv + col + 4); }
            else { gb0[bj] = (f32x4){0.f, 0.f, 0.f, 0.f}; gb1[bj] = gb0[bj]; }
        }
#pragma unroll
        for (int ai = 0; ai < 2; ++ai)
#pragma unroll
            for (int mp = 0; mp < 2; ++mp) {
                u32x4 gw[2][2]; f32x4 xa[2][2], xb[2][2];
#pragma unroll
                for (int mm = 0; mm < 2; ++mm)
#pragma unroll
                    for (int bj = 0; bj < 2; ++bj) {
                        const int row = row0 + ai * HALF + (mp * 2 + mm) * 16, col = col0 + bj * HALF;
                        if (MODE == E_GLU) gw[mm][bj] = *(const u32x4*)(a.G + (size_t)row * a.ldg + col);
                        if (MODE == E_MERGE) { gw[mm][bj] = *(const u32x4*)(a.G + (size_t)row * a.ldg + nbr * 1024 + col);
                            if (nbr != 0) { const u32x4 mw = *(const u32x4*)((const bf16_t*)a.MF + (size_t)row * 1024 + col);
                                xa[mm][bj] = (f32x4){bflo(mw.x), bfhi(mw.x), bflo(mw.y), bfhi(mw.y)}; xb[mm][bj] = (f32x4){bflo(mw.z), bfhi(mw.z), bflo(mw.w), bfhi(mw.w)}; } }
                        if (MODE == E_RESID) { const int lr = row - pm * BM; xa[mm][bj] = *(const f32x4*)(xin + (size_t)lr * DM + col); xb[mm][bj] = *(const f32x4*)(xin + (size_t)lr * DM + col + 4); }
                    }
#pragma unroll
                for (int mm = 0; mm < 2; ++mm)
#pragma unroll
                    for (int bj = 0; bj < 2; ++bj) {
                        const int m = mp * 2 + mm; const int row = row0 + ai * HALF + m * 16, col = col0 + bj * HALF;
                        const f32x4 v0 = acc[ai][bj][m][0], v1 = acc[ai][bj][m][1];
                        if (MODE == E_GLU) {
                            const u32x4 g = gw[mm][bj]; const f32x4 b0 = gb0[bj], b1 = gb1[bj];
                            float o[8];
                            o[0] = bflo(g.x) * sigmoidf_(v0[0] + b0[0]); o[1] = bfhi(g.x) * sigmoidf_(v0[1] + b0[1]);
                            o[2] = bflo(g.y) * sigmoidf_(v0[2] + b0[2]); o[3] = bfhi(g.y) * sigmoidf_(v0[3] + b0[3]);
                            o[4] = bflo(g.z) * sigmoidf_(v1[0] + b1[0]); o[5] = bfhi(g.z) * sigmoidf_(v1[1] + b1[1]);
                            o[6] = bflo(g.w) * sigmoidf_(v1[2] + b1[2]); o[7] = bfhi(g.w) * sigmoidf_(v1[3] + b1[3]);
                            u32x4 w; w.x = cvt_pk_bf16(o[0], o[1]); w.y = cvt_pk_bf16(o[2], o[3]); w.z = cvt_pk_bf16(o[4], o[5]); w.w = cvt_pk_bf16(o[6], o[7]);
                            *(u32x4*)(a.O + (size_t)row * a.ldc + col) = w;
                        } else if (MODE == E_MERGE) {
                            const u32x4 g = gw[mm][bj];
                            f32x4 p0, p1;
                            p0[0] = bflo(g.x) * v0[0]; p0[1] = bfhi(g.x) * v0[1]; p0[2] = bflo(g.y) * v0[2]; p0[3] = bfhi(g.y) * v0[3];
                            p1[0] = bflo(g.z) * v1[0]; p1[1] = bfhi(g.z) * v1[1]; p1[2] = bflo(g.w) * v1[2]; p1[3] = bfhi(g.w) * v1[3];
                            if (nbr != 0) { p0 = p0 + xa[mm][bj]; p1 = p1 + xb[mm][bj]; }
                            u32x4 w; w.x = cvt_pk_bf16(p0[0], p0[1]); w.y = cvt_pk_bf16(p0[2], p0[3]); w.z = cvt_pk_bf16(p1[0], p1[1]); w.w = cvt_pk_bf16(p1[2], p1[3]);
                            if (nbr != 3) *(u32x4*)((bf16_t*)a.MF + (size_t)row * 1024 + col) = w;
                            else *(u32x4*)(a.O + (size_t)row * a.ldc + col) = w;
                        } else if (MODE == E_RESID) {
                            const int lr = row - pm * BM;
                            *(f32x4*)(xout + (size_t)lr * DM + col) = xa[mm][bj] + gb0[bj] * v0;
                            *(f32x4*)(xout + (size_t)lr * DM + col + 4) = xb[mm][bj] + gb1[bj] * v1;
                        }
                    }
            }
    }
};

template <class EpiT, class Sched>
__device__ __forceinline__ void gemm_phase(LAS unsigned char* lds, const Gemm g, const Sched& S, const EpiT& E) {
    int tid_ = threadIdx.x; asm volatile("" : "+v"(tid_));
    const int tid = tid_, wid = __builtin_amdgcn_readfirstlane(tid >> 6), lane = tid & 63, wr = wid >> 2, wc = wid & 3, fr = lane & 15, fq = lane >> 4;
    const int K = g.K, nt = K / BK;
    unsigned voffA[2], voffB[2];
#pragma unroll
    for (int i = 0; i < 2; ++i) { int R, C; stage_rc(tid * 16 + i * 8192, R, C); const int Rb = (R & ~31) + perm32(R & 31);
        voffA[i] = (unsigned)(R * K + C) * 2u; voffB[i] = (unsigned)(Rb * K + C) * 2u; }
    const size_t kstep = (size_t)(BK * 2);
    const size_t hstep = (size_t)HALF * K * 2;
    const size_t tstep = 2 * hstep;
    const unsigned ldsw = (unsigned)wid * 1024u;
    const int aoff = lds_byte(wr * 64 + fr, fq * 8), boff = lds_byte(wc * 32 + fr, fq * 8);
#define PG8_SA(b, h) (((b) * 2 + (h)) * HTB)
#define PG8_SB(b, h) ((4 + (b) * 2 + (h)) * HTB)
#define PG8_STAGE(bufoff, gbase, voff) do { _Pragma("unroll") for (int _i = 0; _i < 2; ++_i) \
        __builtin_amdgcn_global_load_lds((const unsigned*)((const char*)(gbase) + (voff)[_i]), (LAS unsigned*)(lds + (bufoff) + ldsw + _i * 8192), 16, 0, 0); } while (0)
#define PG8_LDA(dst, b, h) do { _Pragma("unroll") for (int m = 0; m < 4; ++m) _Pragma("unroll") for (int k = 0; k < 2; ++k) dst[m][k] = *(const LAS bf16x8*)(lds + PG8_SA(b, h) + aoff + m * 2048 + k * 1024); } while (0)
#define PG8_LDB(dst, b, h) do { _Pragma("unroll") for (int n = 0; n < 2; ++n) _Pragma("unroll") for (int k = 0; k < 2; ++k) dst[n][k] = *(const LAS bf16x8*)(lds + PG8_SB(b, h) + boff + n * 2048 + k * 1024); } while (0)
#define PG8_MMA(ai, bj, At, Bt) do { __builtin_amdgcn_s_setprio(1); _Pragma("unroll") for (int m = 0; m < 4; ++m) _Pragma("unroll") for (int n = 0; n < 2; ++n) _Pragma("unroll") for (int k = 0; k < 2; ++k) \
        acc[ai][bj][m][n] = __builtin_amdgcn_mfma_f32_16x16x32_bf16(Bt[n][k], At[m][k], acc[ai][bj][m][n], 0, 0, 0); __builtin_amdgcn_s_setprio(0); } while (0)
#define PG8_WAIT_V(n) asm volatile("s_waitcnt vmcnt(" #n ")" ::: "memory")
#define PG8_WAIT_L(n) asm volatile("s_waitcnt lgkmcnt(" #n ")" ::: "memory")
#define PG8_BAR __builtin_amdgcn_s_barrier()
#define PG8_SCHED __builtin_amdgcn_sched_barrier(0)
    Unit cur, nxt; int ui = 0;
    if (!S.next(0, cur)) return;
    f32x4 acc[2][2][4][2];
#pragma unroll
    for (int a = 0; a < 2; ++a)
#pragma unroll
        for (int b = 0; b < 2; ++b)
#pragma unroll
            for (int m = 0; m < 4; ++m)
#pragma unroll
                for (int n = 0; n < 2; ++n) acc[a][b][m][n] = (f32x4){0.f, 0.f, 0.f, 0.f};
    bf16x8 At[4][2], B0[2][2], B1[2][2];
    const char* cA = (const char*)g.A + (size_t)cur.pm * tstep; const char* cB = (const char*)g.Bt + (size_t)cur.pn * tstep;
    PG8_STAGE(PG8_SB(0, 0), cB, voffB); PG8_STAGE(PG8_SB(0, 1), cB + hstep, voffB); PG8_STAGE(PG8_SA(0, 0), cA, voffA); PG8_STAGE(PG8_SA(0, 1), cA + hstep, voffA);
    if (wr == 1) PG8_BAR;
    PG8_WAIT_V(2); PG8_BAR;
    PG8_STAGE(PG8_SB(1, 0), cB + kstep, voffB); PG8_STAGE(PG8_SA(1, 0), cA + kstep, voffA); PG8_STAGE(PG8_SB(1, 1), cB + hstep + kstep, voffB);
    PG8_WAIT_V(6); PG8_BAR;
    for (;;) {
        const bool has_next = S.next(ui + 1, nxt);
        const char* nA = has_next ? (const char*)g.A + (size_t)nxt.pm * tstep : cA; const char* nB = has_next ? (const char*)g.Bt + (size_t)nxt.pn * tstep : cB;
        for (int t = 0; t < nt; t += 2) {
            const bool last = (t == nt - 2);
            const char* a1 = cA + (size_t)(t + 1) * kstep;
            const char* a2 = last ? nA : cA + (size_t)(t + 2) * kstep; const char* b2 = last ? nB : cB + (size_t)(t + 2) * kstep;
            const char* a3 = a2 + kstep; const char* b3 = b2 + kstep;
            PG8_LDB(B0, 0, 0); PG8_LDB(B1, 0, 1); PG8_SCHED; PG8_LDA(At, 0, 0); PG8_STAGE(PG8_SA(1, 1), a1 + hstep, voffA);
            PG8_WAIT_V(8); PG8_WAIT_L(0); PG8_BAR; PG8_MMA(0, 0, At, B0); PG8_MMA(0, 1, At, B1); PG8_BAR; PG8_SCHED;
            PG8_LDA(At, 0, 1); PG8_STAGE(PG8_SB(0, 0), b2, voffB); PG8_STAGE(PG8_SB(0, 1), b2 + hstep, voffB); PG8_STAGE(PG8_SA(0, 0), a2, voffA);
            PG8_WAIT_V(8); PG8_WAIT_L(0); PG8_BAR; PG8_MMA(1, 0, At, B0); PG8_MMA(1, 1, At, B1); PG8_BAR; PG8_SCHED;
            PG8_LDB(B0, 1, 0); PG8_LDB(B1, 1, 1); PG8_SCHED; PG8_LDA(At, 1, 0); PG8_STAGE(PG8_SA(0, 1), a2 + hstep, voffA);
            PG8_WAIT_V(8); PG8_WAIT_L(0); PG8_BAR; PG8_MMA(0, 0, At, B0); PG8_MMA(0, 1, At, B1); PG8_BAR; PG8_SCHED;
            PG8_LDA(At, 1, 1); PG8_STAGE(PG8_SB(1, 0), b3, voffB); PG8_STAGE(PG8_SB(1, 1), b3 + hstep, voffB); PG8_STAGE(PG8_SA(1, 0), a3, voffA);
            PG8_WAIT_V(8); PG8_WAIT_L(0); PG8_BAR; PG8_MMA(1, 0, At, B0); PG8_MMA(1, 1, At, B1); PG8_BAR; PG8_SCHED;
        }
        if (wr == 0) PG8_BAR;
        E(acc, cur, wr, wc, fr, fq);
        if (!has_next) break;
#pragma unroll
        for (int a = 0; a < 2; ++a)
#pragma unroll
            for (int b = 0; b < 2; ++b)
#pragma unroll
                for (int m = 0; m < 4; ++m)
#pragma unroll
                    for (int n = 0; n < 2; ++n) acc[a][b][m][n] = (f32x4){0.f, 0.f, 0.f, 0.f};
        cur = nxt; cA = nA; cB = nB; ++ui;
        if (wr == 1) PG8_BAR;
    }
    PG8_WAIT_V(0);
    PG8_BAR;
#undef PG8_SA
#undef PG8_SB
#undef PG8_STAGE
#undef PG8_LDA
#undef PG8_LDB
#undef PG8_MMA
#undef PG8_WAIT_V
#undef PG8_WAIT_L
#undef PG8_BAR
#undef PG8_SCHED
}
}

#ifndef QKT_SB_FROM
#define QKT_SB_FROM 100000
#endif
#ifndef QKT_SB_EVERY
#define QKT_SB_EVERY 4
#endif
#ifndef ATT_SD1_FROM
#define ATT_SD1_FROM 128
#endif
namespace att {
constexpr int NW = 8, QBLK = 32, KVBLK = 64;
constexpr float THR = 8.f;
constexpr int SHM_V = KVBLK * 128 * 2;
#define SBAR() __builtin_amdgcn_sched_barrier(0)
__device__ __forceinline__ int crow(int r, int hi) { return (r & 3) + 8 * (r >> 2) + 4 * hi; }
template <int DQK> __device__ __forceinline__ constexpr float scale_of() { return DQK == 64 ? 0.125f : (DQK == 128 ? 0.088388347648318440f : 0.072168783648703220f); }

template <int DQK>
__device__ __forceinline__ void partialSM(f32x16& p0, f32x16& p1, float& m_reg, float& mn, float& alpha) {
    constexpr float SCALE = scale_of<DQK>();
    constexpr float C = SCALE * 1.4426950408889634f;
    float pmax = p0[0];
#pragma unroll
    for (int r = 1; r < 16; ++r) pmax = fmaxf(pmax, p0[r]);
#pragma unroll
    for (int r = 0; r < 16; ++r) pmax = fmaxf(pmax, p1[r]);
    { auto rr = __builtin_amdgcn_permlane32_swap(__float_as_uint(pmax), __float_as_uint(pmax), false, false);
      pmax = fmaxf(__uint_as_float(rr[0]), __uint_as_float(rr[1])); }
    if (__builtin_expect(__all(pmax - m_reg <= THR / SCALE), 1)) { mn = m_reg; alpha = 1.f; }
    else { mn = fmaxf(m_reg, pmax); alpha = __builtin_amdgcn_exp2f((m_reg - mn) * C); m_reg = mn; }
    float mnC = -mn * C;
#pragma unroll
    for (int r = 0; r < 16; ++r) p0[r] = fmaf(p0[r], C, mnC);
#pragma unroll
    for (int r = 0; r < 16; ++r) p1[r] = fmaf(p1[r], C, mnC);
#pragma unroll
    for (int r = 0; r < 16; ++r) p0[r] = __builtin_amdgcn_exp2f(p0[r]);
}
__device__ __forceinline__ void finishSM(f32x16& p0, f32x16& p1, float alpha, float& l_reg, bf16x8& pa0, bf16x8& pa1, bf16x8& pa2, bf16x8& pa3) {
#pragma unroll
    for (int r = 0; r < 16; ++r) p1[r] = __builtin_amdgcn_exp2f(p1[r]);
    float ps = 0;
#pragma unroll
    for (int r = 0; r < 16; ++r) ps += p0[r];
#pragma unroll
    for (int r = 0; r < 16; ++r) ps += p1[r];
    { auto rr = __builtin_amdgcn_permlane32_swap(__float_as_uint(ps), __float_as_uint(ps), false, false);
      ps = __uint_as_float(rr[0]) + __uint_as_float(rr[1]); }
    l_reg = l_reg * alpha + ps;
#define PK4(P, BASE, OUT) do { unsigned a0 = cvt_pk_bf16(P[BASE + 0], P[BASE + 1]), a1 = cvt_pk_bf16(P[BASE + 2], P[BASE + 3]);   \
    unsigned b0 = cvt_pk_bf16(P[BASE + 4], P[BASE + 5]), b1 = cvt_pk_bf16(P[BASE + 6], P[BASE + 7]);                              \
    auto r0 = __builtin_amdgcn_permlane32_swap(a0, b0, false, false); auto r1 = __builtin_amdgcn_permlane32_swap(a1, b1, false, false); \
    u32x4 w = {r0[0], r1[0], r0[1], r1[1]}; OUT = *reinterpret_cast<bf16x8*>(&w); } while (0)
    PK4(p0, 0, pa0); PK4(p0, 8, pa1); PK4(p1, 0, pa2); PK4(p1, 8, pa3);
#undef PK4
}
template <int DQK> __device__ __forceinline__ int kswz(int row) { return DQK == 128 ? ((row & 15) << 4) : (((row >> 1) & 7) << 4); }
template <int DQK, int QL = 0>
__device__ __forceinline__ void qkt(f32x16& p0, f32x16& p1, const char* Ks, const bf16x8* qr, int r32, int hi, const char* Qs = nullptr) {
    p0 = f32x16{}; p1 = f32x16{};
#pragma unroll
    for (int d0 = 0; d0 < DQK / 16; ++d0) { const int cb = (d0 * 16 + hi * 8) * 2;
        bf16x8 b0 = *reinterpret_cast<const bf16x8*>(Ks + r32 * (DQK * 2) + (cb ^ kswz<DQK>(r32)));
        bf16x8 b1 = *reinterpret_cast<const bf16x8*>(Ks + (32 + r32) * (DQK * 2) + (cb ^ kswz<DQK>(32 + r32)));
        bf16x8 q;
        if (d0 < DQK / 16 - QL) q = qr[d0]; else q = *reinterpret_cast<const bf16x8*>(Qs + (d0 - (DQK / 16 - QL)) * 1024);
        p0 = __builtin_amdgcn_mfma_f32_32x32x16_bf16(b0, q, p0, 0, 0, 0);
        p1 = __builtin_amdgcn_mfma_f32_32x32x16_bf16(b1, q, p1, 0, 0, 0);
        if (DQK > QKT_SB_FROM && (d0 % QKT_SB_EVERY) == QKT_SB_EVERY - 1) SBAR(); }
}
__device__ __forceinline__ int v_st(int k, int c) { const int kk = (k & ~0xC) | ((k & 4) << 1) | ((k & 8) >> 1); return ((kk >> 3) * 4 + (c >> 5)) * 512 + ((kk & 7) * 32 + (c & 31)) * 2; }
__device__ __forceinline__ int v_rd_base(int lane) { return ((lane & 3) << 3) | (((lane >> 2) & 3) << 6) | (((lane >> 4) & 1) << 5) | (((lane >> 5) & 1) << 8); }
constexpr int v_rd_off(int d0, int ks, int half) { return d0 * 512 + ks * 4096 + half * 2048; }
template <int OFF> __device__ __forceinline__ s16x4 tr_read(int vb) {
    s16x4 r; asm volatile("ds_read_b64_tr_b16 %0, %1 offset:%2" : "=&v"(r) : "v"(vb), "i"(OFF) : "memory"); return r;
}
template <int D0> __device__ __forceinline__ void pv_one(f32x16& od, int vb, bf16x8 pa0, bf16x8 pa1, bf16x8 pa2, bf16x8 pa3) {
    const s16x4 l0 = tr_read<v_rd_off(D0, 0, 0)>(vb), h0 = tr_read<v_rd_off(D0, 0, 1)>(vb), l1 = tr_read<v_rd_off(D0, 1, 0)>(vb), h1 = tr_read<v_rd_off(D0, 1, 1)>(vb);
    const s16x4 l2 = tr_read<v_rd_off(D0, 2, 0)>(vb), h2 = tr_read<v_rd_off(D0, 2, 1)>(vb), l3 = tr_read<v_rd_off(D0, 3, 0)>(vb), h3 = tr_read<v_rd_off(D0, 3, 1)>(vb);
    asm volatile("s_waitcnt lgkmcnt(0)" ::: "memory"); SBAR();
#define PK(L, H) (bf16x8){L[0], L[1], L[2], L[3], H[0], H[1], H[2], H[3]}
    od = __builtin_amdgcn_mfma_f32_32x32x16_bf16(pa0, PK(l0, h0), od, 0, 0, 0);
    od = __builtin_amdgcn_mfma_f32_32x32x16_bf16(pa1, PK(l1, h1), od, 0, 0, 0);
    od = __builtin_amdgcn_mfma_f32_32x32x16_bf16(pa2, PK(l2, h2), od, 0, 0, 0);
    od = __builtin_amdgcn_mfma_f32_32x32x16_bf16(pa3, PK(l3, h3), od, 0, 0, 0);
#undef PK
}
__device__ __forceinline__ void pv_d0(f32x16* o, int vb, bf16x8 pa0, bf16x8 pa1, bf16x8 pa2, bf16x8 pa3) {
    pv_one<0>(o[0], vb, pa0, pa1, pa2, pa3); pv_one<1>(o[1], vb, pa0, pa1, pa2, pa3); pv_one<2>(o[2], vb, pa0, pa1, pa2, pa3); pv_one<3>(o[3], vb, pa0, pa1, pa2, pa3);
}

template <int DQK, int ldq, int ldk, int ldv, int ldo, int QL = 0>
__device__ __forceinline__ void attn_body(const bf16_t* __restrict__ Qb, const bf16_t* __restrict__ Kh, const bf16_t* __restrict__ Vh,
                                          bf16_t* __restrict__ Ob, int seq, char* lds) {
    constexpr int SHM_K = KVBLK * DQK * 2, NKC = DQK / 64, SD = (DQK >= ATT_SD1_FROM) ? 1 : 2, CPR = DQK / 8;
    int tid_ = threadIdx.x; asm volatile("" : "+v"(tid_));
    const int tid = tid_, wid = tid >> 6, lane = tid & 63, r32 = lane & 31, hi = lane >> 5;
    char* V_lds = lds; char* K_lds = lds + 2 * SHM_V;
    float* ws = (float*)(lds + 2 * SHM_V + 2 * SHM_K) + wid * 64; float* li_l = ws; float* al_l = ws + 32;
    constexpr int NQR = DQK / 16 - QL;
    float m_reg = -1e30f, l_reg = 0; f32x16 o[4] = {}; bf16x8 qr[NQR];
    const bf16_t* Qw = Qb + (long)(wid * QBLK + r32) * ldq + hi * 8;
#pragma unroll
    for (int d0 = 0; d0 < NQR; ++d0) qr[d0] = *reinterpret_cast<const bf16x8*>(Qw + d0 * 16);
    char* Qs = lds + 2 * SHM_V + 2 * SHM_K + NW * 256 + wid * (QL * 1024) + lane * 16;
#pragma unroll
    for (int d0 = 0; d0 < QL; ++d0) *reinterpret_cast<bf16x8*>(Qs + d0 * 1024) = *reinterpret_cast<const bf16x8*>(Qw + (NQR + d0) * 16);
    const int sr = tid >> 4, sc = (tid & 15) * 8, vst0 = v_st(sr, sc), vst1 = v_st(32 + sr, sc);
    unsigned koff[NKC]; int kdst[NKC];
    const unsigned voffV0 = (unsigned)(sr * ldv + sc) * 2u, voffV1 = (unsigned)((32 + sr) * ldv + sc) * 2u;
#pragma unroll
    for (int kc = 0; kc < NKC; ++kc) { const int ci = tid + 512 * kc; const int krow = ci / CPR, kcol = (ci % CPR) * 8; koff[kc] = (unsigned)(krow * ldk + kcol) * 2u;
        kdst[kc] = krow * (DQK * 2) + ((kcol * 2) ^ kswz<DQK>(krow)); }
    const int vb0 = (int)(uintptr_t)V_lds + v_rd_base(lane);
    struct { bf16x8 vs0, vs1, ks[NKC]; } sr_[SD];
#define SLOAD(i, k0) do { const char* vb_ = (const char*)Vh + (size_t)(k0) * (ldv * 2); const char* kb_ = (const char*)Kh + (size_t)(k0) * (ldk * 2); \
    sr_[i].vs0 = *reinterpret_cast<const bf16x8*>(vb_ + voffV0); sr_[i].vs1 = *reinterpret_cast<const bf16x8*>(vb_ + voffV1); \
    _Pragma("unroll") for (int kc_ = 0; kc_ < NKC; ++kc_) sr_[i].ks[kc_] = *reinterpret_cast<const bf16x8*>(kb_ + koff[kc_]); } while (0)
#define SWRITE(b, i) do { *(bf16x8*)(V_lds + (b) * SHM_V + vst0) = sr_[i].vs0; *(bf16x8*)(V_lds + (b) * SHM_V + vst1) = sr_[i].vs1; \
    _Pragma("unroll") for (int kc_ = 0; kc_ < NKC; ++kc_) *(bf16x8*)(K_lds + (b) * SHM_K + kdst[kc_]) = sr_[i].ks[kc_]; } while (0)
#define SWAIT() do { if constexpr (SD == 2) asm volatile("s_waitcnt vmcnt(%0)" :: "n"(2 + NKC) : "memory"); else asm volatile("s_waitcnt vmcnt(0)" ::: "memory"); } while (0)
#define RESC(a) do { if (__any((a) < 1.f)) { if (hi == 0) al_l[r32] = (a); asm volatile("s_waitcnt lgkmcnt(0)" ::: "memory"); \
    _Pragma("unroll") for (int d = 0; d < 4; ++d) _Pragma("unroll") for (int r = 0; r < 16; ++r) o[d][r] *= al_l[crow(r, hi)]; } } while (0)
    f32x16 pA0, pA1, pB0, pB1; float mnA, mnB, alA, alB; bf16x8 pa0, pa1, pa2, pa3; const int NT = seq / KVBLK;
    constexpr int SE = 0, SO = SD - 1;
    SLOAD(SE, 0); asm volatile("s_waitcnt vmcnt(0)" ::: "memory"); SWRITE(0, SE); __syncthreads();
    qkt<DQK, QL>(pA0, pA1, K_lds, qr, r32, hi, Qs); partialSM<DQK>(pA0, pA1, m_reg, mnA, alA);
    SLOAD(SO, KVBLK); if constexpr (SD == 2) { if (2 < NT) SLOAD(SE, 2 * KVBLK); }
    SWAIT(); SWRITE(1, SO); __syncthreads();
    for (int j = 1; j + 1 < NT; j += 2) {
        SBAR(); qkt<DQK, QL>(pB0, pB1, K_lds + SHM_K, qr, r32, hi, Qs);
        finishSM(pA0, pA1, alA, l_reg, pa0, pa1, pa2, pa3); SBAR();
        SLOAD(SO, (j + SD) * KVBLK); SBAR();
        pv_d0(o, vb0, pa0, pa1, pa2, pa3); partialSM<DQK>(pB0, pB1, m_reg, mnB, alB);
        __syncthreads(); SWAIT(); SWRITE(0, SE);
        RESC(alB); __syncthreads();
        SBAR(); qkt<DQK, QL>(pA0, pA1, K_lds, qr, r32, hi, Qs);
        finishSM(pB0, pB1, alB, l_reg, pa0, pa1, pa2, pa3); SBAR();
        if (SD == 1 || j + 3 < NT) SLOAD(SE, (j + 1 + SD) * KVBLK); SBAR();
        pv_d0(o, vb0 + (int)SHM_V, pa0, pa1, pa2, pa3); partialSM<DQK>(pA0, pA1, m_reg, mnA, alA);
        __syncthreads(); SWAIT(); SWRITE(1, SO);
        RESC(alA); __syncthreads();
    }
    SBAR(); qkt<DQK, QL>(pB0, pB1, K_lds + SHM_K, qr, r32, hi, Qs);
    finishSM(pA0, pA1, alA, l_reg, pa0, pa1, pa2, pa3); SBAR();
    pv_d0(o, vb0, pa0, pa1, pa2, pa3); partialSM<DQK>(pB0, pB1, m_reg, mnB, alB);
    __syncthreads(); RESC(alB);
    finishSM(pB0, pB1, alB, l_reg, pa0, pa1, pa2, pa3); SBAR();
    pv_d0(o, vb0 + (int)SHM_V, pa0, pa1, pa2, pa3);
    if (hi == 0) li_l[r32] = l_reg; asm volatile("s_waitcnt lgkmcnt(0)" ::: "memory");
    float rli[16];
#pragma unroll
    for (int r = 0; r < 16; ++r) rli[r] = __builtin_amdgcn_rcpf(li_l[crow(r, hi)]);
    bf16_t* Ow = Ob + (long)(wid * QBLK) * ldo;
#pragma unroll
    for (int r = 0; r < 16; ++r) { const int orow = crow(r, hi);
#pragma unroll
        for (int d0 = 0; d0 < 4; ++d0) Ow[(long)orow * ldo + d0 * 32 + r32] = f2bf(o[d0][r] * rli[r]); }
    __syncthreads();
#undef SLOAD
#undef SWRITE
#undef SWAIT
#undef RESC
}

template <int DQK, int ldq, int ldk, int ldv, int ldo>
__device__ __forceinline__ void attn_body_simple(const bf16_t* __restrict__ Qb, const bf16_t* __restrict__ Kh, const bf16_t* __restrict__ Vh,
                                                 bf16_t* __restrict__ Ob, int seq, char* lds) {
    constexpr int SHM_K = KVBLK * DQK * 2, NKC = DQK / 64, CPR = DQK / 8;
    int tid_ = threadIdx.x; asm volatile("" : "+v"(tid_));
    const int tid = tid_, wid = tid >> 6, lane = tid & 63, r32 = lane & 31, hi = lane >> 5;
    char* V_lds = lds; char* K_lds = lds + 2 * SHM_V;
    float* ws = (float*)(lds + 2 * SHM_V + 2 * SHM_K) + wid * 64; float* li_l = ws; float* al_l = ws + 32;
    float m_reg = -1e30f, l_reg = 0; f32x16 o[4] = {}; bf16x8 qr[DQK / 16];
    const bf16_t* Qw = Qb + (long)(wid * QBLK + r32) * ldq + hi * 8;
#pragma unroll
    for (int d0 = 0; d0 < DQK / 16; ++d0) qr[d0] = *reinterpret_cast<const bf16x8*>(Qw + d0 * 16);
    const int sr = tid >> 4, sc = (tid & 15) * 8, vst0 = v_st(sr, sc), vst1 = v_st(32 + sr, sc);
    unsigned koff[NKC]; int kdst[NKC];
    const unsigned voffV0 = (unsigned)(sr * ldv + sc) * 2u, voffV1 = (unsigned)((32 + sr) * ldv + sc) * 2u;
#pragma unroll
    for (int kc = 0; kc < NKC; ++kc) { const int ci = tid + 512 * kc; const int krow = ci / CPR, kcol = (ci % CPR) * 8; koff[kc] = (unsigned)(krow * ldk + kcol) * 2u;
        kdst[kc] = krow * (DQK * 2) + ((kcol * 2) ^ kswz<DQK>(krow)); }
    const int vb0 = (int)(uintptr_t)V_lds + v_rd_base(lane);
    bf16x8 vs0, vs1, ks[NKC];
#define SLOAD1(k0) do { const char* vb_ = (const char*)Vh + (size_t)(k0) * (ldv * 2); const char* kb_ = (const char*)Kh + (size_t)(k0) * (ldk * 2); \
    vs0 = *reinterpret_cast<const bf16x8*>(vb_ + voffV0); vs1 = *reinterpret_cast<const bf16x8*>(vb_ + voffV1); \
    _Pragma("unroll") for (int kc_ = 0; kc_ < NKC; ++kc_) ks[kc_] = *reinterpret_cast<const bf16x8*>(kb_ + koff[kc_]); } while (0)
#define SWRITE1(b) do { *(bf16x8*)(V_lds + (b) * SHM_V + vst0) = vs0; *(bf16x8*)(V_lds + (b) * SHM_V + vst1) = vs1; \
    _Pragma("unroll") for (int kc_ = 0; kc_ < NKC; ++kc_) *(bf16x8*)(K_lds + (b) * SHM_K + kdst[kc_]) = ks[kc_]; } while (0)
    f32x16 pA0, pA1; float mnA, alA; bf16x8 pa0, pa1, pa2, pa3; const int NT = seq / KVBLK;
    SLOAD1(0); asm volatile("s_waitcnt vmcnt(0)" ::: "memory"); SWRITE1(0); __syncthreads();
    for (int j = 0; j < NT; ++j) {
        const int buf = j & 1;
        if (j + 1 < NT) SLOAD1((j + 1) * KVBLK);
        SBAR();
        qkt<DQK>(pA0, pA1, K_lds + buf * SHM_K, qr, r32, hi);
        partialSM<DQK>(pA0, pA1, m_reg, mnA, alA);
        if (__any(alA < 1.f)) { if (hi == 0) al_l[r32] = alA; asm volatile("s_waitcnt lgkmcnt(0)" ::: "memory");
#pragma unroll
            for (int d = 0; d < 4; ++d)
#pragma unroll
                for (int r = 0; r < 16; ++r) o[d][r] *= al_l[crow(r, hi)]; }
        finishSM(pA0, pA1, alA, l_reg, pa0, pa1, pa2, pa3); SBAR();
        pv_d0(o, vb0 + buf * (int)SHM_V, pa0, pa1, pa2, pa3);
        if (j + 1 < NT) { asm volatile("s_waitcnt vmcnt(0)" ::: "memory"); SWRITE1(buf ^ 1); }
        __syncthreads();
    }
    if (hi == 0) li_l[r32] = l_reg; asm volatile("s_waitcnt lgkmcnt(0)" ::: "memory");
    float rli[16];
#pragma unroll
    for (int r = 0; r < 16; ++r) rli[r] = __builtin_amdgcn_rcpf(li_l[crow(r, hi)]);
    bf16_t* Ow = Ob + (long)(wid * QBLK) * ldo;
#pragma unroll
    for (int r = 0; r < 16; ++r) { const int orow = crow(r, hi);
#pragma unroll
        for (int d0 = 0; d0 < 4; ++d0) Ow[(long)orow * ldo + d0 * 32 + r32] = f2bf(o[d0][r] * rli[r]); }
    __syncthreads();
#undef SLOAD1
#undef SWRITE1
}

template <int DQK, int ldq, int ldk, int ldv, int ldo>
__device__ __forceinline__ void attn_body_dma(const bf16_t* __restrict__ Qb, const bf16_t* __restrict__ Kh, const bf16_t* __restrict__ Vh,
                                              bf16_t* __restrict__ Ob, int seq, char* lds) {
    constexpr int SHM_K = KVBLK * DQK * 2, NKC = DQK / 64;
    int tid_ = threadIdx.x; asm volatile("" : "+v"(tid_));
    const int tid = tid_, wid = __builtin_amdgcn_readfirstlane(tid >> 6), lane = tid & 63, r32 = lane & 31, hi = lane >> 5;
    char* V_lds = lds; char* K_lds = lds + 2 * SHM_V;
    float* ws = (float*)(lds + 2 * SHM_V + 2 * SHM_K) + wid * 64; float* li_l = ws; float* al_l = ws + 32;
    float m_reg = -1e30f, l_reg = 0; f32x16 o[4] = {}; bf16x8 qr[DQK / 16];
    const bf16_t* Qw = Qb + (long)(wid * QBLK + r32) * ldq + hi * 8;
#pragma unroll
    for (int d0 = 0; d0 < DQK / 16; ++d0) qr[d0] = *reinterpret_cast<const bf16x8*>(Qw + d0 * 16);
    unsigned vsrc[2], ksrc[NKC];
#pragma unroll
    for (int i = 0; i < 2; ++i) { const int o_ = i * 8192 + tid * 16; const int sub = o_ >> 9, w_ = (o_ & 511) >> 1; const int kk = (sub >> 2) * 8 + (w_ >> 5), c = (sub & 3) * 32 + (w_ & 31);
        const int k = (kk & ~0xC) | ((kk & 4) << 1) | ((kk & 8) >> 1); vsrc[i] = (unsigned)(k * ldv + c) * 2u; }
#pragma unroll
    for (int i = 0; i < NKC; ++i) { const int o_ = i * 8192 + tid * 16; const int row = o_ / (DQK * 2), b = o_ % (DQK * 2); const int cb = b ^ kswz<DQK>(row);
        ksrc[i] = (unsigned)(row * ldk) * 2u + (unsigned)cb; }
    const unsigned vdst = (unsigned)(uintptr_t)V_lds + (unsigned)wid * 1024u, kdst0 = (unsigned)(uintptr_t)K_lds + (unsigned)wid * 1024u;
    const int vb0 = (int)(uintptr_t)V_lds + v_rd_base(lane);
#define DMA_TILE(k0, b) do { const char* vb_ = (const char*)Vh + (size_t)(k0) * (ldv * 2); const char* kb_ = (const char*)Kh + (size_t)(k0) * (ldk * 2); \
    _Pragma("unroll") for (int i_ = 0; i_ < 2; ++i_) __builtin_amdgcn_global_load_lds((const unsigned*)(vb_ + vsrc[i_]), (LAS unsigned*)(vdst + (b) * SHM_V + i_ * 8192), 16, 0, 0); \
    _Pragma("unroll") for (int i_ = 0; i_ < NKC; ++i_) __builtin_amdgcn_global_load_lds((const unsigned*)(kb_ + ksrc[i_]), (LAS unsigned*)(kdst0 + (b) * SHM_K + i_ * 8192), 16, 0, 0); } while (0)
    f32x16 pA0, pA1; float mnA, alA; bf16x8 pa0, pa1, pa2, pa3; const int NT = seq / KVBLK;
    DMA_TILE(0, 0); asm volatile("s_waitcnt vmcnt(0)" ::: "memory"); __syncthreads();
    for (int j = 0; j < NT; ++j) {
        const int buf = j & 1;
        SBAR();
        qkt<DQK>(pA0, pA1, K_lds + buf * SHM_K, qr, r32, hi);
        SBAR();
        if (j + 1 < NT) DMA_TILE((j + 1) * KVBLK, buf ^ 1);
        SBAR();
        partialSM<DQK>(pA0, pA1, m_reg, mnA, alA);
        if (__any(alA < 1.f)) { if (hi == 0) al_l[r32] = alA; asm volatile("s_waitcnt lgkmcnt(0)" ::: "memory");
#pragma unroll
            for (int d = 0; d < 4; ++d)
#pragma unroll
                for (int r = 0; r < 16; ++r) o[d][r] *= al_l[crow(r, hi)]; }
        finishSM(pA0, pA1, alA, l_reg, pa0, pa1, pa2, pa3); SBAR();
        pv_d0(o, vb0 + buf * (int)SHM_V, pa0, pa1, pa2, pa3);
        asm volatile("s_waitcnt vmcnt(0)" ::: "memory");
        __syncthreads();
    }
    if (hi == 0) li_l[r32] = l_reg; asm volatile("s_waitcnt lgkmcnt(0)" ::: "memory");
    float rli[16];
#pragma unroll
    for (int r = 0; r < 16; ++r) rli[r] = __builtin_amdgcn_rcpf(li_l[crow(r, hi)]);
    bf16_t* Ow = Ob + (long)(wid * QBLK) * ldo;
#pragma unroll
    for (int r = 0; r < 16; ++r) { const int orow = crow(r, hi);
#pragma unroll
        for (int d0 = 0; d0 < 4; ++d0) Ow[(long)orow * ldo + d0 * 32 + r32] = f2bf(o[d0][r] * rli[r]); }
    __syncthreads();
#undef DMA_TILE
}
}

__device__ __forceinline__ unsigned pk2(float lo, float hi) { return cvt_pk_bf16(lo, hi); }

__device__ __forceinline__ void transpose_mat(const float* W, int K, int Nsrc, bf16_t* WT, int Ndst, int mode, LAS float* scr, int gw, int NGW, int lane) {
    const int nblk = Ndst / 32, nitems = (K / 64) * nblk;
    for (int item = gw; item < nitems; item += NGW) {
        const int kb = item / nblk, nb = item % nblk, k0 = 64 * kb, n0 = 32 * nb;
        int s0 = n0;
        if (mode == 1) s0 = n0 < 3520 ? n0 : (n0 < 3584 ? -1 : n0 - 64);
        if (mode == 2) { const int pn = n0 >> 8, j = n0 & 255; s0 = j < 128 ? 128 * pn + j : DFF + 128 * pn + (j - 128); }
        float wv[32];
#pragma unroll
        for (int i = 0; i < 32; ++i) { const int kk = 2 * i + (lane >> 5); wv[i] = s0 < 0 ? 0.f : W[(size_t)(k0 + kk) * Nsrc + s0 + (lane & 31)]; }
#pragma unroll
        for (int i = 0; i < 32; ++i) { const int kk = 2 * i + (lane >> 5); scr[kk * 33 + (lane & 31)] = wv[i]; }
        asm volatile("s_waitcnt lgkmcnt(0)" ::: "memory");
        const int c = lane & 7;
#pragma unroll
        for (int j = 0; j < 4; ++j) { const int n = (lane >> 3) + 8 * j; const LAS float* s = scr + (8 * c) * 33 + n;
            u32x4 o; o.x = pk2(s[0 * 33], s[1 * 33]); o.y = pk2(s[2 * 33], s[3 * 33]); o.z = pk2(s[4 * 33], s[5 * 33]); o.w = pk2(s[6 * 33], s[7 * 33]);
            *(u32x4*)(WT + (size_t)(n0 + n) * K + k0 + 8 * c) = o; }
        asm volatile("s_waitcnt lgkmcnt(0)" ::: "memory");
    }
}

__device__ __forceinline__ void ph_prologue(const Params& p, LAS unsigned char* lds) {
    const int tid = otid(), wave = tid >> 6, lane = tid & 63;
    const int gw = obid() * 8 + wave, NGW = gridDim.x * 8;
    LAS float* scr = (LAS float*)(lds + wave * 16384);
    for (int l = 0; l < 2; ++l) {
        bf16_t* Wl = (bf16_t*)(p.ws + WS_W + l * W_LAYER_B);
        transpose_mat(p.in[7] + (size_t)l * 1024 * 7616, 1024, 7616, Wl + W_IN, 7680, 1, scr, gw, NGW, lane);
        transpose_mat(p.in[26] + (size_t)l * 256 * 768, 256, 768, Wl + W_UQ, 768, 0, scr, gw, NGW, lane);
        transpose_mat(p.in[27] + (size_t)l * 128 * 1024, 128, 1024, Wl + W_UKV, 1024, 0, scr, gw, NGW, lane);
        transpose_mat(p.in[16] + (size_t)l * 512 * 512, 512, 512, Wl + W_GLU, 512, 0, scr, gw, NGW, lane);
        for (int n = 0; n < 4; ++n) transpose_mat(p.in[30] + ((size_t)l * 4 + n) * 512 * 1024, 512, 1024, Wl + W_BR + (size_t)n * 1024 * 512, 1024, 0, scr, gw, NGW, lane);
        transpose_mat(p.in[31] + (size_t)l * 1024 * 1024, 1024, 1024, Wl + W_OUT, 1024, 0, scr, gw, NGW, lane);
        transpose_mat(p.in[33] + (size_t)l * 1024 * 5632, 1024, 5632, Wl + W_FI, 5632, 2, scr, gw, NGW, lane);
        transpose_mat(p.in[34] + (size_t)l * 2816 * 1024, 2816, 1024, Wl + W_FO, 1024, 0, scr, gw, NGW, lane);
    }
    {
        typedef float f32x2t __attribute__((ext_vector_type(2)));
        f32x2t* T64 = (f32x2t*)(p.ws + WS_ROPE64); f32x2t* T128 = (f32x2t*)(p.ws + WS_ROPE128);
        for (int idx = obid() * 512 + tid; idx < 128 * 16 + 128 * 32; idx += gridDim.x * 512) {
            if (idx < 128 * 16) { const int pos = idx >> 4, k = idx & 15; const float ang = (float)pos * exp2f(-(float)(4 * k) * (13.287712379549449f / 64)); T64[idx] = (f32x2t){cosf(ang), sinf(ang)}; }
            else { const int i2 = idx - 128 * 16, pos = i2 >> 5, k = i2 & 31; const float ang = (float)pos * exp2f(-(float)(4 * k) * (13.287712379549449f / 128)); T128[i2] = (f32x2t){cosf(ang), sinf(ang)}; }
        }
    }
    __syncthreads();
    LAS float* sc = (LAS float*)lds;
    LAS float* part = (LAS float*)(lds + 32768);
    float* MOD = (float*)(p.ws + WS_MOD);
    for (int it = obid(); it < 2 * 96; it += gridDim.x) {
        const int l = it / 96, cb = it % 96;
        for (int idx = tid; idx < 5 * 1024; idx += 512) { const int mi = idx >> 10, k = idx & 1023; const float v = mi < 4 ? p.in[1][mi * 1024 + k] : p.in[3][k]; sc[idx] = v / (1.f + __expf(-v)); }
        __syncthreads();
        const int j = cb * 64 + lane; const float* wm = p.in[4] + (size_t)l * 1024 * MODW + j;
        float a0 = 0, a1 = 0, a2 = 0, a3 = 0, a4 = 0;
#pragma unroll 32
        for (int kk = 0; kk < 128; ++kk) { const int k = wave * 128 + kk; const float w = wm[(size_t)k * MODW];
            a0 += sc[k] * w; a1 += sc[1024 + k] * w; a2 += sc[2048 + k] * w; a3 += sc[3072 + k] * w; a4 += sc[4096 + k] * w; }
        part[(wave * 5 + 0) * 64 + lane] = a0; part[(wave * 5 + 1) * 64 + lane] = a1; part[(wave * 5 + 2) * 64 + lane] = a2; part[(wave * 5 + 3) * 64 + lane] = a3; part[(wave * 5 + 4) * 64 + lane] = a4;
        __syncthreads();
        if (tid < 320) { const int mi = tid >> 6, jj = tid & 63; float s = 0;
#pragma unroll
            for (int w = 0; w < 8; ++w) s += part[(w * 5 + mi) * 64 + jj];
            MOD[((size_t)l * 5 + mi) * MODW + cb * 64 + jj] = s + p.in[5][l * MODW + cb * 64 + jj]; }
        __syncthreads();
    }
}

__device__ __forceinline__ const float* row_src(int R, const float* xl, const float* xc, int& mi) {
    const int b = R / RB, s = R - b * RB;
    if (s < CTX) { mi = 4; return xc + ((size_t)b * CTX + s) * DM; }
    mi = b; return xl + ((size_t)b * SEQ + (s - CTX)) * DM;
}
__device__ __forceinline__ void nm_finish(const f32x4 (&v)[4], int R, int mi, int lane, const float* gain, const float* modl, int sh_chunk, bf16_t* H) {
    const float* shp = modl + (size_t)mi * MODW + sh_chunk * 1024; const float* scp = shp + 1024;
    float ss = 0.f;
#pragma unroll
    for (int j = 0; j < 4; ++j) ss += (v[j].x * v[j].x + v[j].y * v[j].y) + (v[j].z * v[j].z + v[j].w * v[j].w);
    const float rs = rsqrtf(wave_sum(ss) * (1.f / DM) + EPS);
#pragma unroll
    for (int j = 0; j < 4; ++j) { const int c = j * 256 + lane * 4;
        const f32x4 g = *(const f32x4*)(gain + c), sh = *(const f32x4*)(shp + c), sc = *(const f32x4*)(scp + c);
        const f32x4 y = (v[j] * rs * g) * (sc + 1.0f) + sh;
        u32x2 w; w.x = cvt_pk_bf16(y.x, y.y); w.y = cvt_pk_bf16(y.z, y.w);
        *(u32x2*)(H + (size_t)R * DM + c) = w; }
}
__device__ __forceinline__ void ph_norm_mod(const float* xl, const float* xc, const float* gain, const float* modl, int sh_chunk, bf16_t* H) {
    const int tid = otid(); const int lane = tid & 63, gw = obid() * 8 + (tid >> 6), NGW = gridDim.x * 8;
    for (int R = gw; R < MTOT; R += 2 * NGW) {
        const int R2 = R + NGW; const bool has2 = R2 < MTOT;
        int mi, mi2 = 0; const float* xr = row_src(R, xl, xc, mi); const float* xr2 = has2 ? row_src(R2, xl, xc, mi2) : xr;
        f32x4 v[4], v2[4];
#pragma unroll
        for (int j = 0; j < 4; ++j) v[j] = *(const f32x4*)(xr + j * 256 + lane * 4);
#pragma unroll
        for (int j = 0; j < 4; ++j) v2[j] = *(const f32x4*)(xr2 + j * 256 + lane * 4);
        nm_finish(v, R, mi, lane, gain, modl, sh_chunk, H);
        if (has2) nm_finish(v2, R2, mi2, lane, gain, modl, sh_chunk, H);
    }
}

__device__ __forceinline__ int s5_pos(int i, int dir) { return dir == 0 ? i : (i < CTX ? (CTX - 1 - i) : (RB + CTX - 1 - i)); }
__device__ __forceinline__ void s5_chain(const Params& p, int layer, int unit, LAS unsigned char* lds) {
    const int b = unit >> 6, dir = (unit >> 5) & 1, g = unit & 31;
    const int tid = otid(), wid = tid >> 6, lane = tid & 63, fr = lane & 15, quad = lane >> 4;
    LAS float* BU = (LAS float*)lds;
    LAS bf16_t* Hb = (LAS bf16_t*)(lds + 65536);
    const int ldg = ((layer * 2 + dir) * 32 + g);
    const float* lam_re = p.in[8] + (size_t)ldg * 64; const float* lam_im = p.in[9] + (size_t)ldg * 64;
    const float dt = expf(p.in[10][ldg]);
    const float* bre = p.in[11] + (size_t)ldg * 64 * 16; const float* bim = p.in[12] + (size_t)ldg * 64 * 16;
    const float* cre = p.in[13] + (size_t)ldg * 16 * 64; const float* cim = p.in[14] + (size_t)ldg * 16 * 64;
    const bf16_t* U = (const bf16_t*)(p.ws + WS_G + S_U) + (size_t)b * RB * 512 + g * 16;
    bf16_t* Y = (bf16_t*)(p.ws + WS_G + (dir == 0 ? S_YF : S_YR)) + ((size_t)g * MTOT + (size_t)b * RB) * 16;
    const int cb0 = (wid & 3) * 2;
    bf16x8 bop[2] = {{0, 0, 0, 0, 0, 0, 0, 0}, {0, 0, 0, 0, 0, 0, 0, 0}};
#pragma unroll
    for (int t = 0; t < 2; ++t) {
        const int cb = cb0 + t, pst = (cb & 3) * 16 + fr; const float lr = lam_re[pst], li = lam_im[pst];
        const float mag = expf(lr * dt); const float abr = mag * cosf(li * dt), abi = mag * sinf(li * dt);
        const float den = lr * lr + li * li, nr = abr - 1.f, ni = abi;
        const float cr = (nr * lr + ni * li) / den, ci = (ni * lr - nr * li) / den;
        if (quad < 2) {
#pragma unroll
            for (int j = 0; j < 8; ++j) { const int c = quad * 8 + j; const float br_ = bre[pst * 16 + c], bi_ = bim[pst * 16 + c];
                const float v = (cb < 4) ? cr * br_ - ci * bi_ : cr * bi_ + ci * br_; bop[t][j] = (short)f2bf(v); }
        }
    }
    float ar, ai, hr = 0.f, hi = 0.f;
    { const float lr = lam_re[lane], li = lam_im[lane]; const float mag = expf(lr * dt); ar = mag * cosf(li * dt); ai = mag * sinf(li * dt); }
    bf16x8 cop[4];
#pragma unroll
    for (int ks = 0; ks < 4; ++ks)
#pragma unroll
        for (int j = 0; j < 8; ++j) { const int k = ks * 32 + quad * 8 + j; const float v = (k & 1) ? -cim[fr * 64 + (k >> 1)] : cre[fr * 64 + (k >> 1)]; cop[ks][j] = (short)f2bf(v); }
#define S5_LD(chunk, A_) do { _Pragma("unroll") for (int rb = 0; rb < 4; ++rb) { const int s_ = s5_pos((chunk) * 64 + rb * 16 + fr, dir); \
        A_[rb] = (bf16x8){0, 0, 0, 0, 0, 0, 0, 0}; if (quad < 2) A_[rb] = *(const bf16x8*)(U + (size_t)s_ * 512 + quad * 8); } } while (0)
#define S5_MM(A_, BUb) do { _Pragma("unroll") for (int rb = 0; rb < 4; ++rb) { \
        _Pragma("unroll") for (int t = 0; t < 2; ++t) { f32x4 acc = {0.f, 0.f, 0.f, 0.f}; acc = __builtin_amdgcn_mfma_f32_16x16x32_bf16(A_[rb], bop[t], acc, 0, 0, 0); \
            _Pragma("unroll") for (int j = 0; j < 4; ++j) (BUb)[(rb * 16 + quad * 4 + j) * 128 + (cb0 + t) * 16 + fr] = acc[j]; } } } while (0)
#define S5_C(chunk, Hbb, rb) do { f32x4 acc = {0.f, 0.f, 0.f, 0.f}; \
        _Pragma("unroll") for (int ks = 0; ks < 4; ++ks) { const bf16x8 aop = *(const LAS bf16x8*)((Hbb) + ((rb) * 16 + fr) * 136 + ks * 32 + quad * 8); \
            acc = __builtin_amdgcn_mfma_f32_16x16x32_bf16(aop, cop[ks], acc, 0, 0, 0); } \
        _Pragma("unroll") for (int j = 0; j < 4; ++j) { const int s_ = s5_pos((chunk) * 64 + (rb) * 16 + quad * 4 + j, dir); Y[(size_t)s_ * 16 + fr] = f2bf(acc[j]); } } while (0)
    constexpr int NCH = RB / 64;
    bf16x8 ua[4], ub[4];
    if (wid >= 4) { S5_LD(0, ua); S5_MM(ua, BU); S5_LD(1, ua); }
    __syncthreads();
    for (int k = 0; k < NCH; ++k) {
        LAS float* BUc = BU + (k & 1) * 8192; LAS bf16_t* Hbc = Hb + (k & 1) * (64 * 136);
        if (wid == 0) {
#pragma unroll
            for (int hf = 0; hf < 2; ++hf) {
                float brv[32], biv[32];
#pragma unroll
                for (int i = 0; i < 32; ++i) { brv[i] = BUc[(hf * 32 + i) * 128 + lane]; biv[i] = BUc[(hf * 32 + i) * 128 + 64 + lane]; }
#pragma unroll
                for (int i = 0; i < 32; ++i) {
                    const float nr = fmaf(ar, hr, fmaf(-ai, hi, brv[i])), ni = fmaf(ar, hi, fmaf(ai, hr, biv[i]));
                    hr = nr; hi = ni;
                    *(LAS unsigned*)(Hbc + (hf * 32 + i) * 136 + 2 * lane) = cvt_pk_bf16(hr, hi);
                }
            }
        } else if (wid >= 4) {
            if (k + 1 < NCH) { LAS float* BUn = BU + ((k + 1) & 1) * 8192;
                if (k + 2 < NCH) S5_LD(k + 2, ub);
                S5_MM(ua, BUn);
#pragma unroll
                for (int rb = 0; rb < 4; ++rb) ua[rb] = ub[rb]; }
        } else if (k > 0) {
            LAS bf16_t* Hbp = Hb + ((k - 1) & 1) * (64 * 136);
            S5_C(k - 1, Hbp, wid - 1);
            if (wid == 1) S5_C(k - 1, Hbp, 3);
        }
        __syncthreads();
    }
    if (wid >= 1 && wid < 4) { LAS bf16_t* Hbp = Hb + ((NCH - 1) & 1) * (64 * 136); S5_C(NCH - 1, Hbp, wid - 1); if (wid == 1) S5_C(NCH - 1, Hbp, 3); }
    __syncthreads();
#undef S5_LD
#undef S5_MM
#undef S5_C
}

__device__ __forceinline__ u32x4 gelu8(const u32x4 u, const u32x4 yf, const u32x4 yr, const float* d, int c) {
    float o[8];
#pragma unroll
    for (int e = 0; e < 4; ++e) {
        const float y0 = d[c + 2 * e] * bflo(u[e]) + bflo(yf[e]) + bflo(yr[e]);
        const float y1 = d[c + 2 * e + 1] * bfhi(u[e]) + bfhi(yf[e]) + bfhi(yr[e]);
        o[2 * e] = y0 * sigmoidf_(1.5957691216057308f * (y0 + 0.044715f * y0 * y0 * y0));
        o[2 * e + 1] = y1 * sigmoidf_(1.5957691216057308f * (y1 + 0.044715f * y1 * y1 * y1));
    }
    u32x4 w; w.x = cvt_pk_bf16(o[0], o[1]); w.y = cvt_pk_bf16(o[2], o[3]); w.z = cvt_pk_bf16(o[4], o[5]); w.w = cvt_pk_bf16(o[6], o[7]);
    return w;
}
__device__ __forceinline__ void ph_s5_gelu(const Params& p, int layer) {
    bf16_t* U = (bf16_t*)(p.ws + WS_G + S_U); const bf16_t* YF = (const bf16_t*)(p.ws + WS_G + S_YF); const bf16_t* YR = (const bf16_t*)(p.ws + WS_G + S_YR);
    const float* d = p.in[15] + layer * 512;
    const size_t n8 = (size_t)MTOT * 512 / 8, stride = (size_t)gridDim.x * 512;
    const int tid = otid();
    for (size_t i = (size_t)obid() * 512 + tid; i < n8; i += 2 * stride) {
        const size_t i2 = i + stride; const bool has2 = i2 < n8; const size_t ib = has2 ? i2 : i;
        const int c = (int)(i & 63) * 8, c2 = (int)(ib & 63) * 8;
        const size_t yo = ((size_t)(c >> 4) * MTOT + (i >> 6)) * 16 + (c & 15), yo2 = ((size_t)(c2 >> 4) * MTOT + (ib >> 6)) * 16 + (c2 & 15);
        const u32x4 u = *(const u32x4*)(U + i * 8), yf = *(const u32x4*)(YF + yo), yr = *(const u32x4*)(YR + yo);
        const u32x4 ub = *(const u32x4*)(U + ib * 8), yfb = *(const u32x4*)(YF + yo2), yrb = *(const u32x4*)(YR + yo2);
        *(u32x4*)(U + i * 8) = gelu8(u, yf, yr, d, c);
        if (has2) *(u32x4*)(U + ib * 8) = gelu8(ub, yfb, yrb, d, c2);
    }
}

template <int NP> __device__ __forceinline__ void seg_load(const bf16_t* in, int ncols, int lane, unsigned (&w)[NP]) {
#pragma unroll
    for (int i = 0; i < NP; ++i) w[i] = (128 * i + 2 * lane < ncols) ? *(const unsigned*)(in + 128 * i + 2 * lane) : 0u;
}
template <int CW, int NP>
__device__ __forceinline__ void seg_fin(const unsigned (&w)[NP], bf16_t* out, int ncols, const float* gain, bool rope, int t, int lane, const float* rtab = nullptr) {
#pragma unroll
    for (int i = 0; i < NP; ++i) {
        const bool valid = 128 * i + 2 * lane < ncols;
        const float x0 = bflo(w[i]), x1 = bfhi(w[i]);
        float ss = x0 * x0 + x1 * x1;
        ss = (CW == 64) ? half_sum(ss) : wave_sum(ss);
        const float rs = rsqrtf(ss * (1.f / CW) + EPS);
        const int e = (2 * lane) % CW;
        float y0 = x0 * rs * gain[e], y1 = x1 * rs * gain[e + 1];
        if (rope) {
            const int pi = e >> 1, q = CW / 4; const int k = pi < q ? pi : pi - q; const int pos = pi < q ? (t >> 6) : (t & 63);
            typedef float f32x2t __attribute__((ext_vector_type(2)));
            const f32x2t cssn = ((const f32x2t*)rtab)[pos * q + k]; const float cs = cssn.x, sn = cssn.y;
            const float r0 = y0 * cs - y1 * sn, r1 = y0 * sn + y1 * cs; y0 = r0; y1 = r1;
        }
        if (valid) *(unsigned*)(out + 128 * i + 2 * lane) = cvt_pk_bf16(y0, y1);
    }
}
__device__ __forceinline__ void ph_prep1(const Params& p, int layer) {
    const int tid = otid(); const int lane = tid & 63, gw = obid() * 8 + (tid >> 6), NGW = gridDim.x * 8;
    bf16_t* Z = (bf16_t*)(p.ws + WS_G + G_Z); bf16_t* CQ = (bf16_t*)(p.ws + WS_G + G_CQ); bf16_t* CKV = (bf16_t*)(p.ws + WS_G + G_CKV);
    const float* daq = p.in[18] + layer * 64; const float* dak = p.in[19] + layer * 64; const float* gqq = p.in[22] + layer * 128; const float* gqk = p.in[23] + layer * 128;
    const float* r64 = (const float*)(p.ws + WS_ROPE64); const float* r128 = (const float*)(p.ws + WS_ROPE128);
    const float* cqn = p.in[24] + layer * 256; const float* ckvn = p.in[25] + layer * 128; const float* mlk = p.in[29] + layer * 192;
    for (int r = gw; r < RB; r += NGW) {
        bf16_t* z = Z + (size_t)r * ZW; const bool lat = r >= CTX; const int t = r - CTX;
        unsigned wq[4], wk[4], gq[4], gk[2], kv[1], kr[1];
        seg_load<4>(z + Z_DAQ, 512, lane, wq); seg_load<4>(z + Z_DAK, 512, lane, wk); seg_load<4>(z + Z_GQQ, 512, lane, gq); seg_load<2>(z + Z_GQK, 256, lane, gk);
        seg_load<1>(z + Z_CKV, 128, lane, kv); seg_load<1>(z + Z_KR, 64, lane, kr);
        const u32x2 wc = *(const u32x2*)(z + Z_CQ + 4 * lane);
        seg_fin<64, 4>(wq, z + Z_DAQ, 512, daq, lat, t, lane, r64);
        seg_fin<64, 4>(wk, z + Z_DAK, 512, dak, lat, t, lane, r64);
        seg_fin<128, 4>(gq, z + Z_GQQ, 512, gqq, lat, t, lane, r128);
        seg_fin<128, 2>(gk, z + Z_GQK, 256, gqk, lat, t, lane, r128);
        seg_fin<128, 1>(kv, CKV + (size_t)r * 128, 128, ckvn, false, 0, lane);
        seg_fin<64, 1>(kr, z + Z_KR, 64, mlk + 128, lat, t, lane, r64);
        {
            const float x0 = bflo(wc.x), x1 = bfhi(wc.x), x2 = bflo(wc.y), x3 = bfhi(wc.y);
            const float rs = rsqrtf(wave_sum(x0 * x0 + x1 * x1 + x2 * x2 + x3 * x3) * (1.f / 256) + EPS);
            const f32x4 g = *(const f32x4*)(cqn + 4 * lane);
            u32x2 o; o.x = cvt_pk_bf16(x0 * rs * g.x, x1 * rs * g.y); o.y = cvt_pk_bf16(x2 * rs * g.z, x3 * rs * g.w);
            *(u32x2*)(CQ + (size_t)r * 256 + 4 * lane) = o;
        }
    }
}
__device__ __forceinline__ void ph_prep2(const Params& p, int layer) {
    const int tid = otid(); const int lane = tid & 63, gw = obid() * 8 + (tid >> 6), NGW = gridDim.x * 8;
    const bf16_t* Z = (const bf16_t*)(p.ws + WS_G + G_Z); bf16_t* MLQ = (bf16_t*)(p.ws + WS_G + G_MLQ); const bf16_t* MLKV = (const bf16_t*)(p.ws + WS_G + G_MLKV); bf16_t* KF = (bf16_t*)(p.ws + WS_G + G_KF);
    const float* mlq = p.in[28] + layer * 192; const float* mlk = p.in[29] + layer * 192; const float* r64 = (const float*)(p.ws + WS_ROPE64);
    for (int r = gw; r < RB; r += NGW) {
        const bool lat = r >= CTX; const int t = r - CTX;
        bf16_t* q = MLQ + (size_t)r * 768; const bf16_t* kv = MLKV + (size_t)r * 1024; bf16_t* kf = KF + (size_t)r * 768;
        const unsigned krw = lane < 32 ? *(const unsigned*)(Z + (size_t)r * ZW + Z_KR + 2 * lane) : 0u;
        unsigned qn[4][1], qp[4][1], kn[4][1];
#pragma unroll
        for (int h = 0; h < 4; ++h) { seg_load<1>(q + h * 192, 128, lane, qn[h]); seg_load<1>(q + h * 192 + 128, 64, lane, qp[h]); seg_load<1>(kv + h * 256, 128, lane, kn[h]); }
#pragma unroll
        for (int h = 0; h < 4; ++h) {
            seg_fin<128, 1>(qn[h], q + h * 192, 128, mlq, false, 0, lane);
            seg_fin<64, 1>(qp[h], q + h * 192 + 128, 64, mlq + 128, lat, t, lane, r64);
            seg_fin<128, 1>(kn[h], kf + h * 192, 128, mlk, false, 0, lane);
            if (lane < 32) *(unsigned*)(kf + h * 192 + 128 + 2 * lane) = krw;
        }
    }
}
__device__ __forceinline__ void ph_subln(const Params& p, int layer) {
    const int tid = otid(); const int lane = tid & 63, gw = obid() * 8 + (tid >> 6), NGW = gridDim.x * 8;
    const bf16_t* A1 = (const bf16_t*)(p.ws + WS_G + G_A1); const bf16_t* A2 = (const bf16_t*)(p.ws + WS_G + G_A2); bf16_t* O = (bf16_t*)(p.ws + WS_G + G_BR);
    const float* lam = p.in[20] + layer * 256; const float* sub = p.in[21] + layer * 128;
    int lyr = layer; asm volatile("" : "+s"(lyr));
    const float lam_init = lyr == 0 ? 0.2f : 0.35550907f;
    const float l1 = wave_sum(lam[lane] * lam[64 + lane]), l2 = wave_sum(lam[128 + lane] * lam[192 + lane]);
    const float lam_full = expf(l1) - expf(l2) + lam_init;
    const float g0 = sub[2 * lane] * (1.f - lam_init), g1 = sub[2 * lane + 1] * (1.f - lam_init);
    for (int r = gw; r < RB; r += NGW) {
        unsigned w1[4], w2[4];
#pragma unroll
        for (int h = 0; h < 4; ++h) { const size_t off = (size_t)r * 512 + h * 128 + 2 * lane; w1[h] = *(const unsigned*)(A1 + off); w2[h] = *(const unsigned*)(A2 + off); }
#pragma unroll
        for (int h = 0; h < 4; ++h) {
            const size_t off = (size_t)r * 512 + h * 128 + 2 * lane;
            const float d0 = bflo(w1[h]) - lam_full * bflo(w2[h]), d1 = bfhi(w1[h]) - lam_full * bfhi(w2[h]);
            const float rs = rsqrtf(wave_sum(d0 * d0 + d1 * d1) * (1.f / 128) + EPS);
            *(unsigned*)(O + off) = cvt_pk_bf16(d0 * rs * g0, d1 * rs * g1);
        }
    }
}

__device__ __forceinline__ void attn_unit(const Params& p, int u, char* lds) {
    const bf16_t* Z = (const bf16_t*)(p.ws + WS_G + G_Z);
    int type, hd, qb;
    if (u < 128) { type = 0; hd = u >> 5; qb = 1 + (u & 31); }
    else if (u < 256) { type = 1; hd = (u - 128) >> 5; qb = 1 + (u & 31); }
    else if (u < 512) { type = 2; hd = (u - 256) >> 5; qb = 1 + (u & 31); }
    else { const int k = u - 512; qb = 0; if (k < 4) { type = 0; hd = k; } else if (k < 8) { type = 1; hd = k - 4; } else { type = 2; hd = k - 8; } }
    const int seq = qb == 0 ? CTX : RB; const size_t q0 = (size_t)qb * 256;
#ifndef ATT_TYPES
#define ATT_TYPES 7
#endif
    if (type == 0 && (ATT_TYPES & 1)) {
        const bf16_t* Q = (const bf16_t*)(p.ws + WS_G + G_MLQ) + q0 * 768 + hd * 192;
        const bf16_t* K = (const bf16_t*)(p.ws + WS_G + G_KF) + hd * 192;
        const bf16_t* V = (const bf16_t*)(p.ws + WS_G + G_MLKV) + hd * 256 + 128;
        bf16_t* O = (bf16_t*)(p.ws + WS_G + G_BR) + (size_t)2 * RB * 512 + q0 * 512 + hd * 128;
#ifndef ML_QL
#define ML_QL -1
#endif
#ifndef ATT_DMA
#define ATT_DMA 7
#endif
        if constexpr (ATT_DMA & 1) att::attn_body_dma<192, 768, 768, 1024, 512>(Q, K, V, O, seq, lds);
        else if constexpr (ML_QL < 0) att::attn_body_simple<192, 768, 768, 1024, 512>(Q, K, V, O, seq, lds);
        else att::attn_body<192, 768, 768, 1024, 512, (ML_QL < 0 ? 0 : ML_QL)>(Q, K, V, O, seq, lds);
    } else if (type == 1 && (ATT_TYPES & 2)) {
        const int kvh = hd >> 1;
        const bf16_t* Q = Z + q0 * ZW + Z_GQQ + hd * 128;
        const bf16_t* K = Z + Z_GQK + kvh * 128;
        const bf16_t* V = Z + Z_GQV + kvh * 128;
        bf16_t* O = (bf16_t*)(p.ws + WS_G + G_BR) + (size_t)1 * RB * 512 + q0 * 512 + hd * 128;
#ifndef GQ_SIMPLE
#define GQ_SIMPLE 1
#endif
        if constexpr (ATT_DMA & 2) att::attn_body_dma<128, ZW, ZW, ZW, 512>(Q, K, V, O, seq, lds);
        else if constexpr (GQ_SIMPLE) att::attn_body_simple<128, ZW, ZW, ZW, 512>(Q, K, V, O, seq, lds); else att::attn_body<128, ZW, ZW, ZW, 512>(Q, K, V, O, seq, lds);
    } else if (type == 2 && (ATT_TYPES & 4)) {
        const int h = hd >> 1, m = hd & 1;
        const bf16_t* Q = Z + q0 * ZW + Z_DAQ + h * 128 + m * 64;
        const bf16_t* K = Z + Z_DAK + h * 128 + m * 64;
        const bf16_t* V = Z + Z_DAV + h * 128;
        bf16_t* O = (bf16_t*)(p.ws + WS_G + (m == 0 ? G_A1 : G_A2)) + q0 * 512 + h * 128;
#ifndef DA_SIMPLE
#define DA_SIMPLE 0
#endif
        if constexpr (ATT_DMA & 4) att::attn_body_dma<64, ZW, ZW, ZW, 512>(Q, K, V, O, seq, lds);
        else if constexpr (DA_SIMPLE) att::attn_body_simple<64, ZW, ZW, ZW, 512>(Q, K, V, O, seq, lds); else att::attn_body<64, ZW, ZW, ZW, 512>(Q, K, V, O, seq, lds);
    }
}
#ifndef ATT_REP_TYPES
#define ATT_REP_TYPES 7
#endif
__device__ __forceinline__ void ph_attn(const Params& p, char* lds, int last, int tmask = 7) {
    const int G = gridDim.x, c = obid();
    for (int i = 0; i < 3; ++i) {
        int u;
        const int xcd = c & 7, jq = c >> 3;
        if (G == 256) u = i == 0 ? (xcd < 4 ? xcd * 32 + jq : 128 + (xcd - 4) * 32 + jq) : (i == 1 ? 256 + xcd * 32 + jq : ((c >= 128 && c < 144 && !last) ? 512 + (c - 128) : -1));
        else u = -1;
        if (u >= 0) { const int ty = u < 128 ? 1 : (u < 256 ? 2 : (u < 512 ? 4 : 7)); if (ty & tmask) attn_unit(p, u, lds); }
    }
    if (G != 256) for (int u = c; u < (last ? 512 : 528); u += G) attn_unit(p, u, lds);
}


#define XB_TMO      128
#define XB_XCNT(j)  (256  + 64 * (j))
#define XB_XSUB(j)  (1280 + 64 * (j))
#define XB_XGEN(j)  (2304 + 64 * (j))
#define XB_TOP      3328
#define XB_TOPGEN   3392
#define XCD_BAR_WORDS 3456
#define XB_SPIN_CAP (1u << 23)
__device__ __forceinline__ unsigned xb_ld(unsigned* p)              { return __hip_atomic_load(p, __ATOMIC_RELAXED, __HIP_MEMORY_SCOPE_AGENT); }
__device__ __forceinline__ unsigned xb_add(unsigned* p, unsigned v) { return __hip_atomic_fetch_add(p, v, __ATOMIC_RELAXED, __HIP_MEMORY_SCOPE_AGENT); }
__device__ __forceinline__ unsigned xb_xcc_id() { return (unsigned)__builtin_amdgcn_s_getreg((3 << 11) | 20) & 0xFu; }
#define XB_SPIN(cond, bar) do { unsigned _sp = 0; while (cond) { __builtin_amdgcn_s_sleep(1); \
    if ((++_sp & 255u) == 0u) { if (xb_ld(&(bar)[XB_TMO])) break; if (_sp > XB_SPIN_CAP) { atomicAdd(&(bar)[XB_TMO], 1u); break; } } } } while (0)
struct XcdBarrier { unsigned* bar; unsigned x; volatile LAS unsigned* st; };
__device__ __forceinline__ void xcd_barrier_complete(unsigned* bar, unsigned x, unsigned& nloc, unsigned& nx) {
    const unsigned G = gridDim.x * gridDim.y * gridDim.z;
    unsigned sum, cnt, mine, sp = 0u;
    for (;;) {
        sum = 0u; cnt = 0u; mine = 0u;
#pragma unroll
        for (unsigned j = 0; j < 16; ++j) { const unsigned c = xb_ld(&bar[XB_XCNT(j)]); sum += c; cnt += (c > 0u) ? 1u : 0u; mine = (j == x) ? c : mine; }
        if (sum == G) break;
        __builtin_amdgcn_s_sleep(1);
        if ((++sp & 255u) == 0u) { if (xb_ld(&bar[XB_TMO])) break; if (sp > XB_SPIN_CAP) { atomicAdd(&bar[XB_TMO], 1u); break; } }
    }
    nloc = mine > 0u ? mine : 1u; nx = cnt > 0u ? cnt : 1u;
}
__device__ __forceinline__ void xcd_barrier(const XcdBarrier& b) {
    asm volatile("s_waitcnt vmcnt(0)" ::: "memory");
    __syncthreads();
    if (otid() == 0) {
        unsigned* bar = b.bar;
        __builtin_amdgcn_s_waitcnt(0);
        unsigned nloc = b.st[0], nx = b.st[1];
        if (nloc == 0u) { xcd_barrier_complete(bar, b.x, nloc, nx); b.st[0] = nloc; b.st[1] = nx; }
        const unsigned old = xb_add(&bar[XB_XSUB(b.x)], 1u);
        const unsigned gen = old / nloc;
        if (old + 1u == (gen + 1u) * nloc) {
            __builtin_amdgcn_fence(__ATOMIC_RELEASE, "agent");
            asm volatile("s_waitcnt vmcnt(0)" ::: "memory");
            const unsigned og = xb_add(&bar[XB_TOP], 1u);
            const unsigned tg = og / nx;
            if (og + 1u == (tg + 1u) * nx) xb_add(&bar[XB_TOPGEN], 1u);
            else XB_SPIN(xb_ld(&bar[XB_TOPGEN]) == tg, bar);
            __builtin_amdgcn_fence(__ATOMIC_ACQUIRE, "agent");
            xb_add(&bar[XB_XGEN(b.x)], 1u);
            asm volatile("s_waitcnt vmcnt(0)" ::: "memory");
        } else {
            XB_SPIN(xb_ld(&bar[XB_XGEN(b.x)]) == gen, bar);
            __builtin_amdgcn_fence(__ATOMIC_ACQUIRE, "agent");
            asm volatile("s_waitcnt vmcnt(0)" ::: "memory");
        }
    }
    __syncthreads();
}

__global__ void __launch_bounds__(512, 2) mk_fwd(Params p0) {
    extern __shared__ __attribute__((aligned(16))) unsigned char lds_raw[];
    LAS unsigned char* lds = (LAS unsigned char*)lds_raw;
    cg::grid_group grid = cg::this_grid();
#define GSYNC() do { if (hi < 0) { asm volatile("s_waitcnt vmcnt(0) lgkmcnt(0)" ::: "memory"); grid.sync(); }     \
    else { XcdBarrier xb_; xb_.bar = (unsigned*)(load_params().ws + WS_BAR); xb_.x = xb_xcc_id(); xb_.st = (volatile LAS unsigned*)(lds + 131072 + 64); xcd_barrier(xb_); } } while (0)
    if (threadIdx.x == 0) { volatile LAS unsigned* st_ = (volatile LAS unsigned*)(lds + 131072 + 64); st_[0] = 0u; st_[1] = 0u;
        (void)xb_add(&((unsigned*)(p0.ws + WS_BAR))[XB_XCNT(xb_xcc_id())], 1u); }
    __syncthreads();
    const int lo = p0.lo, hi = p0.hi; int ph = 0; int layer = 0;
#ifndef PHASE_MASK
#define PHASE_MASK 0xFFFF
#endif
#ifndef REPEAT_MASK
#define REPEAT_MASK 0
#endif
#define PH_BEGIN(cat) if (ph >= lo && ph < hi) { constexpr int cat_ = (cat); (void)cat_; DIAG_T0(cat) if constexpr ((PHASE_MASK >> (cat)) & 1) for (int rep_ = 0; rep_ < (((REPEAT_MASK >> (cat)) & 1) ? 2 : 1); ++rep_) { if (rep_) GSYNC(); const Params p = load_params(); \
    unsigned char* ws = p.ws; float* MOD = (float*)(ws + WS_MOD); float* ctxb = (float*)(ws + WS_CTXB); bf16_t* H = (bf16_t*)(ws + WS_H); bf16_t* ABR = (bf16_t*)(ws + WS_ABR); \
    const bf16_t* Wl = (const bf16_t*)(ws + WS_W + layer * W_LAYER_B); const float* modl = MOD + (size_t)layer * 5 * MODW; \
    const float* xl_in = layer == 0 ? p.in[0] : p.out; const float* xc_in = layer == 0 ? p.in[2] : ctxb; \
    int lastl = layer; asm volatile("" : "+s"(lastl)); lastl = (lastl == 1) ? 1 : 0; \
    (void)MOD; (void)ctxb; (void)H; (void)ABR; (void)Wl; (void)modl; (void)xl_in; (void)xc_in; (void)lastl;
#if defined(DIAG_A_MASK)
#define DIAG_T0(cat) if (blockIdx.x == 0 && threadIdx.x == 0) { ((LAS unsigned long long*)(lds + LDS_BYTES - 64))[2] = __builtin_amdgcn_s_memrealtime(); }
#define DIAG_T1(cat) if (blockIdx.x == 0 && threadIdx.x == 0) { LAS unsigned long long* ta_ = (LAS unsigned long long*)(lds + LDS_BYTES - 64); const unsigned long long dt_ = __builtin_amdgcn_s_memrealtime() - ta_[2]; \
    if ((DIAG_A_MASK >> (cat)) & 1) ta_[0] += dt_; if ((DIAG_B_MASK >> (cat)) & 1) ta_[1] += dt_; }
#else
#define DIAG_T0(cat)
#define DIAG_T1(cat)
#endif
#define PH_END   } if (ph + 1 < hi) GSYNC(); DIAG_T1(cat_) } ++ph;
    const int G = gridDim.x, c = blockIdx.x;
#if defined(DIAG_A_MASK)
    if (threadIdx.x == 0) { LAS unsigned long long* ta_ = (LAS unsigned long long*)(lds + LDS_BYTES - 64); ta_[0] = 0; ta_[1] = 0; }
#endif

#if defined(EXTRA_SYNCS)
    for (int es = 0; es < EXTRA_SYNCS; ++es) GSYNC();
#endif
    PH_BEGIN(0) ph_prologue(p, lds); PH_END

    for (layer = 0; layer < 2; ++layer) {

        PH_BEGIN(1) ph_norm_mod(xl_in, xc_in, p.in[6] + layer * DM, modl, 0, H); PH_END

        PH_BEGIN(2) {
            pg8::Gemm g{H, Wl + W_IN, MTOT, 512, 1024}; pg8::StaticOrder S; S.init(MTOT, 512, G, c);
            pg8::Epi<pg8::E_STORE> E{}; E.a.O = (bf16_t*)(ws + WS_G + S_U); E.a.ldc = 512;
            pg8::gemm_phase(lds, g, S, E);
            { pg8::Gemm g2{H, Wl + W_IN + (size_t)512 * 1024, RB, ZW, 1024}; pg8::StaticOrder S2; S2.init(RB, ZW, G, (c + 160) % G);
              pg8::Epi<pg8::E_INPROJ> E2{}; E2.a.O = (bf16_t*)(ws + WS_G + G_Z); E2.a.ldc = ZW;
              pg8::gemm_phase(lds, g2, S2, E2); }
        } PH_END

        PH_BEGIN(3) { for (int u = c; u < 256; u += G) s5_chain(p, layer, u, lds); } PH_END

        PH_BEGIN(4) ph_s5_gelu(p, layer); PH_END

        PH_BEGIN(9) {
            pg8::Gemm g{(const bf16_t*)(ws + WS_G + S_U), Wl + W_GLU, MTOT, 512, 512}; pg8::StaticOrder S; S.init(MTOT, 512, G, c);
            pg8::Epi<pg8::E_GLU> E{}; E.a.O = ABR; E.a.ldc = 512; E.a.G = (const bf16_t*)(ws + WS_G + S_U); E.a.ldg = 512; E.a.bias = p.in[17] + layer * 512;
            pg8::gemm_phase(lds, g, S, E);
            ph_prep1(p, layer);
        } PH_END

        for (int gb = 0; gb < NB; ++gb) {
            const size_t grow0 = (size_t)gb * RB;
            if (gb > 0) {
            PH_BEGIN(10) {
                pg8::Gemm g{H + grow0 * DM, Wl + W_IN + (size_t)512 * 1024, RB, ZW, 1024}; pg8::StaticOrder S; S.init(RB, ZW, G, c);
                pg8::Epi<pg8::E_INPROJ> E{}; E.a.O = (bf16_t*)(ws + WS_G + G_Z); E.a.ldc = ZW;
                pg8::gemm_phase(lds, g, S, E);
            } PH_END

            PH_BEGIN(5) ph_prep1(p, layer); PH_END
            }

            PH_BEGIN(11) {
                { pg8::Gemm g{(const bf16_t*)(ws + WS_G + G_CQ), Wl + W_UQ, RB, 768, 256}; pg8::StaticOrder S; S.init(RB, 768, G, c);
                  pg8::Epi<pg8::E_STORE> E{}; E.a.O = (bf16_t*)(ws + WS_G + G_MLQ); E.a.ldc = 768;
                  pg8::gemm_phase(lds, g, S, E); }
                { pg8::Gemm g{(const bf16_t*)(ws + WS_G + G_CKV), Wl + W_UKV, RB, 1024, 128}; pg8::StaticOrder S; S.init(RB, 1024, G, (c + 128) % G);
                  pg8::Epi<pg8::E_STORE> E{}; E.a.O = (bf16_t*)(ws + WS_G + G_MLKV); E.a.ldc = 1024;
                  pg8::gemm_phase(lds, g, S, E); }
            } PH_END

            PH_BEGIN(6) ph_prep2(p, layer); PH_END

            PH_BEGIN(7) ph_attn(p, (char*)lds_raw, lastl, rep_ ? ATT_REP_TYPES : 7); PH_END

            PH_BEGIN(8) ph_subln(p, layer); PH_END

            PH_BEGIN(12) {
                const int vpm0 = gb * TPB, vpm1 = (int)((WS_G + G_BR - WS_ABR) / 262144);
                pg8::Gemm g{ABR, Wl + W_BR, RB, 1024, 512}; pg8::MergeOrder S{G, c, vpm0, vpm1, lastl};
                pg8::Epi<pg8::E_MERGE> E{}; E.a.O = H + grow0 * DM; E.a.ldc = DM; E.a.G = (const bf16_t*)(ws + WS_G + G_Z) + Z_GATE; E.a.ldg = ZW;
                E.a.MF = (float*)(ws + WS_G + G_MF); E.a.vpm0 = vpm0; E.a.vpm1 = vpm1;
                pg8::gemm_phase(lds, g, S, E);
            } PH_END
        }

        PH_BEGIN(13) {
            pg8::Gemm g{H, Wl + W_OUT, MTOT, 1024, 1024}; pg8::StaticOrder S; S.init(MTOT, 1024, G, c, lastl);
            pg8::Epi<pg8::E_RESID> E{}; E.a.xin_l = xl_in; E.a.xin_c = xc_in; E.a.xout_l = p.out; E.a.xout_c = ctxb; E.a.gate = modl + 2 * 1024;
            pg8::gemm_phase(lds, g, S, E);
        } PH_END

        PH_BEGIN(1) ph_norm_mod(p.out, ctxb, p.in[32] + layer * DM, modl, 3, H); PH_END

        PH_BEGIN(14) {
            pg8::Gemm g{H, Wl + W_FI, MTOT, 2 * DFF, 1024}; pg8::StaticOrder S; S.init(MTOT, 2 * DFF, G, c, lastl);
            pg8::Epi<pg8::E_SWIGLU> E{}; E.a.O = (bf16_t*)(ws + WS_G); E.a.ldc = DFF;
            pg8::gemm_phase(lds, g, S, E);
        } PH_END

        PH_BEGIN(15) {
            pg8::Gemm g{(const bf16_t*)(ws + WS_G), Wl + W_FO, MTOT, 1024, DFF}; pg8::StaticOrder S; S.init(MTOT, 1024, G, c, lastl);
            pg8::Epi<pg8::E_RESID> E{}; E.a.xin_l = p.out; E.a.xin_c = ctxb; E.a.xout_l = p.out; E.a.xout_c = ctxb; E.a.gate = modl + 5 * 1024;
            pg8::gemm_phase(lds, g, S, E);
        } PH_END
    }
#if defined(DIAG_A_MASK)
    GSYNC();
    if (blockIdx.x == 0) { LAS unsigned long long* ta_ = (LAS unsigned long long*)(lds + LDS_BYTES - 64);
        const float A = (float)ta_[0] * 0.01f, B = (float)ta_[1] * 0.01f;
        if (threadIdx.x == 0) p0.out[0] = A; else p0.out[threadIdx.x] = B; if (threadIdx.x > 0) p0.out[threadIdx.x + 511] = B; }
#endif
#undef PH_BEGIN
#undef PH_END
}
constexpr int N_PHASES = 1 + 2 * (5 + 4 * 7 + 4 - 2);

extern "C" void kernel_launch(void* const* d_in, const int* in_sizes, int n_in, void* d_out, int out_size, void* d_ws, size_t ws_size, hipStream_t stream) {
    static int grid = 0;
    if (grid == 0) {
        if (n_in != 35 || out_size != NB * SEQ * DM || ws_size < WS_END) { fprintf(stderr, "kernel_launch: bad shapes: n_in %d out %d ws %zu (need %zu)\n", n_in, out_size, ws_size, (size_t)WS_END); grid = -1; return; }
        int dev = 0, cus = 0, per_cu = 0;
        (void)hipGetDevice(&dev); (void)hipDeviceGetAttribute(&cus, hipDeviceAttributeMultiprocessorCount, dev);
        if (hipFuncSetAttribute((const void*)mk_fwd, hipFuncAttributeMaxDynamicSharedMemorySize, LDS_BYTES) != hipSuccess) { fprintf(stderr, "kernel_launch: hipFuncSetAttribute failed\n"); grid = -1; return; }
        (void)hipOccupancyMaxActiveBlocksPerMultiprocessor(&per_cu, (const void*)mk_fwd, 512, LDS_BYTES);
        (void)hipGetLastError();
        if (per_cu < 1) per_cu = 1;
        grid = cus;
    }
    if (grid < 0) return;
    if (hipMemsetAsync((char*)d_ws + WS_BAR, 0, 16384, stream) != hipSuccess) { fprintf(stderr, "kernel_launch: memset failed\n"); return; }
    Params p{};
    for (int i = 0; i < 35; ++i) p.in[i] = (const float*)d_in[i];
    p.out = (float*)d_out; p.ws = (unsigned char*)d_ws;
#if MK_MODE == 0
    p.lo = 0; p.hi = N_PHASES;
    void* args[] = {&p};
    hipError_t e = hipLaunchCooperativeKernel((const void*)mk_fwd, dim3(grid), dim3(512), args, LDS_BYTES, stream);
    if (e != hipSuccess) fprintf(stderr, "cooperative launch failed: %s (grid %d)\n", hipGetErrorString(e), grid);
#else
    for (int ph = 0; ph < N_PHASES; ++ph) {
        p.lo = ph; p.hi = ph + 1;
        hipLaunchKernelGGL(mk_fwd, dim3(grid), dim3(512), LDS_BYTES, stream, p);
    }
#endif
}
```

```cpp
#include <hip/hip_runtime.h>
#include <hip/hip_cooperative_groups.h>
#include <cstdio>
#include <cstdint>
namespace cg = cooperative_groups;

#ifndef MK_MODE
#define MK_MODE 0
#endif

#define LAS __attribute__((address_space(3)))
typedef unsigned short bf16_t;
typedef short bf16x8 __attribute__((ext_vector_type(8)));
typedef short s16x4 __attribute__((ext_vector_type(4)));
typedef float f32x4 __attribute__((ext_vector_type(4)));
typedef float f32x16 __attribute__((ext_vector_type(16)));
typedef unsigned u32x4 __attribute__((ext_vector_type(4)));
typedef unsigned u32x2 __attribute__((ext_vector_type(2)));

constexpr int DM = 1024, NB = 4, SEQ = 8192, CTX = 256, RB = SEQ + CTX  , MTOT = NB * RB  ;
constexpr int TPB = RB / 256;
constexpr int ZW = 7168;
constexpr int Z_DAQ = 0, Z_DAK = 512, Z_DAV = 1024, Z_GQQ = 1536, Z_GQK = 2048, Z_GQV = 2304, Z_CQ = 2560, Z_CKV = 2816, Z_KR = 2944, Z_GATE = 3072;
constexpr int DFF = 2816, MODW = 6144;
constexpr float EPS = 1e-6f;

constexpr size_t MiB = 1u << 20;
constexpr size_t al(size_t x) { return (x + MiB - 1) / MiB * MiB; }
constexpr size_t WS_MOD = 0;
constexpr size_t WS_ROPE64 = 256 * 1024, WS_ROPE128 = WS_ROPE64 + 128 * 16 * 8;
constexpr size_t WS_BAR = 512 * 1024;
constexpr size_t WS_CTXB = al(WS_MOD + 2 * 5 * MODW * 4);
constexpr size_t WS_W = WS_CTXB + 4 * MiB;
constexpr size_t W_IN = 0, W_UQ = W_IN + (size_t)7680 * 1024, W_UKV = W_UQ + 768 * 256, W_GLU = W_UKV + 1024 * 128, W_BR = W_GLU + 512 * 512,
                 W_OUT = W_BR + (size_t)4 * 1024 * 512, W_FI = W_OUT + (size_t)1024 * 1024, W_FO = W_FI + (size_t)5632 * 1024, W_LAYER = W_FO + (size_t)1024 * 2816;
constexpr size_t W_LAYER_B = al(W_LAYER * 2);
constexpr size_t WS_H = WS_W + 2 * W_LAYER_B;
constexpr size_t WS_ABR = WS_H + al((size_t)MTOT * 1024 * 2);
constexpr size_t WS_G = WS_ABR + al((size_t)MTOT * 512 * 2);
constexpr size_t G_Z = 0;
constexpr size_t G_CQ = al(G_Z + (size_t)RB * ZW * 2);
constexpr size_t G_CKV = al(G_CQ + (size_t)RB * 256 * 2);
constexpr size_t G_MLQ = al(G_CKV + (size_t)RB * 128 * 2);
constexpr size_t G_MLKV = al(G_MLQ + (size_t)RB * 768 * 2);
constexpr size_t G_KF = al(G_MLKV + (size_t)RB * 1024 * 2);
constexpr size_t G_A1 = al(G_KF + (size_t)RB * 768 * 2);
constexpr size_t G_A2 = al(G_A1 + (size_t)RB * 512 * 2);
constexpr size_t G_BR = al(G_A2 + (size_t)RB * 512 * 2);
constexpr size_t G_MF = al(G_BR + (size_t)3 * RB * 512 * 2);
constexpr size_t G_END = al(G_MF + (size_t)RB * 1024 * 4);
constexpr size_t S_SZ = al((size_t)MTOT * 512 * 2), S_U = G_MLQ  , S_YF = S_U + S_SZ, S_YR = S_YF + S_SZ, S_END = S_YR + S_SZ;
constexpr size_t HID_B = (size_t)MTOT * DFF * 2;
static_assert(S_END <= G_END && HID_B <= G_END, "aliases fit");
constexpr size_t WS_END = WS_G + G_END;
static_assert(WS_END <= (size_t)512 * MiB, "workspace budget");
static_assert((WS_G + G_BR - WS_ABR) % 262144 == 0, "merge virtual tiles");

constexpr int LDS_BYTES = 147456;

typedef __bf16 bf16x2n __attribute__((ext_vector_type(2)));
typedef float f32x2n __attribute__((ext_vector_type(2)));
__device__ __forceinline__ unsigned cvt_pk_bf16(float lo, float hi) { f32x2n v = {lo, hi}; bf16x2n b = __builtin_convertvector(v, bf16x2n); return __builtin_bit_cast(unsigned, b); }
__device__ __forceinline__ float bf2f(unsigned v) { return __uint_as_float(v << 16); }
__device__ __forceinline__ float bflo(unsigned w) { return __uint_as_float(w << 16); }
__device__ __forceinline__ float bfhi(unsigned w) { return __uint_as_float(w & 0xffff0000u); }
__device__ __forceinline__ bf16_t f2bf(float f) { return (bf16_t)(cvt_pk_bf16(f, 0.f) & 0xffffu); }
template <int O> __device__ __forceinline__ float swz_xor(float v) { return __int_as_float(__builtin_amdgcn_ds_swizzle(__float_as_int(v), 0x1f | (O << 10))); }
__device__ __forceinline__ float half_sum(float v) {
    v += swz_xor<1>(v); v += swz_xor<2>(v); v += swz_xor<4>(v); v += swz_xor<8>(v); v += swz_xor<16>(v); return v;
}
__device__ __forceinline__ float wave_sum(float v) {
    v = half_sum(v);
    auto rr = __builtin_amdgcn_permlane32_swap(__float_as_uint(v), __float_as_uint(v), false, false);
    return __uint_as_float(rr[0]) + __uint_as_float(rr[1]);
}
__device__ __forceinline__ int otid() { int t = threadIdx.x; asm volatile("" : "+v"(t)); return t; }
__device__ __forceinline__ float sigmoidf_(float x) { return __builtin_amdgcn_rcpf(1.f + __expf(-x)); }

__device__ __forceinline__ int obid() { int b = blockIdx.x; asm volatile("" : "+s"(b)); return b; }
struct Params { const float* in[35]; float* out; unsigned char* ws; int lo, hi; };
__device__ __forceinline__ Params load_params() {
#if defined(__HIP_DEVICE_COMPILE__)
    typedef const __attribute__((address_space(4))) Params* CP;
    CP q = (CP)__builtin_amdgcn_kernarg_segment_ptr(); asm volatile("" : "+s"(q));
    Params r;
#pragma unroll
    for (int i = 0; i < 35; ++i) r.in[i] = q->in[i];
    r.out = q->out; r.ws = q->ws; r.lo = q->lo; r.hi = q->hi; return r;
#else
    return Params{};
#endif
}

namespace pg8 {
constexpr int BM = 256, BK = 64, HALF = 128, HTB = HALF * BK * 2, STAGE_BYTES = 8 * HTB, NXCD = 8, WGM = 8;
__host__ __device__ __forceinline__ int lds_byte(int r, int c) { const int st = (r >> 4) * 2 + (c >> 5), rr = r & 15, cc = c & 31, ob = rr * 64 + cc * 2; return st * 1024 + (ob ^ (((ob >> 9) & 1) << 5)); }
__host__ __device__ __forceinline__ void stage_rc(int b, int& R, int& C) { const int st = b / 1024, sb = b % 1024, swz = sb ^ (((sb >> 9) & 1) << 5); R = (st >> 1) * 16 + swz / 64; C = (st & 1) * 32 + (swz % 64) / 2; }
__host__ __device__ __forceinline__ int perm32(int rho) { const int n = rho >> 4, i = rho & 15; return 8 * (i >> 2) + 4 * n + (i & 3); }
struct Unit { int pm, pn; };
struct Gemm { const bf16_t* A; const bf16_t* Bt; int M, N, K; };
struct StaticOrder {
    int nM, nN, nwg, G, c;
    int skip;
    __device__ void init(int M, int N, int G_, int c_, int skip_ = 0) { skip = skip_; nM = skip_ ? NB * (TPB - 1) : M / BM; nN = N / BM; nwg = nM * nN; G = G_; c = c_; }
    __device__ bool next(int i, Unit& u) const {
        const long L = (long)i * G + c; if (L >= nwg) return false;
        int wgid = (int)L; { const int q = nwg / NXCD, r = nwg % NXCD, xcd = wgid % NXCD, off = wgid / NXCD; wgid = (xcd < r ? xcd * (q + 1) : r * (q + 1) + (xcd - r) * q) + off; }
        const int nig = WGM * nN, gid = wgid / nig, fm = gid * WGM, gsz = (nM - fm) < WGM ? (nM - fm) : WGM;
        u.pm = fm + ((wgid % nig) % gsz); u.pn = (wgid % nig) / gsz; if (skip) u.pm += u.pm / (TPB - 1) + 1; return true;
    }
};
struct MergeOrder {
    int G, c, vpm0, vpm1, skip;
    __device__ bool next(int i, Unit& u) const {
        const int j = i >> 2, n = i & 3; const int L = j * G + c; if (L >= (TPB - skip) * 4) return false;
        const int pm = (L >> 2) + skip, pn = L & 3; u.pm = (n == 0 ? vpm0 : vpm1 + (n - 1) * TPB) + pm; u.pn = n * 4 + pn; return true;
    }
};

enum { E_STORE = 0, E_INPROJ = 1, E_GLU = 2, E_MERGE = 3, E_RESID = 4, E_SWIGLU = 5 };
struct EpiArgs {
    bf16_t* O; int ldc;
    const bf16_t* G; int ldg;
    const float* bias;
    float* MF;
    int vpm0, vpm1;
    const float* xin_l; const float* xin_c; float* xout_l; float* xout_c; const float* gate;
};
template <int MODE> struct Epi {
    EpiArgs a;
    __device__ __forceinline__ void operator()(const f32x4 (&acc)[2][2][4][2], const Unit& u, int, int, int, int) const {
        const int t_ = otid(), wid_ = __builtin_amdgcn_readfirstlane(t_ >> 6), wr = wid_ >> 2, wc = wid_ & 3, fr = t_ & 15, fq = (t_ & 63) >> 4;
        int pm = u.pm, pn = u.pn, nbr = 0;
        if (MODE == E_MERGE) { nbr = u.pn >> 2; pn = u.pn & 3; pm = u.pm - (nbr == 0 ? a.vpm0 : a.vpm1 + (nbr - 1) * TPB); }
        const int row0 = pm * BM + wr * 64 + fr;
        const int col0 = (MODE == E_SWIGLU ? pn * 128 : pn * BM) + wc * 32 + 8 * fq;
        const float* xin = nullptr; float* xout = nullptr; const float* gv = nullptr;
        if (MODE == E_RESID) {
            const int b = pm / TPB, t = pm - b * TPB;
            if (t == 0) { xin = a.xin_c + (size_t)b * CTX * DM; xout = a.xout_c + (size_t)b * CTX * DM; gv = a.gate + 4 * MODW; }
            else { xin = a.xin_l + ((size_t)b * SEQ + (size_t)(t - 1) * 256) * DM; xout = a.xout_l + ((size_t)b * SEQ + (size_t)(t - 1) * 256) * DM; gv = a.gate + b * MODW; }
        }
        if (MODE == E_SWIGLU || MODE == E_STORE || MODE == E_INPROJ) {
#pragma unroll
            for (int ai = 0; ai < 2; ++ai)
#pragma unroll
                for (int m = 0; m < 4; ++m) {
                    const int row = row0 + ai * HALF + m * 16;
                    if (MODE == E_SWIGLU) {
                        const f32x4 g0 = acc[ai][0][m][0], g1 = acc[ai][0][m][1], u0 = acc[ai][1][m][0], u1 = acc[ai][1][m][1];
                        float h[8];
#pragma unroll
                        for (int e = 0; e < 4; ++e) { h[e] = g0[e] * sigmoidf_(g0[e]) * u0[e]; h[4 + e] = g1[e] * sigmoidf_(g1[e]) * u1[e]; }
                        u32x4 w; w.x = cvt_pk_bf16(h[0], h[1]); w.y = cvt_pk_bf16(h[2], h[3]); w.z = cvt_pk_bf16(h[4], h[5]); w.w = cvt_pk_bf16(h[6], h[7]);
                        *(u32x4*)(a.O + (size_t)row * a.ldc + col0) = w;
                        continue;
                    }
#pragma unroll
                    for (int bj = 0; bj < 2; ++bj) {
                        const int col = col0 + bj * HALF;
                        f32x4 v0 = acc[ai][bj][m][0], v1 = acc[ai][bj][m][1];
                        if (MODE == E_INPROJ && pn >= 12) {
#pragma unroll
                            for (int e = 0; e < 4; ++e) { v0[e] = sigmoidf_(v0[e]); v1[e] = sigmoidf_(v1[e]); }
                        }
                        u32x4 w; w.x = cvt_pk_bf16(v0[0], v0[1]); w.y = cvt_pk_bf16(v0[2], v0[3]); w.z = cvt_pk_bf16(v1[0], v1[1]); w.w = cvt_pk_bf16(v1[2], v1[3]);
                        *(u32x4*)(a.O + (size_t)row * a.ldc + col) = w;
                    }
                }
            return;
        }
        f32x4 gb0[2], gb1[2];
#pragma unroll
        for (int bj = 0; bj < 2; ++bj) {
            const int col = col0 + bj * HALF;
            if (MODE == E_GLU) { gb0[bj] = *(const f32x4*)(a.bias + col); gb1[bj] = *(const f32x4*)(a.bias + col + 4); }
            else if (MODE == E_RESID) { gb0[bj] = *(const f32x4*)(gv + col); gb1[bj] = *(const f32x4*)(gv + col + 4); }
            else { gb0[bj] = (f32x4){0.f, 0.f, 0.f, 0.f}; gb1[bj] = gb0[bj]; }
        }
#pragma unroll
        for (int ai = 0; ai < 2; ++ai)
#pragma unroll
            for (int mp = 0; mp < 2; ++mp) {
                u32x4 gw[2][2]; f32x4 xa[2][2], xb[2][2];
#pragma unroll
                for (int mm = 0; mm < 2; ++mm)
#pragma unroll
                    for (int bj = 0; bj < 2; ++bj) {
                        const int row = row0 + ai * HALF + (mp * 2 + mm) * 16, col = col0 + bj * HALF;
                        if (MODE == E_GLU) gw[mm][bj] = *(const u32x4*)(a.G + (size_t)row * a.ldg + col);
                        if (MODE == E_MERGE) { gw[mm][bj] = *(const u32x4*)(a.G + (size_t)row * a.ldg + nbr * 1024 + col);
                            if (nbr != 0) { const u32x4 mw = *(const u32x4*)((const bf16_t*)a.MF + (size_t)row * 1024 + col);
                                xa[mm][bj] = (f32x4){bflo(mw.x), bfhi(mw.x), bflo(mw.y), bfhi(mw.y)}; xb[mm][bj] = (f32x4){bflo(mw.z), bfhi(mw.z), bflo(mw.w), bfhi(mw.w)}; } }
                        if (MODE == E_RESID) { const int lr = row - pm * BM; xa[mm][bj] = *(const f32x4*)(xin + (size_t)lr * DM + col); xb[mm][bj] = *(const f32x4*)(xin + (size_t)lr * DM + col + 4); }
                    }
#pragma unroll
                for (int mm = 0; mm < 2; ++mm)
#pragma unroll
                    for (int bj = 0; bj < 2; ++bj) {
                        const int m = mp * 2 + mm; const int row = row0 + ai * HALF + m * 16, col = col0 + bj * HALF;
                        const f32x4 v0 = acc[ai][bj][m][0], v1 = acc[ai][bj][m][1];
                        if (MODE == E_GLU) {
                            const u32x4 g = gw[mm][bj]; const f32x4 b0 = gb0[bj], b1 = gb1[bj];
                            float o[8];
                            o[0] = bflo(g.x) * sigmoidf_(v0[0] + b0[0]); o[1] = bfhi(g.x) * sigmoidf_(v0[1] + b0[1]);
                            o[2] = bflo(g.y) * sigmoidf_(v0[2] + b0[2]); o[3] = bfhi(g.y) * sigmoidf_(v0[3] + b0[3]);
                            o[4] = bflo(g.z) * sigmoidf_(v1[0] + b1[0]); o[5] = bfhi(g.z) * sigmoidf_(v1[1] + b1[1]);
                            o[6] = bflo(g.w) * sigmoidf_(v1[2] + b1[2]); o[7] = bfhi(g.w) * sigmoidf_(v1[3] + b1[3]);
                            u32x4 w; w.x = cvt_pk_bf16(o[0], o[1]); w.y = cvt_pk_bf16(o[2], o[3]); w.z = cvt_pk_bf16(o[4], o[5]); w.w = cvt_pk_bf16(o[6], o[7]);
                            *(u32x4*)(a.O + (size_t)row * a.ldc + col) = w;
                        } else if (MODE == E_MERGE) {
                            const u32x4 g = gw[mm][bj];
                            f32x4 p0, p1;
                            p0[0] = bflo(g.x) * v0[0]; p0[1] = bfhi(g.x) * v0[1]; p0[2] = bflo(g.y) * v0[2]; p0[3] = bfhi(g.y) * v0[3];
                            p1[0] = bflo(g.z) * v1[0]; p1[1] = bfhi(g.z) * v1[1]; p1[2] = bflo(g.w) * v1[2]; p1[3] = bfhi(g.w) * v1[3];
                            if (nbr != 0) { p0 = p0 + xa[mm][bj]; p1 = p1 + xb[mm][bj]; }
                            u32x4 w; w.x = cvt_pk_bf16(p0[0], p0[1]); w.y = cvt_pk_bf16(p0[2], p0[3]); w.z = cvt_pk_bf16(p1[0], p1[1]); w.w = cvt_pk_bf16(p1[2], p1[3]);
                            if (nbr != 3) *(u32x4*)((bf16_t*)a.MF + (size_t)row * 1024 + col) = w;
                            else *(u32x4*)(a.O + (size_t)row * a.ldc + col) = w;
                        } else if (MODE == E_RESID) {
                            const int lr = row - pm * BM;
                            *(f32x4*)(xout + (size_t)lr * DM + col) = xa[mm][bj] + gb0[bj] * v0;
                            *(f32x4*)(xout + (size_t)lr * DM + col + 4) = xb[mm][bj] + gb1[bj] * v1;
                        }
                    }
            }
    }
};

template <class EpiT, class Sched>
__device__ __forceinline__ void gemm_phase(LAS unsigned char* lds, const Gemm g, const Sched& S, const EpiT& E) {
    int tid_ = threadIdx.x; asm volatile("" : "+v"(tid_));
    const int tid = tid_, wid = __builtin_amdgcn_readfirstlane(tid >> 6), lane = tid & 63, wr = wid >> 2, wc = wid & 3, fr = lane & 15, fq = lane >> 4;
    const int K = g.K, nt = K / BK;
    unsigned voffA[2], voffB[2];
#pragma unroll
    for (int i = 0; i < 2; ++i) { int R, C; stage_rc(tid * 16 + i * 8192, R, C); const int Rb = (R & ~31) + perm32(R & 31);
        voffA[i] = (unsigned)(R * K + C) * 2u; voffB[i] = (unsigned)(Rb * K + C) * 2u; }
    const size_t kstep = (size_t)(BK * 2);
    const size_t hstep = (size_t)HALF * K * 2;
    const size_t tstep = 2 * hstep;
    const unsigned ldsw = (unsigned)wid * 1024u;
    const int aoff = lds_byte(wr * 64 + fr, fq * 8), boff = lds_byte(wc * 32 + fr, fq * 8);
#define PG8_SA(b, h) (((b) * 2 + (h)) * HTB)
#define PG8_SB(b, h) ((4 + (b) * 2 + (h)) * HTB)
#define PG8_STAGE(bufoff, gbase, voff) do { _Pragma("unroll") for (int _i = 0; _i < 2; ++_i) \
        __builtin_amdgcn_global_load_lds((const unsigned*)((const char*)(gbase) + (voff)[_i]), (LAS unsigned*)(lds + (bufoff) + ldsw + _i * 8192), 16, 0, 0); } while (0)
#define PG8_LDA(dst, b, h) do { _Pragma("unroll") for (int m = 0; m < 4; ++m) _Pragma("unroll") for (int k = 0; k < 2; ++k) dst[m][k] = *(const LAS bf16x8*)(lds + PG8_SA(b, h) + aoff + m * 2048 + k * 1024); } while (0)
#define PG8_LDB(dst, b, h) do { _Pragma("unroll") for (int n = 0; n < 2; ++n) _Pragma("unroll") for (int k = 0; k < 2; ++k) dst[n][k] = *(const LAS bf16x8*)(lds + PG8_SB(b, h) + boff + n * 2048 + k * 1024); } while (0)
#define PG8_MMA(ai, bj, At, Bt) do { __builtin_amdgcn_s_setprio(1); _Pragma("unroll") for (int m = 0; m < 4; ++m) _Pragma("unroll") for (int n = 0; n < 2; ++n) _Pragma("unroll") for (int k = 0; k < 2; ++k) \
        acc[ai][bj][m][n] = __builtin_amdgcn_mfma_f32_16x16x32_bf16(Bt[n][k], At[m][k], acc[ai][bj][m][n], 0, 0, 0); __builtin_amdgcn_s_setprio(0); } while (0)
#define PG8_WAIT_V(n) asm volatile("s_waitcnt vmcnt(" #n ")" ::: "memory")
#define PG8_WAIT_L(n) asm volatile("s_waitcnt lgkmcnt(" #n ")" ::: "memory")
#define PG8_BAR __builtin_amdgcn_s_barrier()
#define PG8_SCHED __builtin_amdgcn_sched_barrier(0)
    Unit cur, nxt; int ui = 0;
    if (!S.next(0, cur)) return;
    f32x4 acc[2][2][4][2];
#pragma unroll
    for (int a = 0; a < 2; ++a)
#pragma unroll
        for (int b = 0; b < 2; ++b)
#pragma unroll
            for (int m = 0; m < 4; ++m)
#pragma unroll
                for (int n = 0; n < 2; ++n) acc[a][b][m][n] = (f32x4){0.f, 0.f, 0.f, 0.f};
    bf16x8 At[4][2], B0[2][2], B1[2][2];
    const char* cA = (const char*)g.A + (size_t)cur.pm * tstep; const char* cB = (const char*)g.Bt + (size_t)cur.pn * tstep;
    PG8_STAGE(PG8_SB(0, 0), cB, voffB); PG8_STAGE(PG8_SB(0, 1), cB + hstep, voffB); PG8_STAGE(PG8_SA(0, 0), cA, voffA); PG8_STAGE(PG8_SA(0, 1), cA + hstep, voffA);
    if (wr == 1) PG8_BAR;
    PG8_WAIT_V(2); PG8_BAR;
    PG8_STAGE(PG8_SB(1, 0), cB + kstep, voffB); PG8_STAGE(PG8_SA(1, 0), cA + kstep, voffA); PG8_STAGE(PG8_SB(1, 1), cB + hstep + kstep, voffB);
    PG8_WAIT_V(6); PG8_BAR;
    for (;;) {
        const bool has_next = S.next(ui + 1, nxt);
        const char* nA = has_next ? (const char*)g.A + (size_t)nxt.pm * tstep : cA; const char* nB = has_next ? (const char*)g.Bt + (size_t)nxt.pn * tstep : cB;
        for (int t = 0; t < nt; t += 2) {
            const bool last = (t == nt - 2);
            const char* a1 = cA + (size_t)(t + 1) * kstep;
            const char* a2 = last ? nA : cA + (size_t)(t + 2) * kstep; const char* b2 = last ? nB : cB + (size_t)(t + 2) * kstep;
            const char* a3 = a2 + kstep; const char* b3 = b2 + kstep;
            PG8_LDB(B0, 0, 0); PG8_LDB(B1, 0, 1); PG8_SCHED; PG8_LDA(At, 0, 0); PG8_STAGE(PG8_SA(1, 1), a1 + hstep, voffA);
            PG8_WAIT_V(8); PG8_WAIT_L(0); PG8_BAR; PG8_MMA(0, 0, At, B0); PG8_MMA(0, 1, At, B1); PG8_BAR; PG8_SCHED;
            PG8_LDA(At, 0, 1); PG8_STAGE(PG8_SB(0, 0), b2, voffB); PG8_STAGE(PG8_SB(0, 1), b2 + hstep, voffB); PG8_STAGE(PG8_SA(0, 0), a2, voffA);
            PG8_WAIT_V(8); PG8_WAIT_L(0); PG8_BAR; PG8_MMA(1, 0, At, B0); PG8_MMA(1, 1, At, B1); PG8_BAR; PG8_SCHED;
            PG8_LDB(B0, 1, 0); PG8_LDB(B1, 1, 1); PG8_SCHED; PG8_LDA(At, 1, 0); PG8_STAGE(PG8_SA(0, 1), a2 + hstep, voffA);
            PG8_WAIT_V(8); PG8_WAIT_L(0); PG8_BAR; PG8_MMA(0, 0, At, B0); PG8_MMA(0, 1, At, B1); PG8_BAR; PG8_SCHED;
            PG8_LDA(At, 1, 1); PG8_STAGE(PG8_SB(1, 0), b3, voffB); PG8_STAGE(PG8_SB(1, 1), b3 + hstep, voffB); PG8_STAGE(PG8_SA(1, 0), a3, voffA);
            PG8_WAIT_V(8); PG8_WAIT_L(0); PG8_BAR; PG8_MMA(1, 0, At, B0); PG8_MMA(1, 1, At, B1); PG8_BAR; PG8_SCHED;
        }
        if (wr == 0) PG8_BAR;
        E(acc, cur, wr, wc, fr, fq);
        if (!has_next) break;
#pragma unroll
        for (int a = 0; a < 2; ++a)
#pragma unroll
            for (int b = 0; b < 2; ++b)
#pragma unroll
                for (int m = 0; m < 4; ++m)
#pragma unroll
                    for (int n = 0; n < 2; ++n) acc[a][b][m][n] = (f32x4){0.f, 0.f, 0.f, 0.f};
        cur = nxt; cA = nA; cB = nB; ++ui;
        if (wr == 1) PG8_BAR;
    }
    PG8_WAIT_V(0);
    PG8_BAR;
#undef PG8_SA
#undef PG8_SB
#undef PG8_STAGE
#undef PG8_LDA
#undef PG8_LDB
#undef PG8_MMA
#undef PG8_WAIT_V
#undef PG8_WAIT_L
#undef PG8_BAR
#undef PG8_SCHED
}
}

#ifndef QKT_SB_FROM
#define QKT_SB_FROM 100000
#endif
#ifndef QKT_SB_EVERY
#define QKT_SB_EVERY 4
#endif
#ifndef ATT_SD1_FROM
#define ATT_SD1_FROM 128
#endif
namespace att {
constexpr int NW = 8, QBLK = 32, KVBLK = 64;
constexpr float THR = 8.f;
constexpr int SHM_V = KVBLK * 128 * 2;
#define SBAR() __builtin_amdgcn_sched_barrier(0)
__device__ __forceinline__ int crow(int r, int hi) { return (r & 3) + 8 * (r >> 2) + 4 * hi; }
template <int DQK> __device__ __forceinline__ constexpr float scale_of() { return DQK == 64 ? 0.125f : (DQK == 128 ? 0.088388347648318440f : 0.072168783648703220f); }

template <int DQK>
__device__ __forceinline__ void partialSM(f32x16& p0, f32x16& p1, float& m_reg, float& mn, float& alpha) {
    constexpr float SCALE = scale_of<DQK>();
    constexpr float C = SCALE * 1.4426950408889634f;
    float pmax = p0[0];
#pragma unroll
    for (int r = 1; r < 16; ++r) pmax = fmaxf(pmax, p0[r]);
#pragma unroll
    for (int r = 0; r < 16; ++r) pmax = fmaxf(pmax, p1[r]);
    { auto rr = __builtin_amdgcn_permlane32_swap(__float_as_uint(pmax), __float_as_uint(pmax), false, false);
      pmax = fmaxf(__uint_as_float(rr[0]), __uint_as_float(rr[1])); }
    if (__builtin_expect(__all(pmax - m_reg <= THR / SCALE), 1)) { mn = m_reg; alpha = 1.f; }
    else { mn = fmaxf(m_reg, pmax); alpha = __builtin_amdgcn_exp2f((m_reg - mn) * C); m_reg = mn; }
    float mnC = -mn * C;
#pragma unroll
    for (int r = 0; r < 16; ++r) p0[r] = fmaf(p0[r], C, mnC);
#pragma unroll
    for (int r = 0; r < 16; ++r) p1[r] = fmaf(p1[r], C, mnC);
#pragma unroll
    for (int r = 0; r < 16; ++r) p0[r] = __builtin_amdgcn_exp2f(p0[r]);
}
__device__ __forceinline__ void finishSM(f32x16& p0, f32x16& p1, float alpha, float& l_reg, bf16x8& pa0, bf16x8& pa1, bf16x8& pa2, bf16x8& pa3) {
#pragma unroll
    for (int r = 0; r < 16; ++r) p1[r] = __builtin_amdgcn_exp2f(p1[r]);
    float ps = 0;
#pragma unroll
    for (int r = 0; r < 16; ++r) ps += p0[r];
#pragma unroll
    for (int r = 0; r < 16; ++r) ps += p1[r];
    { auto rr = __builtin_amdgcn_permlane32_swap(__float_as_uint(ps), __float_as_uint(ps), false, false);
      ps = __uint_as_float(rr[0]) + __uint_as_float(rr[1]); }
    l_reg = l_reg * alpha + ps;
#define PK4(P, BASE, OUT) do { unsigned a0 = cvt_pk_bf16(P[BASE + 0], P[BASE + 1]), a1 = cvt_pk_bf16(P[BASE + 2], P[BASE + 3]);   \
    unsigned b0 = cvt_pk_bf16(P[BASE + 4], P[BASE + 5]), b1 = cvt_pk_bf16(P[BASE + 6], P[BASE + 7]);                              \
    auto r0 = __builtin_amdgcn_permlane32_swap(a0, b0, false, false); auto r1 = __builtin_amdgcn_permlane32_swap(a1, b1, false, false); \
    u32x4 w = {r0[0], r1[0], r0[1], r1[1]}; OUT = *reinterpret_cast<bf16x8*>(&w); } while (0)
    PK4(p0, 0, pa0); PK4(p0, 8, pa1); PK4(p1, 0, pa2); PK4(p1, 8, pa3);
#undef PK4
}
template <int DQK> __device__ __forceinline__ int kswz(int row) { return DQK == 128 ? ((row & 15) << 4) : (((row >> 1) & 7) << 4); }
template <int DQK, int QL = 0>
__device__ __forceinline__ void qkt(f32x16& p0, f32x16& p1, const char* Ks, const bf16x8* qr, int r32, int hi, const char* Qs = nullptr) {
    p0 = f32x16{}; p1 = f32x16{};
#pragma unroll
    for (int d0 = 0; d0 < DQK / 16; ++d0) { const int cb = (d0 * 16 + hi * 8) * 2;
        bf16x8 b0 = *reinterpret_cast<const bf16x8*>(Ks + r32 * (DQK * 2) + (cb ^ kswz<DQK>(r32)));
        bf16x8 b1 = *reinterpret_cast<const bf16x8*>(Ks + (32 + r32) * (DQK * 2) + (cb ^ kswz<DQK>(32 + r32)));
        bf16x8 q;
        if (d0 < DQK / 16 - QL) q = qr[d0]; else q = *reinterpret_cast<const bf16x8*>(Qs + (d0 - (DQK / 16 - QL)) * 1024);
        p0 = __builtin_amdgcn_mfma_f32_32x32x16_bf16(b0, q, p0, 0, 0, 0);
        p1 = __builtin_amdgcn_mfma_f32_32x32x16_bf16(b1, q, p1, 0, 0, 0);
        if (DQK > QKT_SB_FROM && (d0 % QKT_SB_EVERY) == QKT_SB_EVERY - 1) SBAR(); }
}
__device__ __forceinline__ int v_st(int k, int c) { const int kk = (k & ~0xC) | ((k & 4) << 1) | ((k & 8) >> 1); return ((kk >> 3) * 4 + (c >> 5)) * 512 + ((kk & 7) * 32 + (c & 31)) * 2; }
__device__ __forceinline__ int v_rd_base(int lane) { return ((lane & 3) << 3) | (((lane >> 2) & 3) << 6) | (((lane >> 4) & 1) << 5) | (((lane >> 5) & 1) << 8); }
constexpr int v_rd_off(int d0, int ks, int half) { return d0 * 512 + ks * 4096 + half * 2048; }
template <int OFF> __device__ __forceinline__ s16x4 tr_read(int vb) {
    s16x4 r; asm volatile("ds_read_b64_tr_b16 %0, %1 offset:%2" : "=&v"(r) : "v"(vb), "i"(OFF) : "memory"); return r;
}
template <int D0> __device__ __forceinline__ void pv_one(f32x16& od, int vb, bf16x8 pa0, bf16x8 pa1, bf16x8 pa2, bf16x8 pa3) {
    const s16x4 l0 = tr_read<v_rd_off(D0, 0, 0)>(vb), h0 = tr_read<v_rd_off(D0, 0, 1)>(vb), l1 = tr_read<v_rd_off(D0, 1, 0)>(vb), h1 = tr_read<v_rd_off(D0, 1, 1)>(vb);
    const s16x4 l2 = tr_read<v_rd_off(D0, 2, 0)>(vb), h2 = tr_read<v_rd_off(D0, 2, 1)>(vb), l3 = tr_read<v_rd_off(D0, 3, 0)>(vb), h3 = tr_read<v_rd_off(D0, 3, 1)>(vb);
    asm volatile("s_waitcnt lgkmcnt(0)" ::: "memory"); SBAR();
#define PK(L, H) (bf16x8){L[0], L[1], L[2], L[3], H[0], H[1], H[2], H[3]}
    od = __builtin_amdgcn_mfma_f32_32x32x16_bf16(pa0, PK(l0, h0), od, 0, 0, 0);
    od = __builtin_amdgcn_mfma_f32_32x32x16_bf16(pa1, PK(l1, h1), od, 0, 0, 0);
    od = __builtin_amdgcn_mfma_f32_32x32x16_bf16(pa2, PK(l2, h2), od, 0, 0, 0);
    od = __builtin_amdgcn_mfma_f32_32x32x16_bf16(pa3, PK(l3, h3), od, 0, 0, 0);
#undef PK
}
__device__ __forceinline__ void pv_d0(f32x16* o, int vb, bf16x8 pa0, bf16x8 pa1, bf16x8 pa2, bf16x8 pa3) {
    pv_one<0>(o[0], vb, pa0, pa1, pa2, pa3); pv_one<1>(o[1], vb, pa0, pa1, pa2, pa3); pv_one<2>(o[2], vb, pa0, pa1, pa2, pa3); pv_one<3>(o[3], vb, pa0, pa1, pa2, pa3);
}

template <int DQK, int ldq, int ldk, int ldv, int ldo, int QL = 0>
__device__ __forceinline__ void attn_body(const bf16_t* __restrict__ Qb, const bf16_t* __restrict__ Kh, const bf16_t* __restrict__ Vh,
                                          bf16_t* __restrict__ Ob, int seq, char* lds) {
    constexpr int SHM_K = KVBLK * DQK * 2, NKC = DQK / 64, SD = (DQK >= ATT_SD1_FROM) ? 1 : 2, CPR = DQK / 8;
    int tid_ = threadIdx.x; asm volatile("" : "+v"(tid_));
    const int tid = tid_, wid = tid >> 6, lane = tid & 63, r32 = lane & 31, hi = lane >> 5;
    char* V_lds = lds; char* K_lds = lds + 2 * SHM_V;
    float* ws = (float*)(lds + 2 * SHM_V + 2 * SHM_K) + wid * 64; float* li_l = ws; float* al_l = ws + 32;
    constexpr int NQR = DQK / 16 - QL;
    float m_reg = -1e30f, l_reg = 0; f32x16 o[4] = {}; bf16x8 qr[NQR];
    const bf16_t* Qw = Qb + (long)(wid * QBLK + r32) * ldq + hi * 8;
#pragma unroll
    for (int d0 = 0; d0 < NQR; ++d0) qr[d0] = *reinterpret_cast<const bf16x8*>(Qw + d0 * 16);
    char* Qs = lds + 2 * SHM_V + 2 * SHM_K + NW * 256 + wid * (QL * 1024) + lane * 16;
#pragma unroll
    for (int d0 = 0; d0 < QL; ++d0) *reinterpret_cast<bf16x8*>(Qs + d0 * 1024) = *reinterpret_cast<const bf16x8*>(Qw + (NQR + d0) * 16);
    const int sr = tid >> 4, sc = (tid & 15) * 8, vst0 = v_st(sr, sc), vst1 = v_st(32 + sr, sc);
    unsigned koff[NKC]; int kdst[NKC];
    const unsigned voffV0 = (unsigned)(sr * ldv + sc) * 2u, voffV1 = (unsigned)((32 + sr) * ldv + sc) * 2u;
#pragma unroll
    for (int kc = 0; kc < NKC; ++kc) { const int ci = tid + 512 * kc; const int krow = ci / CPR, kcol = (ci % CPR) * 8; koff[kc] = (unsigned)(krow * ldk + kcol) * 2u;
        kdst[kc] = krow * (DQK * 2) + ((kcol * 2) ^ kswz<DQK>(krow)); }
    const int vb0 = (int)(uintptr_t)V_lds + v_rd_base(lane);
    struct { bf16x8 vs0, vs1, ks[NKC]; } sr_[SD];
#define SLOAD(i, k0) do { const char* vb_ = (const char*)Vh + (size_t)(k0) * (ldv * 2); const char* kb_ = (const char*)Kh + (size_t)(k0) * (ldk * 2); \
    sr_[i].vs0 = *reinterpret_cast<const bf16x8*>(vb_ + voffV0); sr_[i].vs1 = *reinterpret_cast<const bf16x8*>(vb_ + voffV1); \
    _Pragma("unroll") for (int kc_ = 0; kc_ < NKC; ++kc_) sr_[i].ks[kc_] = *reinterpret_cast<const bf16x8*>(kb_ + koff[kc_]); } while (0)
#define SWRITE(b, i) do { *(bf16x8*)(V_lds + (b) * SHM_V + vst0) = sr_[i].vs0; *(bf16x8*)(V_lds + (b) * SHM_V + vst1) = sr_[i].vs1; \
    _Pragma("unroll") for (int kc_ = 0; kc_ < NKC; ++kc_) *(bf16x8*)(K_lds + (b) * SHM_K + kdst[kc_]) = sr_[i].ks[kc_]; } while (0)
#define SWAIT() do { if constexpr (SD == 2) asm volatile("s_waitcnt vmcnt(%0)" :: "n"(2 + NKC) : "memory"); else asm volatile("s_waitcnt vmcnt(0)" ::: "memory"); } while (0)
#define RESC(a) do { if (__any((a) < 1.f)) { if (hi == 0) al_l[r32] = (a); asm volatile("s_waitcnt lgkmcnt(0)" ::: "memory"); \
    _Pragma("unroll") for (int d = 0; d < 4; ++d) _Pragma("unroll") for (int r = 0; r < 16; ++r) o[d][r] *= al_l[crow(r, hi)]; } } while (0)
    f32x16 pA0, pA1, pB0, pB1; float mnA, mnB, alA, alB; bf16x8 pa0, pa1, pa2, pa3; const int NT = seq / KVBLK;
    constexpr int SE = 0, SO = SD - 1;
    SLOAD(SE, 0); asm volatile("s_waitcnt vmcnt(0)" ::: "memory"); SWRITE(0, SE); __syncthreads();
    qkt<DQK, QL>(pA0, pA1, K_lds, qr, r32, hi, Qs); partialSM<DQK>(pA0, pA1, m_reg, mnA, alA);
    SLOAD(SO, KVBLK); if constexpr (SD == 2) { if (2 < NT) SLOAD(SE, 2 * KVBLK); }
    SWAIT(); SWRITE(1, SO); __syncthreads();
    for (int j = 1; j + 1 < NT; j += 2) {
        SBAR(); qkt<DQK, QL>(pB0, pB1, K_lds + SHM_K, qr, r32, hi, Qs);
        finishSM(pA0, pA1, alA, l_reg, pa0, pa1, pa2, pa3); SBAR();
        SLOAD(SO, (j + SD) * KVBLK); SBAR();
        pv_d0(o, vb0, pa0, pa1, pa2, pa3); partialSM<DQK>(pB0, pB1, m_reg, mnB, alB);
        __syncthreads(); SWAIT(); SWRITE(0, SE);
        RESC(alB); __syncthreads();
        SBAR(); qkt<DQK, QL>(pA0, pA1, K_lds, qr, r32, hi, Qs);
        finishSM(pB0, pB1, alB, l_reg, pa0, pa1, pa2, pa3); SBAR();
        if (SD == 1 || j + 3 < NT) SLOAD(SE, (j + 1 + SD) * KVBLK); SBAR();
        pv_d0(o, vb0 + (int)SHM_V, pa0, pa1, pa2, pa3); partialSM<DQK>(pA0, pA1, m_reg, mnA, alA);
        __syncthreads(); SWAIT(); SWRITE(1, SO);
        RESC(alA); __syncthreads();
    }
    SBAR(); qkt<DQK, QL>(pB0, pB1, K_lds + SHM_K, qr, r32, hi, Qs);
    finishSM(pA0, pA1, alA, l_reg, pa0, pa1, pa2, pa3); SBAR();
    pv_d0(o, vb0, pa0, pa1, pa2, pa3); partialSM<DQK>(pB0, pB1, m_reg, mnB, alB);
    __syncthreads(); RESC(alB);
    finishSM(pB0, pB1, alB, l_reg, pa0, pa1, pa2, pa3); SBAR();
    pv_d0(o, vb0 + (int)SHM_V, pa0, pa1, pa2, pa3);
    if (hi == 0) li_l[r32] = l_reg; asm volatile("s_waitcnt lgkmcnt(0)" ::: "memory");
    float rli[16];
#pragma unroll
    for (int r = 0; r < 16; ++r) rli[r] = __builtin_amdgcn_rcpf(li_l[crow(r, hi)]);
    bf16_t* Ow = Ob + (long)(wid * QBLK) * ldo;
#pragma unroll
    for (int r = 0; r < 16; ++r) { const int orow = crow(r, hi);
#pragma unroll
        for (int d0 = 0; d0 < 4; ++d0) Ow[(long)orow * ldo + d0 * 32 + r32] = f2bf(o[d0][r] * rli[r]); }
    __syncthreads();
#undef SLOAD
#undef SWRITE
#undef SWAIT
#undef RESC
}

template <int DQK, int ldq, int ldk, int ldv, int ldo>
__device__ __forceinline__ void attn_body_simple(const bf16_t* __restrict__ Qb, const bf16_t* __restrict__ Kh, const bf16_t* __restrict__ Vh,
                                                 bf16_t* __restrict__ Ob, int seq, char* lds) {
    constexpr int SHM_K = KVBLK * DQK * 2, NKC = DQK / 64, CPR = DQK / 8;
    int tid_ = threadIdx.x; asm volatile("" : "+v"(tid_));
    const int tid = tid_, wid = tid >> 6, lane = tid & 63, r32 = lane & 31, hi = lane >> 5;
    char* V_lds = lds; char* K_lds = lds + 2 * SHM_V;
    float* ws = (float*)(lds + 2 * SHM_V + 2 * SHM_K) + wid * 64; float* li_l = ws; float* al_l = ws + 32;
    float m_reg = -1e30f, l_reg = 0; f32x16 o[4] = {}; bf16x8 qr[DQK / 16];
    const bf16_t* Qw = Qb + (long)(wid * QBLK + r32) * ldq + hi * 8;
#pragma unroll
    for (int d0 = 0; d0 < DQK / 16; ++d0) qr[d0] = *reinterpret_cast<const bf16x8*>(Qw + d0 * 16);
    const int sr = tid >> 4, sc = (tid & 15) * 8, vst0 = v_st(sr, sc), vst1 = v_st(32 + sr, sc);
    unsigned koff[NKC]; int kdst[NKC];
    const unsigned voffV0 = (unsigned)(sr * ldv + sc) * 2u, voffV1 = (unsigned)((32 + sr) * ldv + sc) * 2u;
#pragma unroll
    for (int kc = 0; kc < NKC; ++kc) { const int ci = tid + 512 * kc; const int krow = ci / CPR, kcol = (ci % CPR) * 8; koff[kc] = (unsigned)(krow * ldk + kcol) * 2u;
        kdst[kc] = krow * (DQK * 2) + ((kcol * 2) ^ kswz<DQK>(krow)); }
    const int vb0 = (int)(uintptr_t)V_lds + v_rd_base(lane);
    bf16x8 vs0, vs1, ks[NKC];
#define SLOAD1(k0) do { const char* vb_ = (const char*)Vh + (size_t)(k0) * (ldv * 2); const char* kb_ = (const char*)Kh + (size_t)(k0) * (ldk * 2); \
    vs0 = *reinterpret_cast<const bf16x8*>(vb_ + voffV0); vs1 = *reinterpret_cast<const bf16x8*>(vb_ + voffV1); \
    _Pragma("unroll") for (int kc_ = 0; kc_ < NKC; ++kc_) ks[kc_] = *reinterpret_cast<const bf16x8*>(kb_ + koff[kc_]); } while (0)
#define SWRITE1(b) do { *(bf16x8*)(V_lds + (b) * SHM_V + vst0) = vs0; *(bf16x8*)(V_lds + (b) * SHM_V + vst1) = vs1; \
    _Pragma("unroll") for (int kc_ = 0; kc_ < NKC; ++kc_) *(bf16x8*)(K_lds + (b) * SHM_K + kdst[kc_]) = ks[kc_]; } while (0)
    f32x16 pA0, pA1; float mnA, alA; bf16x8 pa0, pa1, pa2, pa3; const int NT = seq / KVBLK;
    SLOAD1(0); asm volatile("s_waitcnt vmcnt(0)" ::: "memory"); SWRITE1(0); __syncthreads();
    for (int j = 0; j < NT; ++j) {
        const int buf = j & 1;
        if (j + 1 < NT) SLOAD1((j + 1) * KVBLK);
        SBAR();
        qkt<DQK>(pA0, pA1, K_lds + buf * SHM_K, qr, r32, hi);
        partialSM<DQK>(pA0, pA1, m_reg, mnA, alA);
        if (__any(alA < 1.f)) { if (hi == 0) al_l[r32] = alA; asm volatile("s_waitcnt lgkmcnt(0)" ::: "memory");
#pragma unroll
            for (int d = 0; d < 4; ++d)
#pragma unroll
                for (int r = 0; r < 16; ++r) o[d][r] *= al_l[crow(r, hi)]; }
        finishSM(pA0, pA1, alA, l_reg, pa0, pa1, pa2, pa3); SBAR();
        pv_d0(o, vb0 + buf * (int)SHM_V, pa0, pa1, pa2, pa3);
        if (j + 1 < NT) { asm volatile("s_waitcnt vmcnt(0)" ::: "memory"); SWRITE1(buf ^ 1); }
        __syncthreads();
    }
    if (hi == 0) li_l[r32] = l_reg; asm volatile("s_waitcnt lgkmcnt(0)" ::: "memory");
    float rli[16];
#pragma unroll
    for (int r = 0; r < 16; ++r) rli[r] = __builtin_amdgcn_rcpf(li_l[crow(r, hi)]);
    bf16_t* Ow = Ob + (long)(wid * QBLK) * ldo;
#pragma unroll
    for (int r = 0; r < 16; ++r) { const int orow = crow(r, hi);
#pragma unroll
        for (int d0 = 0; d0 < 4; ++d0) Ow[(long)orow * ldo + d0 * 32 + r32] = f2bf(o[d0][r] * rli[r]); }
    __syncthreads();
#undef SLOAD1
#undef SWRITE1
}

template <int DQK, int ldq, int ldk, int ldv, int ldo>
__device__ __forceinline__ void attn_body_dma(const bf16_t* __restrict__ Qb, const bf16_t* __restrict__ Kh, const bf16_t* __restrict__ Vh,
                                              bf16_t* __restrict__ Ob, int seq, char* lds) {
    constexpr int SHM_K = KVBLK * DQK * 2, NKC = DQK / 64;
    int tid_ = threadIdx.x; asm volatile("" : "+v"(tid_));
    const int tid = tid_, wid = __builtin_amdgcn_readfirstlane(tid >> 6), lane = tid & 63, r32 = lane & 31, hi = lane >> 5;
    char* V_lds = lds; char* K_lds = lds + 2 * SHM_V;
    float* ws = (float*)(lds + 2 * SHM_V + 2 * SHM_K) + wid * 64; float* li_l = ws; float* al_l = ws + 32;
    float m_reg = -1e30f, l_reg = 0; f32x16 o[4] = {}; bf16x8 qr[DQK / 16];
    const bf16_t* Qw = Qb + (long)(wid * QBLK + r32) * ldq + hi * 8;
#pragma unroll
    for (int d0 = 0; d0 < DQK / 16; ++d0) qr[d0] = *reinterpret_cast<const bf16x8*>(Qw + d0 * 16);
    unsigned vsrc[2], ksrc[NKC];
#pragma unroll
    for (int i = 0; i < 2; ++i) { const int o_ = i * 8192 + tid * 16; const int sub = o_ >> 9, w_ = (o_ & 511) >> 1; const int kk = (sub >> 2) * 8 + (w_ >> 5), c = (sub & 3) * 32 + (w_ & 31);
        const int k = (kk & ~0xC) | ((kk & 4) << 1) | ((kk & 8) >> 1); vsrc[i] = (unsigned)(k * ldv + c) * 2u; }
#pragma unroll
    for (int i = 0; i < NKC; ++i) { const int o_ = i * 8192 + tid * 16; const int row = o_ / (DQK * 2), b = o_ % (DQK * 2); const int cb = b ^ kswz<DQK>(row);
        ksrc[i] = (unsigned)(row * ldk) * 2u + (unsigned)cb; }
    const unsigned vdst = (unsigned)(uintptr_t)V_lds + (unsigned)wid * 1024u, kdst0 = (unsigned)(uintptr_t)K_lds + (unsigned)wid * 1024u;
    const int vb0 = (int)(uintptr_t)V_lds + v_rd_base(lane);
#define DMA_TILE(k0, b) do { const char* vb_ = (const char*)Vh + (size_t)(k0) * (ldv * 2); const char* kb_ = (const char*)Kh + (size_t)(k0) * (ldk * 2); \
    _Pragma("unroll") for (int i_ = 0; i_ < 2; ++i_) __builtin_amdgcn_global_load_lds((const unsigned*)(vb_ + vsrc[i_]), (LAS unsigned*)(vdst + (b) * SHM_V + i_ * 8192), 16, 0, 0); \
    _Pragma("unroll") for (int i_ = 0; i_ < NKC; ++i_) __builtin_amdgcn_global_load_lds((const unsigned*)(kb_ + ksrc[i_]), (LAS unsigned*)(kdst0 + (b) * SHM_K + i_ * 8192), 16, 0, 0); } while (0)
    f32x16 pA0, pA1; float mnA, alA; bf16x8 pa0, pa1, pa2, pa3; const int NT = seq / KVBLK;
    DMA_TILE(0, 0); asm volatile("s_waitcnt vmcnt(0)" ::: "memory"); __syncthreads();
    for (int j = 0; j < NT; ++j) {
        const int buf = j & 1;
        SBAR();
        qkt<DQK>(pA0, pA1, K_lds + buf * SHM_K, qr, r32, hi);
        SBAR();
        partialSM<DQK>(pA0, pA1, m_reg, mnA, alA);
        SBAR();
        if (j + 1 < NT) DMA_TILE((j + 1) * KVBLK, buf ^ 1);
        SBAR();
        if (__any(alA < 1.f)) { if (hi == 0) al_l[r32] = alA; asm volatile("s_waitcnt lgkmcnt(0)" ::: "memory");
#pragma unroll
            for (int d = 0; d < 4; ++d)
#pragma unroll
                for (int r = 0; r < 16; ++r) o[d][r] *= al_l[crow(r, hi)]; }
        finishSM(pA0, pA1, alA, l_reg, pa0, pa1, pa2, pa3); SBAR();
        pv_d0(o, vb0 + buf * (int)SHM_V, pa0, pa1, pa2, pa3);
        asm volatile("s_waitcnt vmcnt(0)" ::: "memory");
        __syncthreads();
    }
    if (hi == 0) li_l[r32] = l_reg; asm volatile("s_waitcnt lgkmcnt(0)" ::: "memory");
    float rli[16];
#pragma unroll
    for (int r = 0; r < 16; ++r) rli[r] = __builtin_amdgcn_rcpf(li_l[crow(r, hi)]);
    bf16_t* Ow = Ob + (long)(wid * QBLK) * ldo;
#pragma unroll
    for (int r = 0; r < 16; ++r) { const int orow = crow(r, hi);
#pragma unroll
        for (int d0 = 0; d0 < 4; ++d0) Ow[(long)orow * ldo + d0 * 32 + r32] = f2bf(o[d0][r] * rli[r]); }
    __syncthreads();
#undef DMA_TILE
}
}

__device__ __forceinline__ unsigned pk2(float lo, float hi) { return cvt_pk_bf16(lo, hi); }

__device__ __forceinline__ void transpose_mat(const float* W, int K, int Nsrc, bf16_t* WT, int Ndst, int mode, LAS float* scr, int gw, int NGW, int lane) {
    const int nblk = Ndst / 32, nitems = (K / 64) * nblk;
    for (int item = gw; item < nitems; item += NGW) {
        const int kb = item / nblk, nb = item % nblk, k0 = 64 * kb, n0 = 32 * nb;
        int s0 = n0;
        if (mode == 1) s0 = n0 < 3520 ? n0 : (n0 < 3584 ? -1 : n0 - 64);
        if (mode == 2) { const int pn = n0 >> 8, j = n0 & 255; s0 = j < 128 ? 128 * pn + j : DFF + 128 * pn + (j - 128); }
        float wv[32];
#pragma unroll
        for (int i = 0; i < 32; ++i) { const int kk = 2 * i + (lane >> 5); wv[i] = s0 < 0 ? 0.f : W[(size_t)(k0 + kk) * Nsrc + s0 + (lane & 31)]; }
#pragma unroll
        for (int i = 0; i < 32; ++i) { const int kk = 2 * i + (lane >> 5); scr[kk * 33 + (lane & 31)] = wv[i]; }
        asm volatile("s_waitcnt lgkmcnt(0)" ::: "memory");
        const int c = lane & 7;
#pragma unroll
        for (int j = 0; j < 4; ++j) { const int n = (lane >> 3) + 8 * j; const LAS float* s = scr + (8 * c) * 33 + n;
            u32x4 o; o.x = pk2(s[0 * 33], s[1 * 33]); o.y = pk2(s[2 * 33], s[3 * 33]); o.z = pk2(s[4 * 33], s[5 * 33]); o.w = pk2(s[6 * 33], s[7 * 33]);
            *(u32x4*)(WT + (size_t)(n0 + n) * K + k0 + 8 * c) = o; }
        asm volatile("s_waitcnt lgkmcnt(0)" ::: "memory");
    }
}

__device__ __forceinline__ void ph_prologue(const Params& p, LAS unsigned char* lds) {
    const int tid = otid(), wave = tid >> 6, lane = tid & 63;
    const int gw = obid() * 8 + wave, NGW = gridDim.x * 8;
    LAS float* scr = (LAS float*)(lds + wave * 16384);
    for (int l = 0; l < 2; ++l) {
        bf16_t* Wl = (bf16_t*)(p.ws + WS_W + l * W_LAYER_B);
        transpose_mat(p.in[7] + (size_t)l * 1024 * 7616, 1024, 7616, Wl + W_IN, 7680, 1, scr, gw, NGW, lane);
        transpose_mat(p.in[26] + (size_t)l * 256 * 768, 256, 768, Wl + W_UQ, 768, 0, scr, gw, NGW, lane);
        transpose_mat(p.in[27] + (size_t)l * 128 * 1024, 128, 1024, Wl + W_UKV, 1024, 0, scr, gw, NGW, lane);
        transpose_mat(p.in[16] + (size_t)l * 512 * 512, 512, 512, Wl + W_GLU, 512, 0, scr, gw, NGW, lane);
        for (int n = 0; n < 4; ++n) transpose_mat(p.in[30] + ((size_t)l * 4 + n) * 512 * 1024, 512, 1024, Wl + W_BR + (size_t)n * 1024 * 512, 1024, 0, scr, gw, NGW, lane);
        transpose_mat(p.in[31] + (size_t)l * 1024 * 1024, 1024, 1024, Wl + W_OUT, 1024, 0, scr, gw, NGW, lane);
        transpose_mat(p.in[33] + (size_t)l * 1024 * 5632, 1024, 5632, Wl + W_FI, 5632, 2, scr, gw, NGW, lane);
        transpose_mat(p.in[34] + (size_t)l * 2816 * 1024, 2816, 1024, Wl + W_FO, 1024, 0, scr, gw, NGW, lane);
    }
    {
        typedef float f32x2t __attribute__((ext_vector_type(2)));
        f32x2t* T64 = (f32x2t*)(p.ws + WS_ROPE64); f32x2t* T128 = (f32x2t*)(p.ws + WS_ROPE128);
        for (int idx = obid() * 512 + tid; idx < 128 * 16 + 128 * 32; idx += gridDim.x * 512) {
            if (idx < 128 * 16) { const int pos = idx >> 4, k = idx & 15; const float ang = (float)pos * exp2f(-(float)(4 * k) * (13.287712379549449f / 64)); T64[idx] = (f32x2t){cosf(ang), sinf(ang)}; }
            else { const int i2 = idx - 128 * 16, pos = i2 >> 5, k = i2 & 31; const float ang = (float)pos * exp2f(-(float)(4 * k) * (13.287712379549449f / 128)); T128[i2] = (f32x2t){cosf(ang), sinf(ang)}; }
        }
    }
    __syncthreads();
    LAS float* sc = (LAS float*)lds;
    LAS float* part = (LAS float*)(lds + 32768);
    float* MOD = (float*)(p.ws + WS_MOD);
    for (int it = obid(); it < 2 * 96; it += gridDim.x) {
        const int l = it / 96, cb = it % 96;
        for (int idx = tid; idx < 5 * 1024; idx += 512) { const int mi = idx >> 10, k = idx & 1023; const float v = mi < 4 ? p.in[1][mi * 1024 + k] : p.in[3][k]; sc[idx] = v / (1.f + __expf(-v)); }
        __syncthreads();
        const int j = cb * 64 + lane; const float* wm = p.in[4] + (size_t)l * 1024 * MODW + j;
        float a0 = 0, a1 = 0, a2 = 0, a3 = 0, a4 = 0;
#pragma unroll 32
        for (int kk = 0; kk < 128; ++kk) { const int k = wave * 128 + kk; const float w = wm[(size_t)k * MODW];
            a0 += sc[k] * w; a1 += sc[1024 + k] * w; a2 += sc[2048 + k] * w; a3 += sc[3072 + k] * w; a4 += sc[4096 + k] * w; }
        part[(wave * 5 + 0) * 64 + lane] = a0; part[(wave * 5 + 1) * 64 + lane] = a1; part[(wave * 5 + 2) * 64 + lane] = a2; part[(wave * 5 + 3) * 64 + lane] = a3; part[(wave * 5 + 4) * 64 + lane] = a4;
        __syncthreads();
        if (tid < 320) { const int mi = tid >> 6, jj = tid & 63; float s = 0;
#pragma unroll
            for (int w = 0; w < 8; ++w) s += part[(w * 5 + mi) * 64 + jj];
            MOD[((size_t)l * 5 + mi) * MODW + cb * 64 + jj] = s + p.in[5][l * MODW + cb * 64 + jj]; }
        __syncthreads();
    }
}

__device__ __forceinline__ const float* row_src(int R, const float* xl, const float* xc, int& mi) {
    const int b = R / RB, s = R - b * RB;
    if (s < CTX) { mi = 4; return xc + ((size_t)b * CTX + s) * DM; }
    mi = b; return xl + ((size_t)b * SEQ + (s - CTX)) * DM;
}
__device__ __forceinline__ void nm_finish(const f32x4 (&v)[4], int R, int mi, int lane, const float* gain, const float* modl, int sh_chunk, bf16_t* H) {
    const float* shp = modl + (size_t)mi * MODW + sh_chunk * 1024; const float* scp = shp + 1024;
    float ss = 0.f;
#pragma unroll
    for (int j = 0; j < 4; ++j) ss += (v[j].x * v[j].x + v[j].y * v[j].y) + (v[j].z * v[j].z + v[j].w * v[j].w);
    const float rs = rsqrtf(wave_sum(ss) * (1.f / DM) + EPS);
#pragma unroll
    for (int j = 0; j < 4; ++j) { const int c = j * 256 + lane * 4;
        const f32x4 g = *(const f32x4*)(gain + c), sh = *(const f32x4*)(shp + c), sc = *(const f32x4*)(scp + c);
        const f32x4 y = (v[j] * rs * g) * (sc + 1.0f) + sh;
        u32x2 w; w.x = cvt_pk_bf16(y.x, y.y); w.y = cvt_pk_bf16(y.z, y.w);
        *(u32x2*)(H + (size_t)R * DM + c) = w; }
}
__device__ __forceinline__ void ph_norm_mod(const float* xl, const float* xc, const float* gain, const float* modl, int sh_chunk, bf16_t* H) {
    const int tid = otid(); const int lane = tid & 63, gw = obid() * 8 + (tid >> 6), NGW = gridDim.x * 8;
    for (int R = gw; R < MTOT; R += 2 * NGW) {
        const int R2 = R + NGW; const bool has2 = R2 < MTOT;
        int mi, mi2 = 0; const float* xr = row_src(R, xl, xc, mi); const float* xr2 = has2 ? row_src(R2, xl, xc, mi2) : xr;
        f32x4 v[4], v2[4];
#pragma unroll
        for (int j = 0; j < 4; ++j) v[j] = *(const f32x4*)(xr + j * 256 + lane * 4);
#pragma unroll
        for (int j = 0; j < 4; ++j) v2[j] = *(const f32x4*)(xr2 + j * 256 + lane * 4);
        nm_finish(v, R, mi, lane, gain, modl, sh_chunk, H);
        if (has2) nm_finish(v2, R2, mi2, lane, gain, modl, sh_chunk, H);
    }
}

__device__ __forceinline__ int s5_pos(int i, int dir) { return dir == 0 ? i : (i < CTX ? (CTX - 1 - i) : (RB + CTX - 1 - i)); }
__device__ __forceinline__ void s5_chain(const Params& p, int layer, int unit, LAS unsigned char* lds) {
    const int b = unit >> 6, dir = (unit >> 5) & 1, g = unit & 31;
    const int tid = otid(), wid = tid >> 6, lane = tid & 63, fr = lane & 15, quad = lane >> 4;
    LAS float* BU = (LAS float*)lds;
    LAS bf16_t* Hb = (LAS bf16_t*)(lds + 65536);
    const int ldg = ((layer * 2 + dir) * 32 + g);
    const float* lam_re = p.in[8] + (size_t)ldg * 64; const float* lam_im = p.in[9] + (size_t)ldg * 64;
    const float dt = expf(p.in[10][ldg]);
    const float* bre = p.in[11] + (size_t)ldg * 64 * 16; const float* bim = p.in[12] + (size_t)ldg * 64 * 16;
    const float* cre = p.in[13] + (size_t)ldg * 16 * 64; const float* cim = p.in[14] + (size_t)ldg * 16 * 64;
    const bf16_t* U = (const bf16_t*)(p.ws + WS_G + S_U) + (size_t)b * RB * 512 + g * 16;
    bf16_t* Y = (bf16_t*)(p.ws + WS_G + (dir == 0 ? S_YF : S_YR)) + ((size_t)g * MTOT + (size_t)b * RB) * 16;
    const int cb0 = (wid & 3) * 2;
    bf16x8 bop[2] = {{0, 0, 0, 0, 0, 0, 0, 0}, {0, 0, 0, 0, 0, 0, 0, 0}};
#pragma unroll
    for (int t = 0; t < 2; ++t) {
        const int cb = cb0 + t, pst = (cb & 3) * 16 + fr; const float lr = lam_re[pst], li = lam_im[pst];
        const float mag = expf(lr * dt); const float abr = mag * cosf(li * dt), abi = mag * sinf(li * dt);
        const float den = lr * lr + li * li, nr = abr - 1.f, ni = abi;
        const float cr = (nr * lr + ni * li) / den, ci = (ni * lr - nr * li) / den;
        if (quad < 2) {
#pragma unroll
            for (int j = 0; j < 8; ++j) { const int c = quad * 8 + j; const float br_ = bre[pst * 16 + c], bi_ = bim[pst * 16 + c];
                const float v = (cb < 4) ? cr * br_ - ci * bi_ : cr * bi_ + ci * br_; bop[t][j] = (short)f2bf(v); }
        }
    }
    float ar, ai, hr = 0.f, hi = 0.f;
    { const float lr = lam_re[lane], li = lam_im[lane]; const float mag = expf(lr * dt); ar = mag * cosf(li * dt); ai = mag * sinf(li * dt); }
    bf16x8 cop[4];
#pragma unroll
    for (int ks = 0; ks < 4; ++ks)
#pragma unroll
        for (int j = 0; j < 8; ++j) { const int k = ks * 32 + quad * 8 + j; const float v = (k & 1) ? -cim[fr * 64 + (k >> 1)] : cre[fr * 64 + (k >> 1)]; cop[ks][j] = (short)f2bf(v); }
#define S5_LD(chunk, A_) do { _Pragma("unroll") for (int rb = 0; rb < 4; ++rb) { const int s_ = s5_pos((chunk) * 64 + rb * 16 + fr, dir); \
        A_[rb] = (bf16x8){0, 0, 0, 0, 0, 0, 0, 0}; if (quad < 2) A_[rb] = *(const bf16x8*)(U + (size_t)s_ * 512 + quad * 8); } } while (0)
#define S5_MM(A_, BUb) do { _Pragma("unroll") for (int rb = 0; rb < 4; ++rb) { \
        _Pragma("unroll") for (int t = 0; t < 2; ++t) { f32x4 acc = {0.f, 0.f, 0.f, 0.f}; acc = __builtin_amdgcn_mfma_f32_16x16x32_bf16(A_[rb], bop[t], acc, 0, 0, 0); \
            _Pragma("unroll") for (int j = 0; j < 4; ++j) (BUb)[(rb * 16 + quad * 4 + j) * 128 + (cb0 + t) * 16 + fr] = acc[j]; } } } while (0)
#define S5_C(chunk, Hbb, rb) do { f32x4 acc = {0.f, 0.f, 0.f, 0.f}; \
        _Pragma("unroll") for (int ks = 0; ks < 4; ++ks) { const bf16x8 aop = *(const LAS bf16x8*)((Hbb) + ((rb) * 16 + fr) * 136 + ks * 32 + quad * 8); \
            acc = __builtin_amdgcn_mfma_f32_16x16x32_bf16(aop, cop[ks], acc, 0, 0, 0); } \
        _Pragma("unroll") for (int j = 0; j < 4; ++j) { const int s_ = s5_pos((chunk) * 64 + (rb) * 16 + quad * 4 + j, dir); Y[(size_t)s_ * 16 + fr] = f2bf(acc[j]); } } while (0)
    constexpr int NCH = RB / 64;
    bf16x8 ua[4], ub[4];
    if (wid >= 4) { S5_LD(0, ua); S5_MM(ua, BU); S5_LD(1, ua); }
    __syncthreads();
    for (int k = 0; k < NCH; ++k) {
        LAS float* BUc = BU + (k & 1) * 8192; LAS bf16_t* Hbc = Hb + (k & 1) * (64 * 136);
        if (wid == 0) {
#pragma unroll
            for (int hf = 0; hf < 2; ++hf) {
                float brv[32], biv[32];
#pragma unroll
                for (int i = 0; i < 32; ++i) { brv[i] = BUc[(hf * 32 + i) * 128 + lane]; biv[i] = BUc[(hf * 32 + i) * 128 + 64 + lane]; }
#pragma unroll
                for (int i = 0; i < 32; ++i) {
                    const float nr = fmaf(ar, hr, fmaf(-ai, hi, brv[i])), ni = fmaf(ar, hi, fmaf(ai, hr, biv[i]));
                    hr = nr; hi = ni;
                    *(LAS unsigned*)(Hbc + (hf * 32 + i) * 136 + 2 * lane) = cvt_pk_bf16(hr, hi);
                }
            }
        } else if (wid >= 4) {
            if (k + 1 < NCH) { LAS float* BUn = BU + ((k + 1) & 1) * 8192;
                if (k + 2 < NCH) S5_LD(k + 2, ub);
                S5_MM(ua, BUn);
#pragma unroll
                for (int rb = 0; rb < 4; ++rb) ua[rb] = ub[rb]; }
        } else if (k > 0) {
            LAS bf16_t* Hbp = Hb + ((k - 1) & 1) * (64 * 136);
            S5_C(k - 1, Hbp, wid - 1);
            if (wid == 1) S5_C(k - 1, Hbp, 3);
        }
        __syncthreads();
    }
    if (wid >= 1 && wid < 4) { LAS bf16_t* Hbp = Hb + ((NCH - 1) & 1) * (64 * 136); S5_C(NCH - 1, Hbp, wid - 1); if (wid == 1) S5_C(NCH - 1, Hbp, 3); }
    __syncthreads();
#undef S5_LD
#undef S5_MM
#undef S5_C
}

__device__ __forceinline__ u32x4 gelu8(const u32x4 u, const u32x4 yf, const u32x4 yr, const float* d, int c) {
    float o[8];
#pragma unroll
    for (int e = 0; e < 4; ++e) {
        const float y0 = d[c + 2 * e] * bflo(u[e]) + bflo(yf[e]) + bflo(yr[e]);
        const float y1 = d[c + 2 * e + 1] * bfhi(u[e]) + bfhi(yf[e]) + bfhi(yr[e]);
        o[2 * e] = y0 * sigmoidf_(1.5957691216057308f * (y0 + 0.044715f * y0 * y0 * y0));
        o[2 * e + 1] = y1 * sigmoidf_(1.5957691216057308f * (y1 + 0.044715f * y1 * y1 * y1));
    }
    u32x4 w; w.x = cvt_pk_bf16(o[0], o[1]); w.y = cvt_pk_bf16(o[2], o[3]); w.z = cvt_pk_bf16(o[4], o[5]); w.w = cvt_pk_bf16(o[6], o[7]);
    return w;
}
__device__ __forceinline__ void ph_s5_gelu(const Params& p, int layer) {
    bf16_t* U = (bf16_t*)(p.ws + WS_G + S_U); const bf16_t* YF = (const bf16_t*)(p.ws + WS_G + S_YF); const bf16_t* YR = (const bf16_t*)(p.ws + WS_G + S_YR);
    const float* d = p.in[15] + layer * 512;
    const size_t n8 = (size_t)MTOT * 512 / 8, stride = (size_t)gridDim.x * 512;
    const int tid = otid();
    for (size_t i = (size_t)obid() * 512 + tid; i < n8; i += 2 * stride) {
        const size_t i2 = i + stride; const bool has2 = i2 < n8; const size_t ib = has2 ? i2 : i;
        const int c = (int)(i & 63) * 8, c2 = (int)(ib & 63) * 8;
        const size_t yo = ((size_t)(c >> 4) * MTOT + (i >> 6)) * 16 + (c & 15), yo2 = ((size_t)(c2 >> 4) * MTOT + (ib >> 6)) * 16 + (c2 & 15);
        const u32x4 u = *(const u32x4*)(U + i * 8), yf = *(const u32x4*)(YF + yo), yr = *(const u32x4*)(YR + yo);
        const u32x4 ub = *(const u32x4*)(U + ib * 8), yfb = *(const u32x4*)(YF + yo2), yrb = *(const u32x4*)(YR + yo2);
        *(u32x4*)(U + i * 8) = gelu8(u, yf, yr, d, c);
        if (has2) *(u32x4*)(U + ib * 8) = gelu8(ub, yfb, yrb, d, c2);
    }
}

template <int NP> __device__ __forceinline__ void seg_load(const bf16_t* in, int ncols, int lane, unsigned (&w)[NP]) {
#pragma unroll
    for (int i = 0; i < NP; ++i) w[i] = (128 * i + 2 * lane < ncols) ? *(const unsigned*)(in + 128 * i + 2 * lane) : 0u;
}
template <int CW, int NP>
__device__ __forceinline__ void seg_fin(const unsigned (&w)[NP], bf16_t* out, int ncols, const float* gain, bool rope, int t, int lane, const float* rtab = nullptr) {
#pragma unroll
    for (int i = 0; i < NP; ++i) {
        const bool valid = 128 * i + 2 * lane < ncols;
        const float x0 = bflo(w[i]), x1 = bfhi(w[i]);
        float ss = x0 * x0 + x1 * x1;
        ss = (CW == 64) ? half_sum(ss) : wave_sum(ss);
        const float rs = rsqrtf(ss * (1.f / CW) + EPS);
        const int e = (2 * lane) % CW;
        float y0 = x0 * rs * gain[e], y1 = x1 * rs * gain[e + 1];
        if (rope) {
            const int pi = e >> 1, q = CW / 4; const int k = pi < q ? pi : pi - q; const int pos = pi < q ? (t >> 6) : (t & 63);
            typedef float f32x2t __attribute__((ext_vector_type(2)));
            const f32x2t cssn = ((const f32x2t*)rtab)[pos * q + k]; const float cs = cssn.x, sn = cssn.y;
            const float r0 = y0 * cs - y1 * sn, r1 = y0 * sn + y1 * cs; y0 = r0; y1 = r1;
        }
        if (valid) *(unsigned*)(out + 128 * i + 2 * lane) = cvt_pk_bf16(y0, y1);
    }
}
__device__ __forceinline__ void ph_prep1(const Params& p, int layer) {
    const int tid = otid(); const int lane = tid & 63, gw = obid() * 8 + (tid >> 6), NGW = gridDim.x * 8;
    bf16_t* Z = (bf16_t*)(p.ws + WS_G + G_Z); bf16_t* CQ = (bf16_t*)(p.ws + WS_G + G_CQ); bf16_t* CKV = (bf16_t*)(p.ws + WS_G + G_CKV);
    const float* daq = p.in[18] + layer * 64; const float* dak = p.in[19] + layer * 64; const float* gqq = p.in[22] + layer * 128; const float* gqk = p.in[23] + layer * 128;
    const float* r64 = (const float*)(p.ws + WS_ROPE64); const float* r128 = (const float*)(p.ws + WS_ROPE128);
    const float* cqn = p.in[24] + layer * 256; const float* ckvn = p.in[25] + layer * 128; const float* mlk = p.in[29] + layer * 192;
    for (int r = gw; r < RB; r += NGW) {
        bf16_t* z = Z + (size_t)r * ZW; const bool lat = r >= CTX; const int t = r - CTX;
        unsigned wq[4], wk[4], gq[4], gk[2], kv[1], kr[1];
        seg_load<4>(z + Z_DAQ, 512, lane, wq); seg_load<4>(z + Z_DAK, 512, lane, wk); seg_load<4>(z + Z_GQQ, 512, lane, gq); seg_load<2>(z + Z_GQK, 256, lane, gk);
        seg_load<1>(z + Z_CKV, 128, lane, kv); seg_load<1>(z + Z_KR, 64, lane, kr);
        const u32x2 wc = *(const u32x2*)(z + Z_CQ + 4 * lane);
        seg_fin<64, 4>(wq, z + Z_DAQ, 512, daq, lat, t, lane, r64);
        seg_fin<64, 4>(wk, z + Z_DAK, 512, dak, lat, t, lane, r64);
        seg_fin<128, 4>(gq, z + Z_GQQ, 512, gqq, lat, t, lane, r128);
        seg_fin<128, 2>(gk, z + Z_GQK, 256, gqk, lat, t, lane, r128);
        seg_fin<128, 1>(kv, CKV + (size_t)r * 128, 128, ckvn, false, 0, lane);
        seg_fin<64, 1>(kr, z + Z_KR, 64, mlk + 128, lat, t, lane, r64);
        {
            const float x0 = bflo(wc.x), x1 = bfhi(wc.x), x2 = bflo(wc.y), x3 = bfhi(wc.y);
            const float rs = rsqrtf(wave_sum(x0 * x0 + x1 * x1 + x2 * x2 + x3 * x3) * (1.f / 256) + EPS);
            const f32x4 g = *(const f32x4*)(cqn + 4 * lane);
            u32x2 o; o.x = cvt_pk_bf16(x0 * rs * g.x, x1 * rs * g.y); o.y = cvt_pk_bf16(x2 * rs * g.z, x3 * rs * g.w);
            *(u32x2*)(CQ + (size_t)r * 256 + 4 * lane) = o;
        }
    }
}
__device__ __forceinline__ void ph_prep2(const Params& p, int layer) {
    const int tid = otid(); const int lane = tid & 63, gw = obid() * 8 + (tid >> 6), NGW = gridDim.x * 8;
    const bf16_t* Z = (const bf16_t*)(p.ws + WS_G + G_Z); bf16_t* MLQ = (bf16_t*)(p.ws + WS_G + G_MLQ); const bf16_t* MLKV = (const bf16_t*)(p.ws + WS_G + G_MLKV); bf16_t* KF = (bf16_t*)(p.ws + WS_G + G_KF);
    const float* mlq = p.in[28] + layer * 192; const float* mlk = p.in[29] + layer * 192; const float* r64 = (const float*)(p.ws + WS_ROPE64);
    for (int r = gw; r < RB; r += NGW) {
        const bool lat = r >= CTX; const int t = r - CTX;
        bf16_t* q = MLQ + (size_t)r * 768; const bf16_t* kv = MLKV + (size_t)r * 1024; bf16_t* kf = KF + (size_t)r * 768;
        const unsigned krw = lane < 32 ? *(const unsigned*)(Z + (size_t)r * ZW + Z_KR + 2 * lane) : 0u;
        unsigned qn[4][1], qp[4][1], kn[4][1];
#pragma unroll
        for (int h = 0; h < 4; ++h) { seg_load<1>(q + h * 192, 128, lane, qn[h]); seg_load<1>(q + h * 192 + 128, 64, lane, qp[h]); seg_load<1>(kv + h * 256, 128, lane, kn[h]); }
#pragma unroll
        for (int h = 0; h < 4; ++h) {
            seg_fin<128, 1>(qn[h], q + h * 192, 128, mlq, false, 0, lane);
            seg_fin<64, 1>(qp[h], q + h * 192 + 128, 64, mlq + 128, lat, t, lane, r64);
            seg_fin<128, 1>(kn[h], kf + h * 192, 128, mlk, false, 0, lane);
            if (lane < 32) *(unsigned*)(kf + h * 192 + 128 + 2 * lane) = krw;
        }
    }
}
__device__ __forceinline__ void ph_subln(const Params& p, int layer) {
    const int tid = otid(); const int lane = tid & 63, gw = obid() * 8 + (tid >> 6), NGW = gridDim.x * 8;
    const bf16_t* A1 = (const bf16_t*)(p.ws + WS_G + G_A1); const bf16_t* A2 = (const bf16_t*)(p.ws + WS_G + G_A2); bf16_t* O = (bf16_t*)(p.ws + WS_G + G_BR);
    const float* lam = p.in[20] + layer * 256; const float* sub = p.in[21] + layer * 128;
    int lyr = layer; asm volatile("" : "+s"(lyr));
    const float lam_init = lyr == 0 ? 0.2f : 0.35550907f;
    const float l1 = wave_sum(lam[lane] * lam[64 + lane]), l2 = wave_sum(lam[128 + lane] * lam[192 + lane]);
    const float lam_full = expf(l1) - expf(l2) + lam_init;
    const float g0 = sub[2 * lane] * (1.f - lam_init), g1 = sub[2 * lane + 1] * (1.f - lam_init);
    for (int r = gw; r < RB; r += NGW) {
        unsigned w1[4], w2[4];
#pragma unroll
        for (int h = 0; h < 4; ++h) { const size_t off = (size_t)r * 512 + h * 128 + 2 * lane; w1[h] = *(const unsigned*)(A1 + off); w2[h] = *(const unsigned*)(A2 + off); }
#pragma unroll
        for (int h = 0; h < 4; ++h) {
            const size_t off = (size_t)r * 512 + h * 128 + 2 * lane;
            const float d0 = bflo(w1[h]) - lam_full * bflo(w2[h]), d1 = bfhi(w1[h]) - lam_full * bfhi(w2[h]);
            const float rs = rsqrtf(wave_sum(d0 * d0 + d1 * d1) * (1.f / 128) + EPS);
            *(unsigned*)(O + off) = cvt_pk_bf16(d0 * rs * g0, d1 * rs * g1);
        }
    }
}

__device__ __forceinline__ void attn_unit(const Params& p, int u, char* lds) {
    const bf16_t* Z = (const bf16_t*)(p.ws + WS_G + G_Z);
    int type, hd, qb;
    if (u < 128) { type = 0; hd = u >> 5; qb = 1 + (u & 31); }
    else if (u < 256) { type = 1; hd = (u - 128) >> 5; qb = 1 + (u & 31); }
    else if (u < 512) { type = 2; hd = (u - 256) >> 5; qb = 1 + (u & 31); }
    else { const int k = u - 512; qb = 0; if (k < 4) { type = 0; hd = k; } else if (k < 8) { type = 1; hd = k - 4; } else { type = 2; hd = k - 8; } }
    const int seq = qb == 0 ? CTX : RB; const size_t q0 = (size_t)qb * 256;
#ifndef ATT_TYPES
#define ATT_TYPES 7
#endif
    if (type == 0 && (ATT_TYPES & 1)) {
        const bf16_t* Q = (const bf16_t*)(p.ws + WS_G + G_MLQ) + q0 * 768 + hd * 192;
        const bf16_t* K = (const bf16_t*)(p.ws + WS_G + G_KF) + hd * 192;
        const bf16_t* V = (const bf16_t*)(p.ws + WS_G + G_MLKV) + hd * 256 + 128;
        bf16_t* O = (bf16_t*)(p.ws + WS_G + G_BR) + (size_t)2 * RB * 512 + q0 * 512 + hd * 128;
#ifndef ML_QL
#define ML_QL -1
#endif
#ifndef ATT_DMA
#define ATT_DMA 7
#endif
        if constexpr (ATT_DMA & 1) att::attn_body_dma<192, 768, 768, 1024, 512>(Q, K, V, O, seq, lds);
        else if constexpr (ML_QL < 0) att::attn_body_simple<192, 768, 768, 1024, 512>(Q, K, V, O, seq, lds);
        else att::attn_body<192, 768, 768, 1024, 512, (ML_QL < 0 ? 0 : ML_QL)>(Q, K, V, O, seq, lds);
    } else if (type == 1 && (ATT_TYPES & 2)) {
        const int kvh = hd >> 1;
        const bf16_t* Q = Z + q0 * ZW + Z_GQQ + hd * 128;
        const bf16_t* K = Z + Z_GQK + kvh * 128;
        const bf16_t* V = Z + Z_GQV + kvh * 128;
        bf16_t* O = (bf16_t*)(p.ws + WS_G + G_BR) + (size_t)1 * RB * 512 + q0 * 512 + hd * 128;
#ifndef GQ_SIMPLE
#define GQ_SIMPLE 1
#endif
        if constexpr (ATT_DMA & 2) att::attn_body_dma<128, ZW, ZW, ZW, 512>(Q, K, V, O, seq, lds);
        else if constexpr (GQ_SIMPLE) att::attn_body_simple<128, ZW, ZW, ZW, 512>(Q, K, V, O, seq, lds); else att::attn_body<128, ZW, ZW, ZW, 512>(Q, K, V, O, seq, lds);
    } else if (type == 2 && (ATT_TYPES & 4)) {
        const int h = hd >> 1, m = hd & 1;
        const bf16_t* Q = Z + q0 * ZW + Z_DAQ + h * 128 + m * 64;
        const bf16_t* K = Z + Z_DAK + h * 128 + m * 64;
        const bf16_t* V = Z + Z_DAV + h * 128;
        bf16_t* O = (bf16_t*)(p.ws + WS_G + (m == 0 ? G_A1 : G_A2)) + q0 * 512 + h * 128;
#ifndef DA_SIMPLE
#define DA_SIMPLE 0
#endif
        if constexpr (ATT_DMA & 4) att::attn_body_dma<64, ZW, ZW, ZW, 512>(Q, K, V, O, seq, lds);
        else if constexpr (DA_SIMPLE) att::attn_body_simple<64, ZW, ZW, ZW, 512>(Q, K, V, O, seq, lds); else att::attn_body<64, ZW, ZW, ZW, 512>(Q, K, V, O, seq, lds);
    }
}
#ifndef ATT_REP_TYPES
#define ATT_REP_TYPES 7
#endif
__device__ __forceinline__ void ph_attn(const Params& p, char* lds, int last, int tmask = 7) {
    const int G = gridDim.x, c = obid();
    for (int i = 0; i < 3; ++i) {
        int u;
        const int xcd = c & 7, jq = c >> 3;
        if (G == 256) u = i == 0 ? (xcd < 4 ? xcd * 32 + jq : 128 + (xcd - 4) * 32 + jq) : (i == 1 ? 256 + xcd * 32 + jq : ((c >= 128 && c < 144 && !last) ? 512 + (c - 128) : -1));
        else u = -1;
        if (u >= 0) { const int ty = u < 128 ? 1 : (u < 256 ? 2 : (u < 512 ? 4 : 7)); if (ty & tmask) attn_unit(p, u, lds); }
    }
    if (G != 256) for (int u = c; u < (last ? 512 : 528); u += G) attn_unit(p, u, lds);
}


#define XB_TMO      128
#define XB_XCNT(j)  (256  + 64 * (j))
#define XB_XSUB(j)  (1280 + 64 * (j))
#define XB_XGEN(j)  (2304 + 64 * (j))
#define XB_TOP      3328
#define XB_TOPGEN   3392
#define XCD_BAR_WORDS 3456
#define XB_SPIN_CAP (1u << 23)
__device__ __forceinline__ unsigned xb_ld(unsigned* p)              { return __hip_atomic_load(p, __ATOMIC_RELAXED, __HIP_MEMORY_SCOPE_AGENT); }
__device__ __forceinline__ unsigned xb_add(unsigned* p, unsigned v) { return __hip_atomic_fetch_add(p, v, __ATOMIC_RELAXED, __HIP_MEMORY_SCOPE_AGENT); }
__device__ __forceinline__ unsigned xb_xcc_id() { return (unsigned)__builtin_amdgcn_s_getreg((3 << 11) | 20) & 0xFu; }
#define XB_SPIN(cond, bar) do { unsigned _sp = 0; while (cond) { __builtin_amdgcn_s_sleep(1); \
    if ((++_sp & 255u) == 0u) { if (xb_ld(&(bar)[XB_TMO])) break; if (_sp > XB_SPIN_CAP) { atomicAdd(&(bar)[XB_TMO], 1u); break; } } } } while (0)
struct XcdBarrier { unsigned* bar; unsigned x; volatile LAS unsigned* st; };
__device__ __forceinline__ void xcd_barrier_complete(unsigned* bar, unsigned x, unsigned& nloc, unsigned& nx) {
    const unsigned G = gridDim.x * gridDim.y * gridDim.z;
    unsigned sum, cnt, mine, sp = 0u;
    for (;;) {
        sum = 0u; cnt = 0u; mine = 0u;
#pragma unroll
        for (unsigned j = 0; j < 16; ++j) { const unsigned c = xb_ld(&bar[XB_XCNT(j)]); sum += c; cnt += (c > 0u) ? 1u : 0u; mine = (j == x) ? c : mine; }
        if (sum == G) break;
        __builtin_amdgcn_s_sleep(1);
        if ((++sp & 255u) == 0u) { if (xb_ld(&bar[XB_TMO])) break; if (sp > XB_SPIN_CAP) { atomicAdd(&bar[XB_TMO], 1u); break; } }
    }
    nloc = mine > 0u ? mine : 1u; nx = cnt > 0u ? cnt : 1u;
}
__device__ __forceinline__ void xcd_barrier(const XcdBarrier& b) {
    asm volatile("s_waitcnt vmcnt(0)" ::: "memory");
    __syncthreads();
    if (otid() == 0) {
        unsigned* bar = b.bar;
        __builtin_amdgcn_s_waitcnt(0);
        unsigned nloc = b.st[0], nx = b.st[1];
        if (nloc == 0u) { xcd_barrier_complete(bar, b.x, nloc, nx); b.st[0] = nloc; b.st[1] = nx; }
        const unsigned old = xb_add(&bar[XB_XSUB(b.x)], 1u);
        const unsigned gen = old / nloc;
        if (old + 1u == (gen + 1u) * nloc) {
            __builtin_amdgcn_fence(__ATOMIC_RELEASE, "agent");
            asm volatile("s_waitcnt vmcnt(0)" ::: "memory");
            const unsigned og = xb_add(&bar[XB_TOP], 1u);
            const unsigned tg = og / nx;
            if (og + 1u == (tg + 1u) * nx) xb_add(&bar[XB_TOPGEN], 1u);
            else XB_SPIN(xb_ld(&bar[XB_TOPGEN]) == tg, bar);
            __builtin_amdgcn_fence(__ATOMIC_ACQUIRE, "agent");
            xb_add(&bar[XB_XGEN(b.x)], 1u);
            asm volatile("s_waitcnt vmcnt(0)" ::: "memory");
        } else {
            XB_SPIN(xb_ld(&bar[XB_XGEN(b.x)]) == gen, bar);
            __builtin_amdgcn_fence(__ATOMIC_ACQUIRE, "agent");
            asm volatile("s_waitcnt vmcnt(0)" ::: "memory");
        }
    }
    __syncthreads();
}

__global__ void __launch_bounds__(512, 2) mk_fwd(Params p0) {
    extern __shared__ __attribute__((aligned(16))) unsigned char lds_raw[];
    LAS unsigned char* lds = (LAS unsigned char*)lds_raw;
    cg::grid_group grid = cg::this_grid();
#define GSYNC() do { if (hi < 0) { asm volatile("s_waitcnt vmcnt(0) lgkmcnt(0)" ::: "memory"); grid.sync(); }     \
    else { XcdBarrier xb_; xb_.bar = (unsigned*)(load_params().ws + WS_BAR); xb_.x = xb_xcc_id(); xb_.st = (volatile LAS unsigned*)(lds + 131072 + 64); xcd_barrier(xb_); } } while (0)
    if (threadIdx.x == 0) { volatile LAS unsigned* st_ = (volatile LAS unsigned*)(lds + 131072 + 64); st_[0] = 0u; st_[1] = 0u;
        (void)xb_add(&((unsigned*)(p0.ws + WS_BAR))[XB_XCNT(xb_xcc_id())], 1u); }
    __syncthreads();
    const int lo = p0.lo, hi = p0.hi; int ph = 0; int layer = 0;
#ifndef PHASE_MASK
#define PHASE_MASK 0xFFFF
#endif
#ifndef REPEAT_MASK
#define REPEAT_MASK 0
#endif
#define PH_BEGIN(cat) if (ph >= lo && ph < hi) { constexpr int cat_ = (cat); (void)cat_; DIAG_T0(cat) if constexpr ((PHASE_MASK >> (cat)) & 1) for (int rep_ = 0; rep_ < (((REPEAT_MASK >> (cat)) & 1) ? 2 : 1); ++rep_) { if (rep_) GSYNC(); const Params p = load_params(); \
    unsigned char* ws = p.ws; float* MOD = (float*)(ws + WS_MOD); float* ctxb = (float*)(ws + WS_CTXB); bf16_t* H = (bf16_t*)(ws + WS_H); bf16_t* ABR = (bf16_t*)(ws + WS_ABR); \
    const bf16_t* Wl = (const bf16_t*)(ws + WS_W + layer * W_LAYER_B); const float* modl = MOD + (size_t)layer * 5 * MODW; \
    const float* xl_in = layer == 0 ? p.in[0] : p.out; const float* xc_in = layer == 0 ? p.in[2] : ctxb; \
    int lastl = layer; asm volatile("" : "+s"(lastl)); lastl = (lastl == 1) ? 1 : 0; \
    (void)MOD; (void)ctxb; (void)H; (void)ABR; (void)Wl; (void)modl; (void)xl_in; (void)xc_in; (void)lastl;
#if defined(DIAG_A_MASK)
#define DIAG_T0(cat) if (blockIdx.x == 0 && threadIdx.x == 0) { ((LAS unsigned long long*)(lds + LDS_BYTES - 64))[2] = __builtin_amdgcn_s_memrealtime(); }
#define DIAG_T1(cat) if (blockIdx.x == 0 && threadIdx.x == 0) { LAS unsigned long long* ta_ = (LAS unsigned long long*)(lds + LDS_BYTES - 64); const unsigned long long dt_ = __builtin_amdgcn_s_memrealtime() - ta_[2]; \
    if ((DIAG_A_MASK >> (cat)) & 1) ta_[0] += dt_; if ((DIAG_B_MASK >> (cat)) & 1) ta_[1] += dt_; }
#else
#define DIAG_T0(cat)
#define DIAG_T1(cat)
#endif
#define PH_END   } if (ph + 1 < hi) GSYNC(); DIAG_T1(cat_) } ++ph;
    const int G = gridDim.x, c = blockIdx.x;
#if defined(DIAG_A_MASK)
    if (threadIdx.x == 0) { LAS unsigned long long* ta_ = (LAS unsigned long long*)(lds + LDS_BYTES - 64); ta_[0] = 0; ta_[1] = 0; }
#endif

#if defined(EXTRA_SYNCS)
    for (int es = 0; es < EXTRA_SYNCS; ++es) GSYNC();
#endif
    PH_BEGIN(0) ph_prologue(p, lds); PH_END

    for (layer = 0; layer < 2; ++layer) {

        PH_BEGIN(1) ph_norm_mod(xl_in, xc_in, p.in[6] + layer * DM, modl, 0, H); PH_END

        PH_BEGIN(2) {
            pg8::Gemm g{H, Wl + W_IN, MTOT, 512, 1024}; pg8::StaticOrder S; S.init(MTOT, 512, G, c);
            pg8::Epi<pg8::E_STORE> E{}; E.a.O = (bf16_t*)(ws + WS_G + S_U); E.a.ldc = 512;
            pg8::gemm_phase(lds, g, S, E);
            { pg8::Gemm g2{H, Wl + W_IN + (size_t)512 * 1024, RB, ZW, 1024}; pg8::StaticOrder S2; S2.init(RB, ZW, G, (c + 160) % G);
              pg8::Epi<pg8::E_INPROJ> E2{}; E2.a.O = (bf16_t*)(ws + WS_G + G_Z); E2.a.ldc = ZW;
              pg8::gemm_phase(lds, g2, S2, E2); }
        } PH_END

        PH_BEGIN(3) { for (int u = c; u < 256; u += G) s5_chain(p, layer, u, lds); } PH_END

        PH_BEGIN(4) ph_s5_gelu(p, layer); PH_END

        PH_BEGIN(9) {
            pg8::Gemm g{(const bf16_t*)(ws + WS_G + S_U), Wl + W_GLU, MTOT, 512, 512}; pg8::StaticOrder S; S.init(MTOT, 512, G, c);
            pg8::Epi<pg8::E_GLU> E{}; E.a.O = ABR; E.a.ldc = 512; E.a.G = (const bf16_t*)(ws + WS_G + S_U); E.a.ldg = 512; E.a.bias = p.in[17] + layer * 512;
            pg8::gemm_phase(lds, g, S, E);
            ph_prep1(p, layer);
        } PH_END

        for (int gb = 0; gb < NB; ++gb) {
            const size_t grow0 = (size_t)gb * RB;
            if (gb > 0) {
            PH_BEGIN(10) {
                pg8::Gemm g{H + grow0 * DM, Wl + W_IN + (size_t)512 * 1024, RB, ZW, 1024}; pg8::StaticOrder S; S.init(RB, ZW, G, c);
                pg8::Epi<pg8::E_INPROJ> E{}; E.a.O = (bf16_t*)(ws + WS_G + G_Z); E.a.ldc = ZW;
                pg8::gemm_phase(lds, g, S, E);
            } PH_END

            PH_BEGIN(5) ph_prep1(p, layer); PH_END
            }

            PH_BEGIN(11) {
                { pg8::Gemm g{(const bf16_t*)(ws + WS_G + G_CQ), Wl + W_UQ, RB, 768, 256}; pg8::StaticOrder S; S.init(RB, 768, G, c);
                  pg8::Epi<pg8::E_STORE> E{}; E.a.O = (bf16_t*)(ws + WS_G + G_MLQ); E.a.ldc = 768;
                  pg8::gemm_phase(lds, g, S, E); }
                { pg8::Gemm g{(const bf16_t*)(ws + WS_G + G_CKV), Wl + W_UKV, RB, 1024, 128}; pg8::StaticOrder S; S.init(RB, 1024, G, (c + 128) % G);
                  pg8::Epi<pg8::E_STORE> E{}; E.a.O = (bf16_t*)(ws + WS_G + G_MLKV); E.a.ldc = 1024;
                  pg8::gemm_phase(lds, g, S, E); }
            } PH_END

            PH_BEGIN(6) ph_prep2(p, layer); PH_END

            PH_BEGIN(7) ph_attn(p, (char*)lds_raw, lastl, rep_ ? ATT_REP_TYPES : 7); PH_END

            PH_BEGIN(8) ph_subln(p, layer); PH_END

            PH_BEGIN(12) {
                const int vpm0 = gb * TPB, vpm1 = (int)((WS_G + G_BR - WS_ABR) / 262144);
                pg8::Gemm g{ABR, Wl + W_BR, RB, 1024, 512}; pg8::MergeOrder S{G, c, vpm0, vpm1, lastl};
                pg8::Epi<pg8::E_MERGE> E{}; E.a.O = H + grow0 * DM; E.a.ldc = DM; E.a.G = (const bf16_t*)(ws + WS_G + G_Z) + Z_GATE; E.a.ldg = ZW;
                E.a.MF = (float*)(ws + WS_G + G_MF); E.a.vpm0 = vpm0; E.a.vpm1 = vpm1;
                pg8::gemm_phase(lds, g, S, E);
            } PH_END
        }

        PH_BEGIN(13) {
            pg8::Gemm g{H, Wl + W_OUT, MTOT, 1024, 1024}; pg8::StaticOrder S; S.init(MTOT, 1024, G, c, lastl);
            pg8::Epi<pg8::E_RESID> E{}; E.a.xin_l = xl_in; E.a.xin_c = xc_in; E.a.xout_l = p.out; E.a.xout_c = ctxb; E.a.gate = modl + 2 * 1024;
            pg8::gemm_phase(lds, g, S, E);
        } PH_END

        PH_BEGIN(1) ph_norm_mod(p.out, ctxb, p.in[32] + layer * DM, modl, 3, H); PH_END

        PH_BEGIN(14) {
            pg8::Gemm g{H, Wl + W_FI, MTOT, 2 * DFF, 1024}; pg8::StaticOrder S; S.init(MTOT, 2 * DFF, G, c, lastl);
            pg8::Epi<pg8::E_SWIGLU> E{}; E.a.O = (bf16_t*)(ws + WS_G); E.a.ldc = DFF;
            pg8::gemm_phase(lds, g, S, E);
        } PH_END

        PH_BEGIN(15) {
            pg8::Gemm g{(const bf16_t*)(ws + WS_G), Wl + W_FO, MTOT, 1024, DFF}; pg8::StaticOrder S; S.init(MTOT, 1024, G, c, lastl);
            pg8::Epi<pg8::E_RESID> E{}; E.a.xin_l = p.out; E.a.xin_c = ctxb; E.a.xout_l = p.out; E.a.xout_c = ctxb; E.a.gate = modl + 5 * 1024;
            pg8::gemm_phase(lds, g, S, E);
        } PH_END
    }
#if defined(DIAG_A_MASK)
    GSYNC();
    if (blockIdx.x == 0) { LAS unsigned long long* ta_ = (LAS unsigned long long*)(lds + LDS_BYTES - 64);
        const float A = (float)ta_[0] * 0.01f, B = (float)ta_[1] * 0.01f;
        if (threadIdx.x == 0) p0.out[0] = A; else p0.out[threadIdx.x] = B; if (threadIdx.x > 0) p0.out[threadIdx.x + 511] = B; }
#endif
#undef PH_BEGIN
#undef PH_END
}
constexpr int N_PHASES = 1 + 2 * (5 + 4 * 7 + 4 - 2);

extern "C" void kernel_launch(void* const* d_in, const int* in_sizes, int n_in, void* d_out, int out_size, void* d_ws, size_t ws_size, hipStream_t stream) {
    static int grid = 0;
    if (grid == 0) {
        if (n_in != 35 || out_size != NB * SEQ * DM || ws_size < WS_END) { fprintf(stderr, "kernel_launch: bad shapes: n_in %d out %d ws %zu (need %zu)\n", n_in, out_size, ws_size, (size_t)WS_END); grid = -1; return; }
        int dev = 0, cus = 0, per_cu = 0;
        (void)hipGetDevice(&dev); (void)hipDeviceGetAttribute(&cus, hipDeviceAttributeMultiprocessorCount, dev);
        if (hipFuncSetAttribute((const void*)mk_fwd, hipFuncAttributeMaxDynamicSharedMemorySize, LDS_BYTES) != hipSuccess) { fprintf(stderr, "kernel_launch: hipFuncSetAttribute failed\n"); grid = -1; return; }
        (void)hipOccupancyMaxActiveBlocksPerMultiprocessor(&per_cu, (const void*)mk_fwd, 512, LDS_BYTES);
        (void)hipGetLastError();
        if (per_cu < 1) per_cu = 1;
        grid = cus;
    }
    if (grid < 0) return;
    if (hipMemsetAsync((char*)d_ws + WS_BAR, 0, 16384, stream) != hipSuccess) { fprintf(stderr, "kernel_launch: memset failed\n"); return; }
    Params p{};
    for (int i = 0; i < 35; ++i) p.in[i] = (const float*)d_in[i];
    p.out = (float*)d_out; p.ws = (unsigned char*)d_ws;
#if MK_MODE == 0
    p.lo = 0; p.hi = N_PHASES;
    void* args[] = {&p};
    hipError_t e = hipLaunchCooperativeKernel((const void*)mk_fwd, dim3(grid), dim3(512), args, LDS_BYTES, stream);
    if (e != hipSuccess) fprintf(stderr, "cooperative launch failed: %s (grid %d)\n", hipGetErrorString(e), grid);
#else
    for (int ph = 0; ph < N_PHASES; ++ph) {
        p.lo = ph; p.hi = ph + 1;
        hipLaunchKernelGGL(mk_fwd, dim3(grid), dim3(512), LDS_BYTES, stream, p);
    }
#endif
}
```
